# Optimizing an MI355X kernel written in HIP

```python
import math
import jax, jax.numpy as jnp
from jax import lax
import numpy as np

D_MODEL = 1024
BATCH = 8
SEQ = 4096
DEPTH = 4

N_HEADS = 16
HEAD_DIM = D_MODEL // N_HEADS
N_A_LAYERS = DEPTH // 2
N_B_LAYERS = DEPTH - N_A_LAYERS
MOBA_BLOCK = 256
MOBA_TOPK = 3
Q_BLOCK = 128
N_BUCKETS = 32
MAX_DISTANCE = 1024
D_FF = 2816
N_EXPERTS = 8
TOP_K_EXPERTS = 2
D_FF_EXPERT = 3584
N_DENSE = (DEPTH + 1) // 2
N_MOE = DEPTH // 2
EPS = 1e-6
NEG = -1e30

kernel_name = "yoco_moba_stickbreaking_moe_trunk"


def rmsnorm(x, g):
    xf = x.astype(jnp.float32)
    y = xf * lax.rsqrt(jnp.mean(xf * xf, axis=-1, keepdims=True) + EPS)
    return (y * g.astype(jnp.float32)).astype(x.dtype)


def modulate(h, shift, scale):
    return h * (1.0 + scale[:, None, :]) + shift[:, None, :]


def rel_bucket(dist):
    dist = jnp.maximum(dist, 0)
    max_exact = N_BUCKETS // 2
    d = jnp.maximum(dist, 1).astype(jnp.float32)
    large = max_exact + (jnp.log(d / max_exact) / math.log(MAX_DISTANCE / max_exact)
                         * (N_BUCKETS - max_exact)).astype(jnp.int32)
    large = jnp.minimum(large, N_BUCKETS - 1)
    return jnp.where(dist < max_exact, dist, large)


def moba_attend(q, k, v, rel_bias):
    H, S, dh = q.shape
    nb = -(-S // MOBA_BLOCK)
    pad = nb * MOBA_BLOCK - S
    kp = jnp.pad(k, ((0, 0), (0, pad), (0, 0)))
    vp = jnp.pad(v, ((0, 0), (0, pad), (0, 0)))
    kb = kp.reshape(H, nb, MOBA_BLOCK, dh)
    vb = vp.reshape(H, nb, MOBA_BLOCK, dh)
    kmean = jnp.mean(kb, axis=2)
    bias_t = rel_bias.T
    scale = HEAD_DIM ** -0.5
    topk = min(MOBA_TOPK, nb)
    h_idx = jnp.arange(H)[:, None, None]
    blk_ids = jnp.arange(nb)
    offs = jnp.arange(MOBA_BLOCK)

    def per_block(i):
        q0 = i * Q_BLOCK
        qi = lax.dynamic_slice_in_dim(q, q0, Q_BLOCK, axis=1)
        qpos = q0 + jnp.arange(Q_BLOCK)
        cur = q0 // MOBA_BLOCK
        gate = jnp.einsum('hqd,hnd->hqn', qi, kmean).astype(jnp.float32)
        gate = jnp.where(blk_ids[None, None, :] < cur, gate, NEG)
        _, sel = lax.top_k(gate, topk)
        valid = sel < cur
        kg = kb[h_idx, sel]
        vg = vb[h_idx, sel]
        kpos_sel = sel[..., None] * MOBA_BLOCK + offs
        bucket_sel = rel_bucket(qpos[None, :, None, None] - kpos_sel)
        b_sel = jnp.take_along_axis(bias_t, bucket_sel.reshape(H, -1), axis=1).reshape(kpos_sel.shape)
        s_sel = jnp.einsum('hqd,hqjkd->hqjk', qi, kg).astype(jnp.float32) * scale + b_sel
        s_sel = jnp.where(valid[..., None], s_sel, NEG).reshape(H, Q_BLOCK, topk * MOBA_BLOCK)
        k0 = cur * MOBA_BLOCK
        ko = lax.dynamic_slice_in_dim(kp, k0, MOBA_BLOCK, axis=1)
        vo = lax.dynamic_slice_in_dim(vp, k0, MOBA_BLOCK, axis=1)
        d_own = qpos[:, None] - (k0 + offs)[None, :]
        b_own = jnp.take(bias_t, rel_bucket(d_own), axis=1)
        s_own = jnp.einsum('hqd,hkd->hqk', qi, ko).astype(jnp.float32) * scale + b_own
        s_own = jnp.where(d_own[None] >= 0, s_own, NEG)
        p = jax.nn.softmax(jnp.concatenate([s_sel, s_own], axis=-1), axis=-1)
        p_sel = p[..., :topk * MOBA_BLOCK].reshape(H, Q_BLOCK, topk, MOBA_BLOCK).astype(v.dtype)
        p_own = p[..., topk * MOBA_BLOCK:].astype(v.dtype)
        return (jnp.einsum('hqjk,hqjkd->hqd', p_sel, vg)
                + jnp.einsum('hqk,hkd->hqd', p_own, vo))

    outs = lax.map(per_block, jnp.arange(S // Q_BLOCK))
    return outs.transpose(1, 0, 2, 3).reshape(H, S, dh)


def stick_breaking(q, k, v):
    H, S, dh = q.shape
    scale = HEAD_DIM ** -0.5
    kpos = jnp.arange(S)

    def per_block(i):
        q0 = i * Q_BLOCK
        qi = lax.dynamic_slice_in_dim(q, q0, Q_BLOCK, axis=1)
        qpos = q0 + jnp.arange(Q_BLOCK)
        z = jnp.einsum('hqd,hkd->hqk', qi, k).astype(jnp.float32) * scale
        causal = (kpos[None, :] < qpos[:, None])[None]
        log_beta = jax.nn.log_sigmoid(z)
        log_1mb = jnp.where(causal, jax.nn.log_sigmoid(-z), 0.0)
        tail = lax.cumsum(log_1mb, axis=2, reverse=True) - log_1mb
        a = jnp.where(causal, jnp.exp(log_beta + tail), 0.0)
        return jnp.einsum('hqk,hkd->hqd', a.astype(v.dtype), v)

    outs = lax.map(per_block, jnp.arange(S // Q_BLOCK))
    return outs.transpose(1, 0, 2, 3).reshape(H, S, dh)


def split_heads(t):
    B, S, _ = t.shape
    return t.reshape(B, S, N_HEADS, HEAD_DIM).transpose(0, 2, 1, 3)


def merge_heads(t):
    B, H, S, dh = t.shape
    return t.transpose(0, 2, 1, 3).reshape(B, S, H * dh)


def swiglu(t, w13, w2):
    g, u = jnp.split(t @ w13, 2, axis=-1)
    return (jax.nn.silu(g) * u) @ w2


def moe_ffn(h, router_w, w13, w2):
    B, S, D = h.shape
    t = h.reshape(B * S, D)
    logits = (t @ router_w).astype(jnp.float32)
    top_v, top_i = lax.top_k(logits, TOP_K_EXPERTS)
    w = jax.nn.softmax(top_v, axis=-1)
    combine = jnp.sum(jax.nn.one_hot(top_i, N_EXPERTS, dtype=jnp.float32) * w[..., None], axis=1)
    out = jnp.zeros_like(t)
    for e in range(N_EXPERTS):
        out = out + combine[:, e:e + 1].astype(t.dtype) * swiglu(t, w13[e], w2[e])
    return out.reshape(B, S, D)


def setup_inputs(seed: int = 0) -> dict:
    key = jax.random.key(seed)
    ks = jax.random.split(key, 24)
    D = D_MODEL

    def nrm(k, shape, s):
        return jax.random.normal(k, shape, jnp.float32) * s

    return {
        "x": nrm(ks[0], (BATCH, SEQ, D), 1.0),
        "c": nrm(ks[1], (BATCH, D), 1.0),
        "rel_bias": nrm(ks[2], (N_BUCKETS, N_HEADS), 0.5),
        "mod_w": nrm(ks[3], (DEPTH, D, 6 * D), 0.5 * D ** -0.5),
        "mod_b": nrm(ks[4], (DEPTH, 6 * D), 0.02),
        "norm_mix_g": 1.0 + nrm(ks[5], (DEPTH, D), 0.02),
        "norm_ffn_g": 1.0 + nrm(ks[6], (DEPTH, D), 0.02),
        "a_wqkv": nrm(ks[7], (N_A_LAYERS, D, 3 * D), D ** -0.5),
        "a_wo": nrm(ks[8], (N_A_LAYERS, D, D), D ** -0.5),
        "kv_norm_g": 1.0 + nrm(ks[9], (D,), 0.02),
        "kv_mod_w": nrm(ks[10], (D, 2 * D), 0.5 * D ** -0.5),
        "kv_mod_b": nrm(ks[11], (2 * D,), 0.02),
        "b_wkv": nrm(ks[12], (D, 2 * D), D ** -0.5),
        "b_wq": nrm(ks[13], (N_B_LAYERS, D, D), D ** -0.5),
        "b_wo": nrm(ks[14], (N_B_LAYERS, D, D), D ** -0.5),
        "ffn_w13": nrm(ks[15], (N_DENSE, D, 2 * D_FF), D ** -0.5),
        "ffn_w2": nrm(ks[16], (N_DENSE, D_FF, D), D_FF ** -0.5),
        "router_w": nrm(ks[17], (N_MOE, D, N_EXPERTS), D ** -0.5),
        "moe_w13": nrm(ks[18], (N_MOE, N_EXPERTS, D, 2 * D_FF_EXPERT), D ** -0.5),
        "moe_w2": nrm(ks[19], (N_MOE, N_EXPERTS, D_FF_EXPERT, D), D_FF_EXPERT ** -0.5),
        "final_norm_g": 1.0 + nrm(ks[20], (D,), 0.02),
    }


def reference(x, c, rel_bias, mod_w, mod_b, norm_mix_g, norm_ffn_g, a_wqkv, a_wo,
              kv_norm_g, kv_mod_w, kv_mod_b, b_wkv, b_wq, b_wo, ffn_w13, ffn_w2,
              router_w, moe_w13, moe_w2, final_norm_g):
    B, S, D = x.shape
    silu_c = jax.nn.silu(c)
    k_sh = None
    v_sh = None
    for l in range(DEPTH):
        mod = silu_c @ mod_w[l] + mod_b[l]
        sh_a, sc_a, g_a, sh_f, sc_f, g_f = jnp.split(mod, 6, axis=-1)
        h = modulate(rmsnorm(x, norm_mix_g[l]), sh_a, sc_a)
        if l < N_A_LAYERS:
            q, k, v = jnp.split(h @ a_wqkv[l], 3, axis=-1)
            attn = lax.map(lambda a: moba_attend(a[0], a[1], a[2], rel_bias),
                           (split_heads(q), split_heads(k), split_heads(v)))
            y = merge_heads(attn) @ a_wo[l]
        else:
            j = l - N_A_LAYERS
            if j == 0:
                kv_mod = silu_c @ kv_mod_w + kv_mod_b
                kv_sh, kv_sc = jnp.split(kv_mod, 2, axis=-1)
                hk = modulate(rmsnorm(x, kv_norm_g), kv_sh, kv_sc)
                k_s, v_s = jnp.split(hk @ b_wkv, 2, axis=-1)
                k_sh = split_heads(k_s)
                v_sh = split_heads(v_s)
            q = split_heads(h @ b_wq[j])
            attn = lax.map(lambda a: stick_breaking(a[0], a[1], a[2]), (q, k_sh, v_sh))
            y = merge_heads(attn) @ b_wo[j]
        x = x + g_a[:, None, :] * y
        h = modulate(rmsnorm(x, norm_ffn_g[l]), sh_f, sc_f)
        if l % 2 == 0:
            y = swiglu(h, ffn_w13[l // 2], ffn_w2[l // 2])
        else:
            y = moe_ffn(h, router_w[l // 2], moe_w13[l // 2], moe_w2[l // 2])
        x = x + g_f[:, None, :] * y
    return rmsnorm(x, final_norm_g)
```

```cpp
#include <hip/hip_runtime.h>
#include <cstdio>
#include <cstdint>
namespace pg8 {
#define PG8_LAS __attribute__((address_space(3)))
#define PG8_GAS __attribute__((address_space(1)))
typedef unsigned short bf16_t;
typedef short bf16x8 __attribute__((ext_vector_type(8)));
typedef float f32x4 __attribute__((ext_vector_type(4)));
typedef unsigned u32x4 __attribute__((ext_vector_type(4)));
constexpr int BM = 256, BK = 64, HALF = 128, HTB = HALF * BK * 2  , STAGE_BYTES = 8 * HTB, NXCD = 8, WGM = 8;

__host__ __device__ __forceinline__ int lds_byte(int r, int c) { const int st = (r >> 4) * 2 + (c >> 5), rr = r & 15, cc = c & 31, ob = rr * 64 + cc * 2; return st * 1024 + (ob ^ (((ob >> 9) & 1) << 5)); }
__host__ __device__ __forceinline__ void stage_rc(int b, int& R, int& C) { const int st = b / 1024, sb = b % 1024, swz = sb ^ (((sb >> 9) & 1) << 5); R = (st >> 1) * 16 + swz / 64; C = (st & 1) * 32 + (swz % 64) / 2; }
__host__ __device__ __forceinline__ int perm32(int rho) { const int n = rho >> 4, i = rho & 15; return 8 * (i >> 2) + 4 * n + (i & 3); }

struct Unit { int pm, pn, ks; };
struct Gemm { const bf16_t* A; const bf16_t* Bt; int M, N, K, ld; };

struct StaticOrder {
    static constexpr bool SPLITK = false, GATHER = false; const int* tokof;
    int nM, nN, nwg, G, c;
    __host__ __device__ void init(int M, int N, int G_, int c_) { nM = M / BM; nN = N / BM; nwg = nM * nN; G = G_; c = c_; }
    __host__ __device__ bool next(int i, Unit& u) const {
        const long L = (long)i * G + c; if (L >= nwg) return false;
        int wgid = (int)L; { const int q = nwg / NXCD, r = nwg % NXCD, xcd = wgid % NXCD, off = wgid / NXCD; wgid = (xcd < r ? xcd * (q + 1) : r * (q + 1) + (xcd - r) * q) + off; }
        const int nig = WGM * nN, gid = wgid / nig, fm = gid * WGM, gsz = (nM - fm) < WGM ? (nM - fm) : WGM;
        u.pm = fm + ((wgid % nig) % gsz); u.pn = (wgid % nig) / gsz; return true;
    }
    __device__ __forceinline__ void a_ready(const Unit&) const {}
    __device__ __forceinline__ void done(const Unit&) const {}
};
struct MoeOrder {
    static constexpr bool SPLITK = false, GATHER = false; const int* tokof;
    int nM, nN, nwg, G, c; const PG8_LAS int* texp;
    __device__ void init(int ntiles, int nN_, int G_, int c_, const PG8_LAS int* t) { nM = ntiles; nN = nN_; nwg = nM * nN; G = G_; c = c_; texp = t; }
    __device__ bool next(int i, Unit& u) const {
        const long L = (long)i * G + c; if (L >= nwg) return false;
        int wgid = (int)L; { const int q = nwg / NXCD, r = nwg % NXCD, xcd = wgid % NXCD, off = wgid / NXCD; wgid = (xcd < r ? xcd * (q + 1) : r * (q + 1) + (xcd - r) * q) + off; }
        const int nig = WGM * nN, gid = wgid / nig, fm = gid * WGM, gsz = (nM - fm) < WGM ? (nM - fm) : WGM;
        u.pm = fm + ((wgid % nig) % gsz); const int pnl = (wgid % nig) / gsz;
        const int e = __builtin_amdgcn_readfirstlane(texp[u.pm]); u.pn = e * nN + pnl; return true;
    }
    __device__ __forceinline__ void a_ready(const Unit&) const {}
    __device__ __forceinline__ void done(const Unit&) const {}
};

struct MoeGatherOrder : MoeOrder { static constexpr bool GATHER = true; };
struct TailOrder {
    static constexpr bool SPLITK = true, GATHER = false; const int* tokof;
    int nN, nS, nwg, G, c; const PG8_LAS int* texp;
    __device__ void init(int ntail, int nN_, int nS_, int G_, int c_, const PG8_LAS int* t) { nN = nN_; nS = nS_; nwg = ntail * nN_ * nS_; G = G_; c = c_; texp = t; }
    __device__ bool next(int i, Unit& u) const {
        const long L = (long)i * G + c; if (L >= nwg) return false;
        const int id = (int)L, rest = id / nS; u.ks = id - rest * nS; const int tl = rest / nN, pnl = rest - tl * nN; u.pm = 256 + tl;
        const int e = __builtin_amdgcn_readfirstlane(texp[u.pm]); u.pn = e * nN + pnl; return true;
    }
    __device__ __forceinline__ void a_ready(const Unit&) const {}
    __device__ __forceinline__ void done(const Unit&) const {}
};
template <class Base> struct ScaleStage : Base {
    const float* sA; const float* sB; PG8_LAS unsigned char* buf; mutable int cnt;
    __device__ __forceinline__ void a_ready(const Unit& u) const {
        if (threadIdx.x < 64) { PG8_LAS unsigned char* d = buf + (cnt & 1) * 2048;
            __builtin_amdgcn_global_load_lds((const unsigned*)(sA + (size_t)u.pm * BM + threadIdx.x * 4), (PG8_LAS unsigned*)d, 16, 0, 0);
            __builtin_amdgcn_global_load_lds((const unsigned*)(sB + (size_t)u.pn * BM + threadIdx.x * 4), (PG8_LAS unsigned*)(d + 1024), 16, 0, 0); }
        ++cnt; }
};
__device__ __forceinline__ unsigned cvt_pk_bf16(float lo, float hi) { unsigned r; asm volatile("v_cvt_pk_bf16_f32 %0, %1, %2" : "=v"(r) : "v"(lo), "v"(hi)); return r; }

typedef int i32x8 __attribute__((ext_vector_type(8)));
typedef int i32x4 __attribute__((ext_vector_type(4)));
typedef unsigned u32x2 __attribute__((ext_vector_type(2)));
__device__ __forceinline__ i32x8 cat8(bf16x8 a, bf16x8 b) { const i32x4 x = __builtin_bit_cast(i32x4, a), y = __builtin_bit_cast(i32x4, b); return __builtin_shufflevector(x, y, 0, 1, 2, 3, 4, 5, 6, 7); }
__device__ __forceinline__ void mfma8(f32x4& acc, const i32x8 a, const i32x8 b, const int sc) { asm volatile("v_mfma_scale_f32_16x16x128_f8f6f4 %0, %1, %2, %0, %3, %3 op_sel_hi:[0,0,0]" : "+v"(acc) : "v"(a), "v"(b), "v"(sc)); }
__device__ __forceinline__ void mfma8z(f32x4& acc, const i32x8 a, const i32x8 b, const int sc) { asm volatile("v_mfma_scale_f32_16x16x128_f8f6f4 %0, %1, %2, 0, %3, %3 op_sel_hi:[0,0,0]" : "=&v"(acc) : "v"(a), "v"(b), "v"(sc)); }
__device__ __forceinline__ unsigned pk4_fp8(float a, float b, float c, float d) {
    a = __builtin_amdgcn_fmed3f(a, -448.f, 448.f); b = __builtin_amdgcn_fmed3f(b, -448.f, 448.f); c = __builtin_amdgcn_fmed3f(c, -448.f, 448.f); d = __builtin_amdgcn_fmed3f(d, -448.f, 448.f);
    int w = 0; w = __builtin_amdgcn_cvt_pk_fp8_f32(a, b, w, false); w = __builtin_amdgcn_cvt_pk_fp8_f32(c, d, w, true); return (unsigned)w; }
struct EpiBf16 {
    static constexpr bool PERM = true, AFTER_DRAIN = false;
    bf16_t* O; int ldc; int split_cols; size_t split_stride; float scale0; int ntn; float scale_all;
    __device__ __forceinline__ void operator()(const f32x4 (&acc)[2][2][4][2], const Unit& u, int wr, int wc, int fr, int fq) const {
        const int row0 = u.pm * BM + wr * 64 + fr; int colt = (ntn ? (u.pn % ntn) : u.pn) * BM; bf16_t* base = O;
        float sc = scale_all; if (split_cols) { const int t = colt / split_cols; base += (size_t)t * split_stride; colt -= t * split_cols; if (t == 0) sc *= scale0; }
        const int col0 = colt + wc * 32 + 8 * fq;
#pragma unroll
        for (int ai = 0; ai < 2; ++ai)
#pragma unroll
            for (int m = 0; m < 4; ++m) { bf16_t* rowp = base + (size_t)(row0 + ai * HALF + m * 16) * ldc + col0;
#pragma unroll
                for (int bj = 0; bj < 2; ++bj) { f32x4 v0 = acc[ai][bj][m][0] * sc, v1 = acc[ai][bj][m][1] * sc;
                    u32x4 w; w.x = cvt_pk_bf16(v0[0], v0[1]); w.y = cvt_pk_bf16(v0[2], v0[3]); w.z = cvt_pk_bf16(v1[0], v1[1]); w.w = cvt_pk_bf16(v1[2], v1[3]);
                    *(PG8_GAS u32x4*)(rowp + bj * HALF) = w; } }
    }
};
struct EpiBf16I8 {
    static constexpr bool PERM = true, AFTER_DRAIN = false;
    bf16_t* O; int ldc; int split_cols; size_t split_stride; float scale0; PG8_LAS unsigned char* sbuf; mutable int cnt;
    __device__ __forceinline__ void operator()(const f32x4 (&acc)[2][2][4][2], const Unit& u, int wr, int wc, int fr, int fq) const {
        const int row0 = u.pm * BM + wr * 64 + fr; int colt = u.pn * BM; bf16_t* base = O;
        float sc = 1.0f; if (split_cols) { const int t = colt / split_cols; base += (size_t)t * split_stride; colt -= t * split_cols; if (t == 0) sc = scale0; }
        const int col0 = colt + wc * 32 + 8 * fq;
        const PG8_LAS float* sa = (const PG8_LAS float*)(sbuf + (cnt & 1) * 2048) + wr * 64 + fr; const PG8_LAS float* sb = (const PG8_LAS float*)(sbuf + (cnt & 1) * 2048 + 1024) + wc * 32 + 8 * fq; ++cnt;
        f32x4 sv[2][2];
#pragma unroll
        for (int bj = 0; bj < 2; ++bj)
#pragma unroll
            for (int n = 0; n < 2; ++n) sv[bj][n] = *(const PG8_LAS f32x4*)(sb + bj * HALF + 4 * n) * sc;
#pragma unroll
        for (int ai = 0; ai < 2; ++ai)
#pragma unroll
            for (int m = 0; m < 4; ++m) { const int r = row0 + ai * HALF + m * 16; bf16_t* rowp = base + (size_t)r * ldc + col0; const float a = sa[ai * HALF + m * 16];
#pragma unroll
                for (int bj = 0; bj < 2; ++bj) { const f32x4 v0 = __builtin_convertvector(__builtin_bit_cast(i32x4, acc[ai][bj][m][0]), f32x4) * (sv[bj][0] * a), v1 = __builtin_convertvector(__builtin_bit_cast(i32x4, acc[ai][bj][m][1]), f32x4) * (sv[bj][1] * a);
                    u32x4 w; w.x = cvt_pk_bf16(v0[0], v0[1]); w.y = cvt_pk_bf16(v0[2], v0[3]); w.z = cvt_pk_bf16(v1[0], v1[1]); w.w = cvt_pk_bf16(v1[2], v1[3]);
                    *(PG8_GAS u32x4*)(rowp + bj * HALF) = w; } }
    }
};
__device__ __forceinline__ float silu_mul2(float t, float u2) { return (t * u2) * __builtin_amdgcn_rcpf(1.0f + __builtin_amdgcn_exp2f(t)); }
__device__ __forceinline__ float silu_mul(float g, float u) { const float e = __builtin_amdgcn_exp2f(g * -1.4426950408889634f); return g * u * __builtin_amdgcn_rcpf(1.0f + e); }
struct EpiSwiGlu {
    static constexpr bool PERM = true, AFTER_DRAIN = false;
    unsigned char* O; int ldc; int ntn; float ascale, hscale;
    __device__ __forceinline__ void operator()(const f32x4 (&acc)[2][2][4][2], const Unit& u, int wr, int wc, int fr, int fq) const {
        const int row0 = u.pm * BM + wr * 64 + fr; const int col0 = (u.pn % ntn) * HALF + wc * 32 + 8 * fq;
#pragma unroll
        for (int ai = 0; ai < 2; ++ai)
#pragma unroll
            for (int m = 0; m < 4; ++m) { unsigned char* rowp = O + (size_t)(row0 + ai * HALF + m * 16) * ldc + col0;
                const f32x4 g0 = acc[ai][0][m][0] * ascale, g1 = acc[ai][0][m][1] * ascale, u0 = acc[ai][1][m][0] * (ascale * hscale), u1 = acc[ai][1][m][1] * (ascale * hscale);
                u32x2 w; w.x = pk4_fp8(silu_mul(g0[0], u0[0]), silu_mul(g0[1], u0[1]), silu_mul(g0[2], u0[2]), silu_mul(g0[3], u0[3]));
                w.y = pk4_fp8(silu_mul(g1[0], u1[0]), silu_mul(g1[1], u1[1]), silu_mul(g1[2], u1[2]), silu_mul(g1[3], u1[3]));
                *(PG8_GAS u32x2*)rowp = w; }
    }
};
struct EpiSwiGluI8 {
    static constexpr bool PERM = true, AFTER_DRAIN = false;
    unsigned char* O; int ldc; int ntn; PG8_LAS unsigned char* sbuf; float hscale; mutable int cnt;
    __device__ __forceinline__ void operator()(const f32x4 (&acc)[2][2][4][2], const Unit& u, int wr, int wc, int fr, int fq) const {
        const int row0 = u.pm * BM + wr * 64 + fr; const int col0 = (u.pn % ntn) * HALF + wc * 32 + 8 * fq;
        const PG8_LAS float* sa = (const PG8_LAS float*)(sbuf + (cnt & 1) * 2048) + wr * 64 + fr; const PG8_LAS float* sb = (const PG8_LAS float*)(sbuf + (cnt & 1) * 2048 + 1024) + wc * 32 + 8 * fq; ++cnt;
        const f32x4 sg0 = *(const PG8_LAS f32x4*)(sb) * -1.4426950408889634f, sg1 = *(const PG8_LAS f32x4*)(sb + 4) * -1.4426950408889634f;
        const f32x4 su0 = *(const PG8_LAS f32x4*)(sb + HALF) * (hscale * -0.6931471805599453f), su1 = *(const PG8_LAS f32x4*)(sb + HALF + 4) * (hscale * -0.6931471805599453f);
#pragma unroll
        for (int ai = 0; ai < 2; ++ai)
#pragma unroll
            for (int m = 0; m < 4; ++m) { const int r = row0 + ai * HALF + m * 16; unsigned char* rowp = O + (size_t)r * ldc + col0; const float a = sa[ai * HALF + m * 16];
                const f32x4 g0 = __builtin_convertvector(__builtin_bit_cast(i32x4, acc[ai][0][m][0]), f32x4) * (sg0 * a), g1 = __builtin_convertvector(__builtin_bit_cast(i32x4, acc[ai][0][m][1]), f32x4) * (sg1 * a);
                const f32x4 u0 = __builtin_convertvector(__builtin_bit_cast(i32x4, acc[ai][1][m][0]), f32x4) * (su0 * a), u1 = __builtin_convertvector(__builtin_bit_cast(i32x4, acc[ai][1][m][1]), f32x4) * (su1 * a);
                u32x2 w; w.x = pk4_fp8(silu_mul2(g0[0], u0[0]), silu_mul2(g0[1], u0[1]), silu_mul2(g0[2], u0[2]), silu_mul2(g0[3], u0[3]));
                w.y = pk4_fp8(silu_mul2(g1[0], u1[0]), silu_mul2(g1[1], u1[1]), silu_mul2(g1[2], u1[2]), silu_mul2(g1[3], u1[3]));
                *(PG8_GAS u32x2*)rowp = w; }
    }
};
struct EpiPlaneF32 {
    static constexpr bool PERM = true, AFTER_DRAIN = false;
    float* O; int ntn; float scale; size_t plane;
    __device__ __forceinline__ void operator()(const f32x4 (&acc)[2][2][4][2], const Unit& u, int wr, int wc, int fr, int fq) const {
        const int row0 = (u.pm - 256) * BM + wr * 64 + fr, col0 = (u.pn % ntn) * BM + wc * 32 + 8 * fq; float* base = O + (size_t)u.ks * plane;
#pragma unroll
        for (int ai = 0; ai < 2; ++ai)
#pragma unroll
            for (int m = 0; m < 4; ++m) { float* rowp = base + (size_t)(row0 + ai * HALF + m * 16) * 1024 + col0;
#pragma unroll
                for (int bj = 0; bj < 2; ++bj) { *(PG8_GAS f32x4*)(rowp + bj * HALF) = acc[ai][bj][m][0] * scale; *(PG8_GAS f32x4*)(rowp + bj * HALF + 4) = acc[ai][bj][m][1] * scale; } }
    }
};
template <bool XIN_F32> struct EpiResidB {
    static constexpr bool PERM = true, AFTER_DRAIN = false;
    const void* xin; bf16_t* out; const float* gate; int gstride; float ascale;
    __device__ __forceinline__ void operator()(const f32x4 (&acc)[2][2][4][2], const Unit& u, int wr, int wc, int fr, int fq) const {
        const int row0 = u.pm * BM + wr * 64 + fr, col0 = u.pn * BM + wc * 32 + 8 * fq; const float* gp = gate + (size_t)(u.pm >> 4) * gstride + col0;
        f32x4 gv[2][2];
#pragma unroll
        for (int bj = 0; bj < 2; ++bj)
#pragma unroll
            for (int n = 0; n < 2; ++n) gv[bj][n] = *(const PG8_GAS f32x4*)(gp + bj * HALF + 4 * n) * ascale;
#pragma unroll
        for (int ai = 0; ai < 2; ++ai)
#pragma unroll
            for (int m = 0; m < 4; ++m) { const size_t off = (size_t)(row0 + ai * HALF + m * 16) * 1024 + col0;
#pragma unroll
                for (int bj = 0; bj < 2; ++bj) { f32x4 xa, xb;
                    if (XIN_F32) { xa = *(const PG8_GAS f32x4*)((const float*)xin + off + bj * HALF); xb = *(const PG8_GAS f32x4*)((const float*)xin + off + bj * HALF + 4); }
                    else { const u32x4 w = *(const PG8_GAS u32x4*)((const bf16_t*)xin + off + bj * HALF);
                        xa = (f32x4){__uint_as_float(w.x << 16), __uint_as_float(w.x & 0xffff0000u), __uint_as_float(w.y << 16), __uint_as_float(w.y & 0xffff0000u)};
                        xb = (f32x4){__uint_as_float(w.z << 16), __uint_as_float(w.z & 0xffff0000u), __uint_as_float(w.w << 16), __uint_as_float(w.w & 0xffff0000u)}; }
                    const f32x4 r0 = xa + gv[bj][0] * acc[ai][bj][m][0], r1 = xb + gv[bj][1] * acc[ai][bj][m][1];
                    u32x4 o; o.x = cvt_pk_bf16(r0[0], r0[1]); o.y = cvt_pk_bf16(r0[2], r0[3]); o.z = cvt_pk_bf16(r1[0], r1[1]); o.w = cvt_pk_bf16(r1[2], r1[3]);
                    *(PG8_GAS u32x4*)(out + off + bj * HALF) = o; }
                if (m & 1) asm volatile("" ::: "memory"); }
    }
};

template <class Epi, class Sched, bool ALIGN_EPI = false, bool SP2 = false, int MODE = 0>
__device__ __forceinline__ void gemm_phase(PG8_LAS unsigned char* lds, const Gemm g, const Sched& S, const Epi& E) {
    int tid_ = threadIdx.x; asm volatile("" : "+v"(tid_));
    const int tid = tid_, wid = __builtin_amdgcn_readfirstlane(tid >> 6), lane = tid & 63, wr = wid >> 2, wc = wid & 3, fr = lane & 15, fq = lane >> 4;
    const int K = g.K, nt = K / BK, LD = g.ld ? g.ld : K;
    unsigned voffA[2], voffB[2];
#pragma unroll
    for (int i = 0; i < 2; ++i) { int R, C; stage_rc(tid * 16 + i * 8192, R, C); const int Rb = Epi::PERM ? ((R & ~31) + perm32(R & 31)) : R;
        voffA[i] = (unsigned)(R * LD + C) * 2u; voffB[i] = (unsigned)(Rb * LD + C) * 2u; }
    const size_t kstep = (size_t)(BK * 2);
    const size_t hstep = (size_t)HALF * LD * 2;
    const size_t tstep = 2 * hstep;
    const unsigned ldsw = (unsigned)wid * 1024u;
    const int aoff = lds_byte(wr * 64 + fr, fq * 8), boff = lds_byte(wc * 32 + fr, fq * 8);
#define PG8_SA(b, h) (((b) * 2 + (h)) * HTB)
#define PG8_SB(b, h) ((4 + (b) * 2 + (h)) * HTB)
#define PG8_STAGE(bufoff, gbase, voff) do { _Pragma("unroll") for (int _i = 0; _i < 2; ++_i) { unsigned vo_ = (voff)[_i]; asm volatile("" : "+v"(vo_));   \
        __builtin_amdgcn_global_load_lds((const unsigned*)((const char*)(gbase) + vo_), (PG8_LAS unsigned*)(lds + (bufoff) + ldsw + _i * 8192), 16, 0, 0); } } while (0)
#define PG8_STA(bufoff, gbase, h, NX) do { if constexpr (Sched::GATHER) { unsigned vg_[2]; vg_[0] = (NX) ? gN[h][0] : gC[h][0]; vg_[1] = (NX) ? gN[h][1] : gC[h][1]; PG8_STAGE(bufoff, gbase, vg_); } \
        else { PG8_STAGE(bufoff, (gbase) + (h) * hstep, voffA); } } while (0)
#define PG8_LDA(dst, b, h) do { _Pragma("unroll") for (int m = 0; m < 4; ++m) _Pragma("unroll") for (int k = 0; k < 2; ++k) dst[m][k] = *(const PG8_LAS bf16x8*)(lds + PG8_SA(b, h) + aoff + m * 2048 + k * 1024); } while (0)
#define PG8_LDB(dst, b, h) do { _Pragma("unroll") for (int n = 0; n < 2; ++n) _Pragma("unroll") for (int k = 0; k < 2; ++k) dst[n][k] = *(const PG8_LAS bf16x8*)(lds + PG8_SB(b, h) + boff + n * 2048 + k * 1024); } while (0)
#define PG8_MMA(ai, bj, At, Bt) do { __builtin_amdgcn_s_setprio(1); \
        if constexpr (MODE == 1) { _Pragma("unroll") for (int m = 0; m < 4; ++m) _Pragma("unroll") for (int n = 0; n < 2; ++n) \
            mfma8(acc[ai][bj][m][n], cat8(Bt[n][0], Bt[n][1]), cat8(At[m][0], At[m][1]), sc8); } \
        else if constexpr (MODE == 2) { _Pragma("unroll") for (int m = 0; m < 4; ++m) _Pragma("unroll") for (int n = 0; n < 2; ++n) _Pragma("unroll") for (int k = 0; k < 2; ++k) \
            acc[ai][bj][m][n] = __builtin_bit_cast(f32x4, __builtin_amdgcn_mfma_i32_16x16x64_i8(__builtin_bit_cast(i32x4, Bt[n][k]), __builtin_bit_cast(i32x4, At[m][k]), __builtin_bit_cast(i32x4, acc[ai][bj][m][n]), 0, 0, 0)); } \
        else { _Pragma("unroll") for (int m = 0; m < 4; ++m) _Pragma("unroll") for (int n = 0; n < 2; ++n) _Pragma("unroll") for (int k = 0; k < 2; ++k) \
            acc[ai][bj][m][n] = __builtin_amdgcn_mfma_f32_16x16x32_bf16(Bt[n][k], At[m][k], acc[ai][bj][m][n], 0, 0, 0); } __builtin_amdgcn_s_setprio(0); } while (0)
#define PG8_WAIT_V(n) asm volatile("s_waitcnt vmcnt(" #n ")" ::: "memory")
#define PG8_WAIT_L(n) asm volatile("s_waitcnt lgkmcnt(" #n ")" ::: "memory")
#define PG8_BAR __builtin_amdgcn_s_barrier()
#define PG8_SCHED __builtin_amdgcn_sched_barrier(0)
    int sc8 = 0x7f7f7f7f; asm volatile("" : "+v"(sc8));
    Unit cur, nxt; int ui = 0;
    if (!S.next(0, cur)) return;
    f32x4 acc[2][2][4][2];
#pragma unroll
    for (int a = 0; a < 2; ++a)
#pragma unroll
        for (int b = 0; b < 2; ++b)
#pragma unroll
            for (int m = 0; m < 4; ++m)
#pragma unroll
                for (int n = 0; n < 2; ++n) acc[a][b][m][n] = (f32x4){0.f, 0.f, 0.f, 0.f};
    bf16x8 At[4][2], B0[2][2], B1[2][2];
    unsigned gC[2][2] = {{0u, 0u}, {0u, 0u}}, gN[2][2] = {{0u, 0u}, {0u, 0u}};
    auto gload = [&](const Unit& u_, unsigned (&gx)[2][2]) {
#pragma unroll
        for (int h = 0; h < 2; ++h)
#pragma unroll
            for (int i = 0; i < 2; ++i) { int R, C; stage_rc(tid * 16 + i * 8192, R, C); const int tk = S.tokof[u_.pm * BM + h * HALF + R]; gx[h][i] = (unsigned)(tk * LD + C) * 2u; } };
    if constexpr (Sched::GATHER) gload(cur, gC);
    const char* cA = (const char*)g.A + (Sched::GATHER ? (size_t)0 : (size_t)cur.pm * tstep); const char* cB = (const char*)g.Bt + (size_t)cur.pn * tstep;
    if constexpr (Sched::SPLITK) { cA += (size_t)cur.ks * K * 2; cB += (size_t)cur.ks * K * 2; }
    S.a_ready(cur);
    if constexpr (SP2) {
        PG8_STAGE(PG8_SB(0, 0), cB, voffB); PG8_STAGE(PG8_SB(0, 1), cB + hstep, voffB); PG8_STA(PG8_SA(0, 0), cA, 0, false); PG8_STA(PG8_SA(0, 1), cA, 1, false);
        if (wr == 1) PG8_BAR;
        PG8_WAIT_V(2); PG8_BAR;
        PG8_STAGE(PG8_SB(1, 0), cB + kstep, voffB); PG8_STA(PG8_SA(1, 0), cA + kstep, 0, false); PG8_STAGE(PG8_SB(1, 1), cB + hstep + kstep, voffB);
        PG8_WAIT_V(6); PG8_BAR;
    } else {
        PG8_STAGE(PG8_SB(0, 0), cB, voffB); PG8_STAGE(PG8_SA(0, 0), cA, voffA); PG8_STAGE(PG8_SB(0, 1), cB + hstep, voffB); PG8_STAGE(PG8_SA(0, 1), cA + hstep, voffA);
        if (wr == 1) PG8_BAR;
        PG8_WAIT_V(4); PG8_BAR;
        PG8_STAGE(PG8_SB(1, 0), cB + kstep, voffB); PG8_STAGE(PG8_SA(1, 0), cA + kstep, voffA); PG8_STAGE(PG8_SB(1, 1), cB + hstep + kstep, voffB);
        PG8_WAIT_V(6); PG8_BAR;
    }
    for (;;) {
        const bool has_next = S.next(ui + 1, nxt);
        if constexpr (Sched::GATHER) { if (has_next && nxt.pm != cur.pm) gload(nxt, gN); else { gN[0][0] = gC[0][0]; gN[0][1] = gC[0][1]; gN[1][0] = gC[1][0]; gN[1][1] = gC[1][1]; } }
        const char* nA = (has_next && !Sched::GATHER) ? (const char*)g.A + (size_t)nxt.pm * tstep : cA; const char* nB = has_next ? (const char*)g.Bt + (size_t)nxt.pn * tstep : cB;
        if constexpr (Sched::SPLITK) { if (has_next) { nA += (size_t)nxt.ks * K * 2; nB += (size_t)nxt.ks * K * 2; } }
#pragma nounroll
        for (int t = 0; t < nt; t += 2) {
            const bool last = (t == nt - 2);
            const char* a1 = cA + (size_t)(t + 1) * kstep;
            const char* a2 = last ? nA : cA + (size_t)(t + 2) * kstep; const char* b2 = last ? nB : cB + (size_t)(t + 2) * kstep;
            const char* a3 = a2 + kstep; const char* b3 = b2 + kstep;
            if (last && has_next) S.a_ready(nxt);
            if constexpr (SP2) {
            PG8_LDB(B0, 0, 0); PG8_LDB(B1, 0, 1); PG8_SCHED; PG8_LDA(At, 0, 0); PG8_STA(PG8_SA(1, 1), a1, 1, false);
            PG8_WAIT_V(8); PG8_WAIT_L(0); PG8_BAR; PG8_MMA(0, 0, At, B0); PG8_MMA(0, 1, At, B1); PG8_BAR; PG8_SCHED;
            PG8_LDA(At, 0, 1); PG8_STAGE(PG8_SB(0, 0), b2, voffB); PG8_STAGE(PG8_SB(0, 1), b2 + hstep, voffB); PG8_STA(PG8_SA(0, 0), a2, 0, last);
            PG8_WAIT_V(8); PG8_WAIT_L(0); PG8_BAR; PG8_MMA(1, 0, At, B0); PG8_MMA(1, 1, At, B1); PG8_BAR; PG8_SCHED;
            PG8_LDB(B0, 1, 0); PG8_LDB(B1, 1, 1); PG8_SCHED; PG8_LDA(At, 1, 0); PG8_STA(PG8_SA(0, 1), a2, 1, last);
            PG8_WAIT_V(8); PG8_WAIT_L(0); PG8_BAR; PG8_MMA(0, 0, At, B0); PG8_MMA(0, 1, At, B1); PG8_BAR; PG8_SCHED;
            PG8_LDA(At, 1, 1); PG8_STAGE(PG8_SB(1, 0), b3, voffB); PG8_STAGE(PG8_SB(1, 1), b3 + hstep, voffB); PG8_STA(PG8_SA(1, 0), a3, 0, last);
            PG8_WAIT_V(8); PG8_WAIT_L(0); PG8_BAR; PG8_MMA(1, 0, At, B0); PG8_MMA(1, 1, At, B1); PG8_BAR; PG8_SCHED;
            } else {
            PG8_LDB(B0, 0, 0); PG8_SCHED; PG8_LDA(At, 0, 0); PG8_STAGE(PG8_SA(1, 1), a1 + hstep, voffA);
            PG8_WAIT_L(8); PG8_BAR; PG8_WAIT_L(0); PG8_MMA(0, 0, At, B0); PG8_BAR; PG8_SCHED;
            PG8_LDB(B1, 0, 1); PG8_STAGE(PG8_SB(0, 0), b2, voffB);
            PG8_BAR; PG8_WAIT_L(0); PG8_MMA(0, 1, At, B1); PG8_BAR;
            PG8_LDA(At, 0, 1); PG8_STAGE(PG8_SA(0, 0), a2, voffA);
            PG8_BAR; PG8_WAIT_L(0); PG8_MMA(1, 0, At, B0); PG8_BAR; PG8_SCHED;
            PG8_STAGE(PG8_SB(0, 1), b2 + hstep, voffB);
            PG8_WAIT_V(6); PG8_BAR; PG8_MMA(1, 1, At, B1); PG8_BAR;
            PG8_LDB(B0, 1, 0); PG8_SCHED; PG8_LDA(At, 1, 0); PG8_STAGE(PG8_SA(0, 1), a2 + hstep, voffA);
            PG8_WAIT_L(8); PG8_BAR; PG8_WAIT_L(0); PG8_MMA(0, 0, At, B0); PG8_BAR; PG8_SCHED;
            PG8_LDB(B1, 1, 1); PG8_STAGE(PG8_SB(1, 0), b3, voffB);
            PG8_BAR; PG8_WAIT_L(0); PG8_MMA(0, 1, At, B1); PG8_BAR;
            PG8_LDA(At, 1, 1); PG8_STAGE(PG8_SA(1, 0), a3, voffA);
            PG8_BAR; PG8_WAIT_L(0); PG8_MMA(1, 0, At, B0); PG8_BAR; PG8_SCHED;
            PG8_STAGE(PG8_SB(1, 1), b3 + hstep, voffB);
            PG8_WAIT_V(6); PG8_BAR; PG8_MMA(1, 1, At, B1); PG8_BAR;
            }
        }
        if constexpr (MODE == 1) asm volatile("s_nop 15\n\ts_nop 7" ::: "memory");
        if constexpr (ALIGN_EPI) { if (wr == 0) PG8_BAR; }
        if constexpr (!Epi::AFTER_DRAIN) { E(acc, cur, wr, wc, fr, fq); S.done(cur); }
        if (!has_next) break;
#pragma unroll
        for (int a = 0; a < 2; ++a)
#pragma unroll
            for (int b = 0; b < 2; ++b)
#pragma unroll
                for (int m = 0; m < 4; ++m)
#pragma unroll
                    for (int n = 0; n < 2; ++n) acc[a][b][m][n] = (f32x4){0.f, 0.f, 0.f, 0.f};
        cur = nxt; cA = nA; cB = nB; ++ui;
        if constexpr (Sched::GATHER) { gC[0][0] = gN[0][0]; gC[0][1] = gN[0][1]; gC[1][0] = gN[1][0]; gC[1][1] = gN[1][1]; }
        if constexpr (ALIGN_EPI) { if (wr == 1) PG8_BAR; }
    }
    PG8_WAIT_V(0);
    if constexpr (!ALIGN_EPI) { if (wr == 0) PG8_BAR; }
    PG8_BAR;
    if constexpr (Epi::AFTER_DRAIN) { E.fused(acc, cur, wr, wc, fr, fq, lds, wid, lane); S.done(cur); }
#undef PG8_SA
#undef PG8_SB
#undef PG8_STAGE
#undef PG8_STA
#undef PG8_LDA
#undef PG8_LDB
#undef PG8_MMA
#undef PG8_WAIT_V
#undef PG8_WAIT_L
#undef PG8_BAR
#undef PG8_SCHED
}
}

constexpr int NWAVES = 8;
constexpr int NB = 8, SEQ = 4096, D = 1024, NH = 16, HD = 64, NTOK = NB * SEQ;
constexpr int FF = 2816, FFE = 3584, NE = 8;
constexpr int MODW = 6 * D, MODLD = 4 * MODW + 2 * D;
constexpr int KVMOD = 4 * MODW;
constexpr float RMS_EPS = 1e-6f;
constexpr float LOG2E = 1.4426950408889634f;
constexpr float QSCALE = 0.125f * LOG2E;
constexpr float ASCALE8 = 4.0f, WSCALE8 = 128.0f, HSCALE8 = 4.0f, OSCALE8 = 16.0f;
constexpr int BT_PAD = 256;
constexpr int MAXTILES = 264;

constexpr size_t MiB = 1u << 20;
constexpr size_t WS_CTL = 0, CTL_ZERO_BYTES = 64 * 1024;
constexpr size_t WS_MOD = 1 * MiB;
constexpr size_t WS_BIAS = 2 * MiB;
constexpr size_t WS_KMEAN = 2 * MiB + 256 * 1024;
constexpr size_t WS_TOKE = 3 * MiB;
constexpr size_t WS_TOKW = WS_TOKE + 128 * 1024;
constexpr size_t WS_TOKS = WS_TOKW + 256 * 1024;
constexpr size_t WS_HIST = WS_TOKS + 256 * 1024;
constexpr size_t WS_SA = 4 * MiB, WS_SAG = 4 * MiB + 256 * 1024;
constexpr size_t WS_SA2 = 4 * MiB + 640 * 1024;
constexpr size_t WS_SBQKV = 5 * MiB + 576 * 1024, WS_SBKV = WS_SBQKV + 32 * 1024, WS_SBQ = WS_SBKV + 16 * 1024;
constexpr size_t WS_SB13 = 5 * MiB, WS_SBM13 = 5 * MiB + 64 * 1024;
constexpr size_t WS_WQKV = 8 * MiB, WS_WO = 20 * MiB, WS_WKV = 24 * MiB, WS_WQ = 28 * MiB, WS_WBO = 32 * MiB, WS_W13 = 36 * MiB, WS_W2 = 58 * MiB, WS_MW13 = 70 * MiB, WS_MW2 = 294 * MiB;
constexpr size_t WS_XN = 408 * MiB, WS_XN2 = 440 * MiB, WS_XBF = 472 * MiB;
constexpr size_t WS_Q = 536 * MiB, WS_K = 600 * MiB, WS_V = 664 * MiB, WS_KSH = 728 * MiB, WS_VSH = 792 * MiB, WS_HID = 856 * MiB, WS_END = 1320 * MiB;
constexpr int TAIL_NS = 2, TAIL_ROWS = (MAXTILES - 256) * 256;
constexpr size_t WS_YT = WS_KSH;
constexpr size_t WS_TOKOF = 6 * MiB;
constexpr size_t WS_XG = WS_Q;
static_assert((size_t)MAXTILES * 256 * D * 2 <= WS_KSH - WS_Q && (size_t)MAXTILES * 256 * FFE * 2 <= WS_END - WS_HID && WS_MW2 + (size_t)16 * D * FFE * 2 <= WS_XN, "d_ws map");
constexpr int CW_TMO = 0, CW_CODE = 1, CW_BAR = 4096;

constexpr int RING_OFF = 0, RING_BYTES = 131072;
constexpr int LDSCTL_OFF = RING_BYTES, MISC_OFF = LDSCTL_OFF + 320;
constexpr int ROUTE_OFF = RING_BYTES + 1024;
constexpr int RT_CNT = 0, RT_BASE = 8, RT_SEG = 16, RT_NT = 25, RT_TEXP = 32, RT_WC = 320, RT_LS = 336, RT_HIST = 600;
constexpr int PTR_OFF = RING_BYTES + 512;
constexpr int SCALEBUF_OFF = RING_BYTES + 4096;
constexpr int LDS_BYTES = 147456;
static_assert(ROUTE_OFF + (RT_HIST + 8) * 4 <= LDS_BYTES, "LDS map");

#define GAS __attribute__((address_space(1)))
#define LAS __attribute__((address_space(3)))
typedef unsigned short bf16;
typedef unsigned v4u __attribute__((ext_vector_type(4)));
typedef unsigned v2u __attribute__((ext_vector_type(2)));
typedef float f32x4 __attribute__((ext_vector_type(4)));
typedef float f32x2 __attribute__((ext_vector_type(2)));
typedef GAS unsigned gu32;
#define RLX_AGENT __ATOMIC_RELAXED, __HIP_MEMORY_SCOPE_AGENT
#define LDS_WAIT() asm volatile("s_waitcnt lgkmcnt(0)" ::: "memory")
#define VM_WAIT() asm volatile("s_waitcnt vmcnt(0)" ::: "memory")
__device__ __forceinline__ unsigned f2bf(float f) { unsigned u = __builtin_bit_cast(unsigned, f); return (u + 0x7fffu + ((u >> 16) & 1u)) >> 16; }
__device__ __forceinline__ unsigned pk2(float lo, float hi) { return f2bf(lo) | (f2bf(hi) << 16); }
__device__ __forceinline__ float bflo(unsigned w) { return __uint_as_float(w << 16); }
__device__ __forceinline__ float bfhi(unsigned w) { return __uint_as_float(w & 0xffff0000u); }
template <int CTRL> __device__ __forceinline__ float dppf(float v) { return __uint_as_float((unsigned)__builtin_amdgcn_update_dpp(0, (int)__float_as_uint(v), CTRL, 0xf, 0xf, true)); }
template <int CTRL> __device__ __forceinline__ int dppi(int v) { return __builtin_amdgcn_update_dpp(0, v, CTRL, 0xf, 0xf, true); }
#define DPP_X1 0xB1
#define DPP_X2 0x4E
#define DPP_HM 0x141
#define DPP_RM 0x140
#define DPP_X8 0x128
__device__ __forceinline__ float sum16x(float v) { const auto r = __builtin_amdgcn_permlane16_swap(__float_as_uint(v), __float_as_uint(v), false, false); return __uint_as_float(r[0]) + __uint_as_float(r[1]); }
__device__ __forceinline__ float sum32x(float v) { const auto r = __builtin_amdgcn_permlane32_swap(__float_as_uint(v), __float_as_uint(v), false, false); return __uint_as_float(r[0]) + __uint_as_float(r[1]); }
__device__ __forceinline__ float max16x(float v) { const auto r = __builtin_amdgcn_permlane16_swap(__float_as_uint(v), __float_as_uint(v), false, false); return fmaxf(__uint_as_float(r[0]), __uint_as_float(r[1])); }
__device__ __forceinline__ float max32x(float v) { const auto r = __builtin_amdgcn_permlane32_swap(__float_as_uint(v), __float_as_uint(v), false, false); return fmaxf(__uint_as_float(r[0]), __uint_as_float(r[1])); }
__device__ __forceinline__ int isum16x(int v) { const auto r = __builtin_amdgcn_permlane16_swap((unsigned)v, (unsigned)v, false, false); return (int)(r[0] + r[1]); }
__device__ __forceinline__ int isum32x(int v) { const auto r = __builtin_amdgcn_permlane32_swap((unsigned)v, (unsigned)v, false, false); return (int)(r[0] + r[1]); }
__device__ __forceinline__ float wave_sum(float v) { v += dppf<DPP_X1>(v); v += dppf<DPP_X2>(v); v += dppf<DPP_HM>(v); v += dppf<DPP_RM>(v); return sum32x(sum16x(v)); }
__device__ __forceinline__ float wave_max(float v) { v = fmaxf(v, dppf<DPP_X1>(v)); v = fmaxf(v, dppf<DPP_X2>(v)); v = fmaxf(v, dppf<DPP_HM>(v)); v = fmaxf(v, dppf<DPP_RM>(v)); return max32x(max16x(v)); }
__device__ __forceinline__ int wave_isum(int v) { v += dppi<DPP_X1>(v); v += dppi<DPP_X2>(v); v += dppi<DPP_HM>(v); v += dppi<DPP_RM>(v); return isum32x(isum16x(v)); }
__device__ __forceinline__ float max_x8_16_32(float v) { v = fmaxf(v, dppf<DPP_X8>(v)); return max32x(max16x(v)); }
__device__ __forceinline__ float ex2(float x) { return __builtin_amdgcn_exp2f(x); }
__device__ __forceinline__ float lg2(float x) { return __builtin_amdgcn_logf(x); }

#define XB_TMO      128
#define XB_XCNT(j)  (256  + 64 * (j))
#define XB_XSUB(j)  (1280 + 64 * (j))
#define XB_XGEN(j)  (2304 + 64 * (j))
#define XB_TOP      3328
#define XB_TOPGEN   3392
#define XB_LSUB(j)  (3456 + 64 * (j))
#define XB_LGEN(j)  (4480 + 64 * (j))
#define XCD_BAR_WORDS 5504
#define XB_SPIN_CAP (1u << 18)

__device__ __forceinline__ unsigned xb_ld(unsigned* p)              { return __hip_atomic_load(p, __ATOMIC_RELAXED, __HIP_MEMORY_SCOPE_AGENT); }
__device__ __forceinline__ unsigned xb_add(unsigned* p, unsigned v) { return __hip_atomic_fetch_add(p, v, __ATOMIC_RELAXED, __HIP_MEMORY_SCOPE_AGENT); }
__device__ __forceinline__ unsigned xb_xcc_id() { return (unsigned)__builtin_amdgcn_s_getreg((3 << 11) | 20) & 0xFu; }
#define XB_SPIN(cond, bar) do { unsigned _sp = 0; while (cond) { __builtin_amdgcn_s_sleep(1); \
    if ((++_sp & 255u) == 0u) { if (xb_ld(&(bar)[XB_TMO])) break; if (_sp > XB_SPIN_CAP) { atomicAdd(&(bar)[XB_TMO], 1u); break; } } } } while (0)

struct XcdBarrier {
    unsigned* bar; unsigned x;
    volatile LAS unsigned* st;
};

__device__ __forceinline__ XcdBarrier xcd_barrier_post(unsigned* bar, volatile LAS unsigned* st) {
    XcdBarrier b; b.bar = bar; b.x = xb_xcc_id(); b.st = st;
    if (threadIdx.x == 0) st[3] = 1u + xb_add(&bar[XB_XCNT(b.x)], 1u);
    return b;
}
__device__ __forceinline__ void xcd_barrier_complete(unsigned* bar, unsigned x, unsigned& nloc, unsigned& nx, unsigned& reg32) {
    const unsigned G = gridDim.x * gridDim.y * gridDim.z;
    unsigned sum, cnt, mine, n32, sp = 0u;
    for (;;) {
        sum = 0u; cnt = 0u; mine = 0u; n32 = 0u;
#pragma unroll
        for (unsigned j = 0; j < 16; ++j) { const unsigned c = xb_ld(&bar[XB_XCNT(j)]); sum += c; cnt += (c > 0u) ? 1u : 0u; n32 += (c == 32u && j < 8u) ? 1u : 0u; mine = (j == x) ? c : mine; }
        if (sum == G) break;
        __builtin_amdgcn_s_sleep(1);
        if ((++sp & 255u) == 0u) { if (xb_ld(&bar[XB_TMO])) break; if (sp > XB_SPIN_CAP) { atomicAdd(&bar[XB_TMO], 1u); break; } }
    }
    nloc = mine > 0u ? mine : 1u; nx = cnt > 0u ? cnt : 1u;
    reg32 = (sum == G && G == 256u && n32 == 8u) ? 1u : 0u;
}

__device__ __forceinline__ void xcd_barrier(const XcdBarrier& b) {
    asm volatile("s_waitcnt vmcnt(0)" ::: "memory");
    __syncthreads();
    if (threadIdx.x == 0) {
        unsigned* bar = b.bar;
        __builtin_amdgcn_s_waitcnt(0);
        unsigned nloc = b.st[0], nx = b.st[1];
        if (nloc == 0u) { unsigned r32; xcd_barrier_complete(bar, b.x, nloc, nx, r32); b.st[0] = nloc; b.st[1] = nx; b.st[2] = 1u + r32; }
        const unsigned old = xb_add(&bar[XB_XSUB(b.x)], 1u);
        const unsigned gen = old / nloc;
        if (old + 1u == (gen + 1u) * nloc) {
            __builtin_amdgcn_fence(__ATOMIC_RELEASE, "agent");
            asm volatile("s_waitcnt vmcnt(0)" ::: "memory");
            const unsigned og = xb_add(&bar[XB_TOP], 1u);
            const unsigned tg = og / nx;
            if (og + 1u == (tg + 1u) * nx) xb_add(&bar[XB_TOPGEN], 1u);
            else XB_SPIN(xb_ld(&bar[XB_TOPGEN]) == tg, bar);
            __builtin_amdgcn_fence(__ATOMIC_ACQUIRE, "agent");
            xb_add(&bar[XB_XGEN(b.x)], 1u);
            asm volatile("s_waitcnt vmcnt(0)" ::: "memory");
        } else {
            XB_SPIN(xb_ld(&bar[XB_XGEN(b.x)]) == gen, bar);
            __builtin_amdgcn_fence(__ATOMIC_ACQUIRE, "agent");
            asm volatile("s_waitcnt vmcnt(0)" ::: "memory");
        }
    }
    __syncthreads();
}

__device__ __forceinline__ void xcd_barrier_local(const XcdBarrier& b) {
    asm volatile("s_waitcnt vmcnt(0)" ::: "memory");
    __syncthreads();
    if (threadIdx.x == 0) {
        unsigned* bar = b.bar;
        __builtin_amdgcn_s_waitcnt(0);
        const unsigned old = xb_add(&bar[XB_LSUB(b.x)], 1u);
        const unsigned gen = old >> 5;
        if (((old + 1u) & 31u) == 0u) xb_add(&bar[XB_LGEN(b.x)], 1u);
        else XB_SPIN(xb_ld(&bar[XB_LGEN(b.x)]) == gen, bar);
        __builtin_amdgcn_fence(__ATOMIC_ACQUIRE, "agent");
        asm volatile("s_waitcnt vmcnt(0)" ::: "memory");
    }
    __syncthreads();
}

struct Ctx { LAS unsigned char* lds; int tid, lane, wave, vcu, G; };
__device__ __forceinline__ Ctx phase_ctx(const Ctx& C0) { Ctx C = C0; int t = C0.tid; asm volatile("" : "+v"(t)); C.tid = t; C.lane = t & 63; return C; }
enum { IN_X = 0, IN_C, IN_RELB, IN_MODW, IN_MODB, IN_NMIX, IN_NFFN, IN_AWQKV, IN_AWO, IN_KVNG, IN_KVMW, IN_KVMB, IN_BWKV, IN_BWQ, IN_BWO, IN_W13, IN_W2, IN_RW, IN_MW13, IN_MW2, IN_FNG, IN_OUT, IN_WS, IN_COUNT };
__device__ __forceinline__ unsigned long long ptr_bits(const Ctx& C, int k) {
    volatile LAS unsigned long long* t = (volatile LAS unsigned long long*)(C.lds + PTR_OFF);
    const unsigned long long v = t[k];
    const unsigned lo = __builtin_amdgcn_readfirstlane((unsigned)v), hi = __builtin_amdgcn_readfirstlane((unsigned)(v >> 32));
    return ((unsigned long long)hi << 32) | lo; }
__device__ __forceinline__ const float* inp(const Ctx& C, int k) { return (const float*)ptr_bits(C, k); }
__device__ __forceinline__ float* outp(const Ctx& C) { return (float*)ptr_bits(C, IN_OUT); }
__device__ __forceinline__ unsigned char* wsp(const Ctx& C) { return (unsigned char*)ptr_bits(C, IN_WS); }

__device__ __forceinline__ void tr_load(f32x4 (&v)[8], const float* W, int N, int cs, int k0, int lane) {
#pragma unroll
    for (int i = 0; i < 8; ++i) v[i] = *(const GAS f32x4*)(W + (size_t)(k0 + 8 * i + (lane >> 3)) * N + cs + 4 * (lane & 7));
}
template <bool F8>
__device__ __forceinline__ void tr_item(const f32x4 (&v)[8], int K, bf16* WT, int rd, int k0, LAS float* scr, int lane) {
#pragma unroll
    for (int i = 0; i < 8; ++i) { LAS float* d = scr + (8 * i + (lane >> 3)) * 33 + 4 * (lane & 7); d[0] = v[i].x; d[1] = v[i].y; d[2] = v[i].z; d[3] = v[i].w; }
    LDS_WAIT(); asm volatile("" ::: "memory");
    const int c = lane & 7;
    if (F8) {
#pragma unroll
        for (int j = 0; j < 4; ++j) { const int n = (lane >> 3) + 8 * j; const LAS float* s = scr + (8 * c) * 33 + n;
            v2u o; o.x = pg8::pk4_fp8(s[0 * 33] * WSCALE8, s[1 * 33] * WSCALE8, s[2 * 33] * WSCALE8, s[3 * 33] * WSCALE8); o.y = pg8::pk4_fp8(s[4 * 33] * WSCALE8, s[5 * 33] * WSCALE8, s[6 * 33] * WSCALE8, s[7 * 33] * WSCALE8);
            *(GAS v2u*)((unsigned char*)WT + (size_t)(rd + n) * K + k0 + 8 * c) = o; }
    } else {
#pragma unroll
        for (int j = 0; j < 4; ++j) { const int n = (lane >> 3) + 8 * j; const LAS float* s = scr + (8 * c) * 33 + n;
            v4u o; o.x = pk2(s[0 * 33], s[1 * 33]); o.y = pk2(s[2 * 33], s[3 * 33]); o.z = pk2(s[4 * 33], s[5 * 33]); o.w = pk2(s[6 * 33], s[7 * 33]);
            *(GAS v4u*)(WT + (size_t)(rd + n) * K + k0 + 8 * c) = o; }
    }
    LDS_WAIT(); asm volatile("" ::: "memory");
}
template <bool F8>
__device__ __forceinline__ void tr_group(const float* src, bf16* dst, int K, int N, int F, int cnt, int& it, int NTW, LAS float* scr, int lane) {
    const int nblk = N / 32, ipm = (K / 64) * nblk, total = cnt * ipm;
#define TRG_LOAD(vv, it_) do { const int mi_ = (it_) / ipm, r_ = (it_) - mi_ * ipm, kb_ = r_ / nblk, rd_ = 32 * (r_ - kb_ * nblk); int cs_ = rd_; \
        if (F) { const int j_ = rd_ >> 8, w_ = rd_ & 255; cs_ = (w_ < 128) ? 128 * j_ + w_ : F + 128 * j_ + (w_ - 128); } tr_load(vv, src + (size_t)mi_ * K * N, N, cs_, 64 * kb_, lane); } while (0)
    f32x4 v[8], vn[8];
    if (it < total) TRG_LOAD(v, it);
    for (; it < total; it += NTW) {
        const int mi = it / ipm, r = it - mi * ipm, kb = r / nblk, nb = r - kb * nblk, rd = 32 * nb;
        if (it + NTW < total) TRG_LOAD(vn, it + NTW);
        tr_item<F8>(v, K, F8 ? (bf16*)((unsigned char*)dst + (size_t)mi * K * N) : dst + (size_t)mi * K * N, rd, 64 * kb, scr, lane);
#pragma unroll
        for (int i = 0; i < 8; ++i) v[i] = vn[i];
    }
#undef TRG_LOAD
    it -= total;
}
__device__ __forceinline__ unsigned q8b(float x) { return __float_as_uint(x + 12582912.0f) & 0xffu; }
__device__ __forceinline__ void tr_group_i8(const float* src, unsigned char* dst, float* sBout, int K, int N, int F, int cnt, int& it, int NTW, LAS float* scr, int lane) {
    const int nblk = N / 32, total = cnt * nblk;
    for (; it < total; it += NTW) {
        const int mi = it / nblk, nb = it - mi * nblk, rd = 32 * nb;
        int cs = rd; if (F) { const int j = rd >> 8, w = rd & 255; cs = (w < 128) ? 128 * j + w : F + 128 * j + (w - 128); }
        const float* W = src + (size_t)mi * K * N + cs + 4 * (lane & 7);
        f32x4 mx = (f32x4){0.f, 0.f, 0.f, 0.f};
#pragma unroll 2
        for (int kb = 0; kb < K / 64; ++kb) {
#pragma unroll
            for (int i = 0; i < 8; ++i) { const f32x4 v = *(const GAS f32x4*)(W + (size_t)(64 * kb + 8 * i + (lane >> 3)) * N);
                mx.x = fmaxf(mx.x, fabsf(v.x)); mx.y = fmaxf(mx.y, fabsf(v.y)); mx.z = fmaxf(mx.z, fabsf(v.z)); mx.w = fmaxf(mx.w, fabsf(v.w)); } }
        mx.x = max_x8_16_32(mx.x); mx.y = max_x8_16_32(mx.y); mx.z = max_x8_16_32(mx.z); mx.w = max_x8_16_32(mx.w);
        f32x4 inv, sc;
        inv.x = mx.x > 0.f ? 127.0f / mx.x : 0.f; inv.y = mx.y > 0.f ? 127.0f / mx.y : 0.f; inv.z = mx.z > 0.f ? 127.0f / mx.z : 0.f; inv.w = mx.w > 0.f ? 127.0f / mx.w : 0.f;
        sc = mx * (1.0f / 127.0f);
        if ((lane >> 3) == 0) *(GAS f32x4*)(sBout + (size_t)mi * N + rd + 4 * (lane & 7)) = sc;
        unsigned char* WT = dst + ((size_t)mi * N + rd) * K;
        for (int kb = 0; kb < K / 64; ++kb) {
            f32x4 v[8];
#pragma unroll
            for (int i = 0; i < 8; ++i) v[i] = *(const GAS f32x4*)(W + (size_t)(64 * kb + 8 * i + (lane >> 3)) * N);
#pragma unroll
            for (int i = 0; i < 8; ++i) { LAS float* d = scr + (8 * i + (lane >> 3)) * 33 + 4 * (lane & 7); d[0] = v[i].x * inv.x; d[1] = v[i].y * inv.y; d[2] = v[i].z * inv.z; d[3] = v[i].w * inv.w; }
            LDS_WAIT(); asm volatile("" ::: "memory");
            const int c = lane & 7;
#pragma unroll
            for (int j = 0; j < 4; ++j) { const int n = (lane >> 3) + 8 * j; const LAS float* s = scr + (8 * c) * 33 + n;
                v2u o; o.x = q8b(s[0 * 33]) | (q8b(s[1 * 33]) << 8) | (q8b(s[2 * 33]) << 16) | (q8b(s[3 * 33]) << 24); o.y = q8b(s[4 * 33]) | (q8b(s[5 * 33]) << 8) | (q8b(s[6 * 33]) << 16) | (q8b(s[7 * 33]) << 24);
                *(GAS v2u*)(WT + (size_t)n * K + 64 * kb + 8 * c) = o; }
            LDS_WAIT(); asm volatile("" ::: "memory");
        }
    }
    it -= total;
}
__device__ __forceinline__ void i8_wg_group(const Ctx& C, const float* src, unsigned char* dst, float* sBout, int N, int F, int cnt, int& it, LAS float* scr) {
    constexpr int K = D;
    const int lane = C.lane, nblk = N / 32, total = cnt * nblk;
    LAS float* pmax = (LAS float*)(C.lds + 69632);
#define I8WG_SRC(it_) ([&](int i_) { const int mi_ = i_ / nblk, rd_ = 32 * (i_ - mi_ * nblk); int cs_ = rd_; if (F) { const int j_ = rd_ >> 8, w_ = rd_ & 255; cs_ = (w_ < 128) ? 128 * j_ + w_ : F + 128 * j_ + (w_ - 128); } \
        return src + (size_t)mi_ * K * N + (size_t)(128 * C.wave + (lane >> 3)) * N + cs_ + 4 * (lane & 7); })(it_)
    f32x4 v[16], vn[16];
    if (it < total) { const float* W0 = I8WG_SRC(it);
#pragma unroll
        for (int i = 0; i < 16; ++i) v[i] = *(const GAS f32x4*)(W0 + (size_t)(8 * i) * N); }
    for (; it < total; it += C.G) {
        const int mi = it / nblk, nb = it - mi * nblk, rd = 32 * nb, par = (it / C.G) & 1;
        f32x4 mx = (f32x4){0.f, 0.f, 0.f, 0.f};
#pragma unroll
        for (int i = 0; i < 16; ++i) { mx.x = fmaxf(mx.x, fabsf(v[i].x)); mx.y = fmaxf(mx.y, fabsf(v[i].y)); mx.z = fmaxf(mx.z, fabsf(v[i].z)); mx.w = fmaxf(mx.w, fabsf(v[i].w)); }
        mx.x = max_x8_16_32(mx.x); mx.y = max_x8_16_32(mx.y); mx.z = max_x8_16_32(mx.z); mx.w = max_x8_16_32(mx.w);
        if (lane < 8) *(LAS f32x4*)(pmax + (par * 8 + C.wave) * 32 + 4 * lane) = mx;
        __syncthreads();
        if (it + C.G < total) { const float* Wn = I8WG_SRC(it + C.G);
#pragma unroll
            for (int i = 0; i < 16; ++i) vn[i] = *(const GAS f32x4*)(Wn + (size_t)(8 * i) * N); }
#pragma unroll
        for (int w = 0; w < 8; ++w) { const f32x4 p = *(const LAS f32x4*)(pmax + (par * 8 + w) * 32 + 4 * (lane & 7)); mx.x = fmaxf(mx.x, p.x); mx.y = fmaxf(mx.y, p.y); mx.z = fmaxf(mx.z, p.z); mx.w = fmaxf(mx.w, p.w); }
        f32x4 inv;
        inv.x = mx.x > 0.f ? 127.0f / mx.x : 0.f; inv.y = mx.y > 0.f ? 127.0f / mx.y : 0.f; inv.z = mx.z > 0.f ? 127.0f / mx.z : 0.f; inv.w = mx.w > 0.f ? 127.0f / mx.w : 0.f;
        if (C.wave == 0 && lane < 8) *(GAS f32x4*)(sBout + (size_t)mi * N + rd + 4 * lane) = mx * (1.0f / 127.0f);
        unsigned char* WT = dst + ((size_t)mi * N + rd) * K + 128 * C.wave;
#pragma unroll
        for (int hf = 0; hf < 2; ++hf) {
#pragma unroll
            for (int i = 0; i < 8; ++i) { LAS float* d = scr + (8 * i + (lane >> 3)) * 33 + 4 * (lane & 7); const f32x4 x = v[8 * hf + i]; d[0] = x.x * inv.x; d[1] = x.y * inv.y; d[2] = x.z * inv.z; d[3] = x.w * inv.w; }
            LDS_WAIT(); asm volatile("" ::: "memory");
            const int c = lane & 7;
#pragma unroll
            for (int j = 0; j < 4; ++j) { const int n = (lane >> 3) + 8 * j; const LAS float* sp = scr + (8 * c) * 33 + n;
                v2u o; o.x = q8b(sp[0 * 33]) | (q8b(sp[1 * 33]) << 8) | (q8b(sp[2 * 33]) << 16) | (q8b(sp[3 * 33]) << 24); o.y = q8b(sp[4 * 33]) | (q8b(sp[5 * 33]) << 8) | (q8b(sp[6 * 33]) << 16) | (q8b(sp[7 * 33]) << 24);
                *(GAS v2u*)(WT + (size_t)n * K + 64 * hf + 8 * c) = o; }
            LDS_WAIT(); asm volatile("" ::: "memory");
        }
#pragma unroll
        for (int i = 0; i < 16; ++i) v[i] = vn[i];
    }
#undef I8WG_SRC
    it -= total;
}
__device__ __forceinline__ void gemv_mod(const Ctx& C, int w) {
    const float* Wm; const float* bias; int N, j0, ooff;
    if (w < 192) { const int l = w / 48, cb = w % 48; Wm = inp(C, IN_MODW) + (size_t)l * D * MODW; bias = inp(C, IN_MODB) + l * MODW; N = MODW; j0 = 128 * cb; ooff = l * MODW + j0; }
    else { const int cb = w - 192; Wm = inp(C, IN_KVMW); bias = inp(C, IN_KVMB); N = 2 * D; j0 = 128 * cb; ooff = KVMOD + j0; }
    const LAS f32x4* tab = (const LAS f32x4*)(C.lds + 65536) + 2 * 128 * C.wave;
    const GAS f32x2* wp = (const GAS f32x2*)(Wm + (size_t)(128 * C.wave) * N + j0) + C.lane;
    const size_t rs = (size_t)(N / 2);
    float a0[8], a1[8];
#pragma unroll
    for (int b = 0; b < 8; ++b) { a0[b] = 0.f; a1[b] = 0.f; }
#pragma unroll 16
    for (int k = 0; k < 128; ++k) {
        const f32x2 wv = wp[(size_t)k * rs]; const f32x4 s0 = tab[2 * k], s1 = tab[2 * k + 1];
        a0[0] += s0.x * wv.x; a1[0] += s0.x * wv.y; a0[1] += s0.y * wv.x; a1[1] += s0.y * wv.y; a0[2] += s0.z * wv.x; a1[2] += s0.z * wv.y; a0[3] += s0.w * wv.x; a1[3] += s0.w * wv.y;
        a0[4] += s1.x * wv.x; a1[4] += s1.x * wv.y; a0[5] += s1.y * wv.x; a1[5] += s1.y * wv.y; a0[6] += s1.z * wv.x; a1[6] += s1.z * wv.y; a0[7] += s1.w * wv.x; a1[7] += s1.w * wv.y;
    }
    LAS float* part = (LAS float*)(C.lds + 98304);
#pragma unroll
    for (int b = 0; b < 8; ++b) *(LAS f32x2*)(part + (C.wave * 8 + b) * 128 + 2 * C.lane) = (f32x2){a0[b], a1[b]};
    __syncthreads();
    float* mod = (float*)(wsp(C) + WS_MOD);
#pragma unroll
    for (int j = 0; j < 2; ++j) { const int idx = C.tid + 512 * j, b = idx >> 7, col = idx & 127; float s = bias[j0 + col];
#pragma unroll
        for (int ww = 0; ww < 8; ++ww) s += part[(ww * 8 + b) * 128 + col];
        mod[(size_t)b * MODLD + ooff + col] = s; }
    __syncthreads();
}
__device__ __forceinline__ void p0_prologue(const Ctx& C0) {
    const Ctx C = phase_ctx(C0);
    const int wg = (int)blockIdx.x;
    if (wg < 208) {
        LAS float* tab = (LAS float*)(C.lds + 65536);
        for (int idx = C.tid; idx < NB * D; idx += NWAVES * 64) { const int b = idx >> 10, k = idx & 1023; const float v = inp(C, IN_C)[idx]; tab[k * 8 + b] = v / (1.0f + __expf(-v)); }
        __syncthreads();
        gemv_mod(C, wg);
    } else if (wg < 224 && C.wave == 7) {
        const int h = wg - 208; float* bt = (float*)(wsp(C) + WS_BIAS) + h * 1024;
        for (int i = 0; i < 16; ++i) { const int d = C.lane + 64 * i; int bk;
            if (d < 16) bk = d; else { bk = 16 + (int)(logf((float)d / 16.0f) / 4.1588830833596715f * 16.0f); bk = bk > 31 ? 31 : bk; }
            bt[d] = inp(C, IN_RELB)[bk * NH + h] * LOG2E; }
    }
    {
        LAS float* scr = (LAS float*)(C.lds + C.wave * 8704);
        unsigned char* ws = wsp(C);
        int itg = wg;
        i8_wg_group(C, inp(C, IN_MW13), ws + WS_MW13, (float*)(ws + WS_SBM13), 2 * FFE, FFE, 16, itg, scr);
        i8_wg_group(C, inp(C, IN_W13), ws + WS_W13, (float*)(ws + WS_SB13), 2 * FF, FF, 2, itg, scr);
        i8_wg_group(C, inp(C, IN_AWQKV), ws + WS_WQKV, (float*)(ws + WS_SBQKV), 3 * D, 0, 2, itg, scr);
        i8_wg_group(C, inp(C, IN_BWKV), ws + WS_WKV, (float*)(ws + WS_SBKV), 2 * D, 0, 1, itg, scr);
        i8_wg_group(C, inp(C, IN_BWQ), ws + WS_WQ, (float*)(ws + WS_SBQ), D, 0, 2, itg, scr);
        int it = wg * NWAVES + C.wave; const int NTW = C.G * NWAVES;
        tr_group<true>(inp(C, IN_MW2), (bf16*)(ws + WS_MW2), FFE, D, 0, 16, it, NTW, scr, C.lane);
        tr_group<true>(inp(C, IN_W2), (bf16*)(ws + WS_W2), FF, D, 0, 2, it, NTW, scr, C.lane);
        tr_group<true>(inp(C, IN_AWO), (bf16*)(ws + WS_WO), D, D, 0, 2, it, NTW, scr, C.lane);
        tr_group<true>(inp(C, IN_BWO), (bf16*)(ws + WS_WBO), D, D, 0, 2, it, NTW, scr, C.lane);
    }
}

__device__ __forceinline__ void tail_row(v2u (&y)[4], const unsigned char* ws, int ts, int lane) {
    f32x4 p[TAIL_NS][4];
#pragma unroll
    for (int k = 0; k < TAIL_NS; ++k)
#pragma unroll
        for (int j = 0; j < 4; ++j) p[k][j] = ((const GAS f32x4*)((const float*)(ws + WS_YT) + ((size_t)k * TAIL_ROWS + ts) * D) + lane)[64 * j];
#pragma unroll
    for (int j = 0; j < 4; ++j) { f32x4 a = p[0][j];
#pragma unroll
        for (int k = 1; k < TAIL_NS; ++k) a += p[k][j];
        y[j] = (v2u){pk2(a.x, a.y), pk2(a.z, a.w)}; }
}
template <bool COMBINE, bool KV2, bool ROUTER, bool FINAL, bool F8OUT = false, bool XIN_F32 = false>
__device__ __forceinline__ void token_phase(const Ctx& C0, const void* xin, void* xout, const float* gnorm, int off_sh, int off_sc, bf16* XNo, int off_gf, const float* router) {
    const Ctx C = phase_ctx(C0);
    const int gw = C.vcu * NWAVES + C.wave, r0 = gw * 16, b = r0 >> 12, lane = C.lane;
    unsigned char* const ws = wsp(C);
    const float* modb = (const float*)(ws + WS_MOD) + (size_t)b * MODLD;
    const float* kvng = KV2 ? inp(C, IN_KVNG) : nullptr;
    f32x4 A[4], Bv[4], A2[4], B2[4], GF[4];
#pragma unroll
    for (int j = 0; j < 4; ++j) { const int col = 256 * j + 4 * lane;
        const f32x4 g = *(const f32x4*)(gnorm + col);
        if (FINAL) { A[j] = g; Bv[j] = (f32x4){0.f, 0.f, 0.f, 0.f}; }
        else { const f32x4 sc = *(const f32x4*)(modb + off_sc + col); A[j] = g * (sc + 1.0f); Bv[j] = *(const f32x4*)(modb + off_sh + col); }
        if (KV2) { const f32x4 g2 = *(const f32x4*)(kvng + col), sc2 = *(const f32x4*)(modb + KVMOD + D + col); A2[j] = g2 * (sc2 + 1.0f); B2[j] = *(const f32x4*)(modb + KVMOD + col); }
        if (COMBINE) GF[j] = *(const f32x4*)(modb + off_gf + col);
    }
    LAS int* rt = (LAS int*)(C.lds + ROUTE_OFF);
    if (ROUTER) {
        LAS float* rw = (LAS float*)C.lds;
        for (int i = C.tid; i < D * NE; i += NWAVES * 64) rw[i] = router[i];
        if (C.tid < 8) rt[RT_HIST + C.tid] = 0;
        if (C.tid < MAXTILES) ((int*)(ws + WS_TOKOF))[C.vcu * MAXTILES + C.tid] = 0;
        __syncthreads();
    }
    int cnt[8];
#pragma unroll
    for (int e = 0; e < 8; ++e) cnt[e] = 0;
    const bf16* Y2 = (const bf16*)(ws + WS_XG);
    const int* tslot = (const int*)(ws + WS_TOKS); const float* tw = (const float*)(ws + WS_TOKW);
    constexpr int RG = 4;
    for (int i0 = 0; i0 < 16; i0 += RG) {
      f32x4 vin[RG][4]; v2u ya_[RG][4], yc_[RG][4]; float w0_[RG], w1_[RG]; int sl0_[RG], sl1_[RG];
#pragma unroll
      for (int rr = 0; rr < RG; ++rr) { const int row = r0 + i0 + rr;
        if (XIN_F32) { const GAS f32x4* xr = (const GAS f32x4*)((const float*)xin + (size_t)row * D) + lane;
#pragma unroll
            for (int j = 0; j < 4; ++j) vin[rr][j] = xr[64 * j];
        } else { const GAS v2u* xr = (const GAS v2u*)((const bf16*)xin + (size_t)row * D) + lane;
#pragma unroll
            for (int j = 0; j < 4; ++j) { const v2u w = xr[64 * j]; vin[rr][j] = (f32x4){bflo(w.x), bfhi(w.x), bflo(w.y), bfhi(w.y)}; } }
        if (COMBINE) {
            const int s0 = tslot[2 * row], s1 = tslot[2 * row + 1]; w0_[rr] = tw[2 * row]; w1_[rr] = tw[2 * row + 1]; sl0_[rr] = __builtin_amdgcn_readfirstlane(s0); sl1_[rr] = __builtin_amdgcn_readfirstlane(s1);
            const GAS v2u* y0 = (const GAS v2u*)(Y2 + (size_t)(s0 < 65536 ? s0 : 0) * D) + lane; const GAS v2u* y1 = (const GAS v2u*)(Y2 + (size_t)(s1 < 65536 ? s1 : 0) * D) + lane;
#pragma unroll
            for (int j = 0; j < 4; ++j) { ya_[rr][j] = y0[64 * j]; yc_[rr][j] = y1[64 * j]; } } }
      if (COMBINE) {
        int anyt = 0;
#pragma unroll
        for (int rr = 0; rr < RG; ++rr) anyt |= (sl0_[rr] | sl1_[rr]) >> 16;
        if (anyt) {
#pragma unroll
            for (int rr = 0; rr < RG; ++rr) {
                if (sl0_[rr] >= 65536) { tail_row(ya_[rr], ws, sl0_[rr] - 65536, lane); asm volatile("" ::: "memory"); }
                if (sl1_[rr] >= 65536) { tail_row(yc_[rr], ws, sl1_[rr] - 65536, lane); asm volatile("" ::: "memory"); } } } }
#pragma unroll
      for (int rr = 0; rr < RG; ++rr) {
        const int row = r0 + i0 + rr;
        f32x4 v[4];
#pragma unroll
        for (int j = 0; j < 4; ++j) v[j] = vin[rr][j];
        if (COMBINE) {
#pragma unroll
            for (int j = 0; j < 4; ++j) { const v2u a = ya_[rr][j], c = yc_[rr][j];
                f32x4 ya = (f32x4){bflo(a.x), bfhi(a.x), bflo(a.y), bfhi(a.y)}, yc = (f32x4){bflo(c.x), bfhi(c.x), bflo(c.y), bfhi(c.y)};
                v[j] = v[j] + GF[j] * (ya * w0_[rr] + yc * w1_[rr]); }
            if (!FINAL) { GAS v2u* xo = (GAS v2u*)((bf16*)xout + (size_t)row * D) + lane;
#pragma unroll
                for (int j = 0; j < 4; ++j) xo[64 * j] = (v2u){pk2(v[j].x, v[j].y), pk2(v[j].z, v[j].w)}; }
        }
        float ss = 0.f;
#pragma unroll
        for (int j = 0; j < 4; ++j) ss += (v[j].x * v[j].x + v[j].y * v[j].y) + (v[j].z * v[j].z + v[j].w * v[j].w);
        const float rstd = 1.0f / sqrtf(wave_sum(ss) * (1.0f / D) + RMS_EPS);
        f32x4 hv[4];
#pragma unroll
        for (int j = 0; j < 4; ++j) hv[j] = (v[j] * rstd) * A[j] + Bv[j];
        if (FINAL) { GAS f32x4* xo = (GAS f32x4*)((float*)xout + (size_t)row * D) + lane;
#pragma unroll
            for (int j = 0; j < 4; ++j) xo[64 * j] = hv[j];
        } else if (F8OUT) { GAS unsigned* o4 = (GAS unsigned*)((unsigned char*)XNo + (size_t)row * D) + lane;
            float am = 0.f;
#pragma unroll
            for (int j = 0; j < 4; ++j) am = fmaxf(am, fmaxf(fmaxf(fabsf(hv[j].x), fabsf(hv[j].y)), fmaxf(fabsf(hv[j].z), fabsf(hv[j].w))));
            am = wave_max(am); const float inv = am > 0.f ? 127.0f / am : 0.f;
            if (lane == 0) ((float*)(ws + WS_SA))[row] = am * (1.0f / 127.0f);
#pragma unroll
            for (int j = 0; j < 4; ++j) o4[64 * j] = q8b(hv[j].x * inv) | (q8b(hv[j].y * inv) << 8) | (q8b(hv[j].z * inv) << 16) | (q8b(hv[j].w * inv) << 24);
        } else { GAS v2u* o8 = (GAS v2u*)(XNo + (size_t)row * D) + lane;
#pragma unroll
            for (int j = 0; j < 4; ++j) o8[64 * j] = (v2u){pk2(hv[j].x, hv[j].y), pk2(hv[j].z, hv[j].w)}; }
        if (KV2) { GAS unsigned* o4 = (GAS unsigned*)(ws + WS_XN2 + (size_t)row * D) + lane; f32x4 h2[4]; float am = 0.f;
#pragma unroll
            for (int j = 0; j < 4; ++j) { h2[j] = (v[j] * rstd) * A2[j] + B2[j]; am = fmaxf(am, fmaxf(fmaxf(fabsf(h2[j].x), fabsf(h2[j].y)), fmaxf(fabsf(h2[j].z), fabsf(h2[j].w)))); }
            am = wave_max(am); const float inv = am > 0.f ? 127.0f / am : 0.f;
            if (lane == 0) ((float*)(ws + WS_SA2))[row] = am * (1.0f / 127.0f);
#pragma unroll
            for (int j = 0; j < 4; ++j) o4[64 * j] = q8b(h2[j].x * inv) | (q8b(h2[j].y * inv) << 8) | (q8b(h2[j].z * inv) << 16) | (q8b(h2[j].w * inv) << 24); }
        if (ROUTER) {
            const LAS f32x4* rw = (const LAS f32x4*)C.lds;
            f32x4 p0 = (f32x4){0.f, 0.f, 0.f, 0.f}, p1 = p0;
#pragma unroll
            for (int j = 0; j < 4; ++j) { const int col = 256 * j + 4 * lane;
                p0 += rw[2 * col + 0] * hv[j].x; p1 += rw[2 * col + 1] * hv[j].x; p0 += rw[2 * col + 2] * hv[j].y; p1 += rw[2 * col + 3] * hv[j].y;
                p0 += rw[2 * col + 4] * hv[j].z; p1 += rw[2 * col + 5] * hv[j].z; p0 += rw[2 * col + 6] * hv[j].w; p1 += rw[2 * col + 7] * hv[j].w; }
            float p[8] = {wave_sum(p0.x), wave_sum(p0.y), wave_sum(p0.z), wave_sum(p0.w), wave_sum(p1.x), wave_sum(p1.y), wave_sum(p1.z), wave_sum(p1.w)};
            int e0 = 0; float v0 = p[0];
#pragma unroll
            for (int e = 1; e < 8; ++e) if (p[e] > v0) { v0 = p[e]; e0 = e; }
            int e1 = 0; float v1 = -INFINITY;
#pragma unroll
            for (int e = 0; e < 8; ++e) if (e != e0 && p[e] > v1) { v1 = p[e]; e1 = e; }
            const float w0 = 1.0f / (1.0f + __expf(v1 - v0)), w1 = 1.0f - w0;
            if (lane == 0) { ((int*)(ws + WS_TOKE))[row] = e0 | (e1 << 8); *(f32x2*)((float*)(ws + WS_TOKW) + 2 * row) = (f32x2){w0, w1}; }
#pragma unroll
            for (int e = 0; e < 8; ++e) cnt[e] += (e == e0 || e == e1) ? 1 : 0;
        }
      }
    }
    if (ROUTER) {
        if (lane == 0) {
#pragma unroll
            for (int e = 0; e < 8; ++e) __hip_atomic_fetch_add(rt + RT_HIST + e, cnt[e], __ATOMIC_RELAXED, __HIP_MEMORY_SCOPE_WORKGROUP);
        }
        __syncthreads();
        if (C.tid < 8) ((int*)(ws + WS_HIST))[C.vcu * 8 + C.tid] = rt[RT_HIST + C.tid];
    }
}

__device__ __forceinline__ void route_phase(const Ctx& C0, const bf16* XN) {
    const Ctx C = phase_ctx(C0);
    LAS int* rt = (LAS int*)(C.lds + ROUTE_OFF);
    unsigned char* const ws = wsp(C);
    const int* hist = (const int*)(ws + WS_HIST);
    { const int e = C.wave; int tot = 0, pre = 0;
#pragma unroll
      for (int i = 0; i < 4; ++i) { const int wg = C.lane + 64 * i; const int v = hist[wg * 8 + e]; tot += v; pre += (wg < C.vcu) ? v : 0; }
      tot = wave_isum(tot); pre = wave_isum(pre);
      if (C.lane == 0) { rt[RT_CNT + e] = tot; rt[RT_BASE + e] = pre; } }
    __syncthreads();
    { int tp[9]; tp[0] = 0;
#pragma unroll
        for (int e = 0; e < 8; ++e) tp[e + 1] = tp[e] + ((rt[RT_CNT + e] + 255) >> 8);
        if (C.tid < 9) { int v = 0;
#pragma unroll
            for (int e = 0; e < 9; ++e) v = (C.tid == e) ? tp[e] : v;
            rt[RT_SEG + C.tid] = v * 256; }
        if (C.tid == 9) rt[RT_NT] = tp[8] < MAXTILES ? tp[8] : MAXTILES;
        if (C.tid < MAXTILES && C.tid < tp[8]) { int e = 0;
#pragma unroll
            for (int k = 1; k < 8; ++k) e += (C.tid >= tp[k]) ? 1 : 0;
            rt[RT_TEXP + C.tid] = e; } }
    __syncthreads();
    const int tok = 128 * C.vcu + (C.tid & 127);
    int e0 = -1, e1 = -1; if (C.tid < 128) { const int ee = ((const int*)(ws + WS_TOKE))[tok]; e0 = ee & 255; e1 = ee >> 8; }
    unsigned long long bal[8];
#pragma unroll
    for (int e = 0; e < 8; ++e) bal[e] = __ballot((e0 == e) || (e1 == e));
    if (C.tid == 0) {
#pragma unroll
        for (int e = 0; e < 8; ++e) rt[RT_WC + e] = __popcll(bal[e]);
    }
    __syncthreads();
    if (C.tid < 128) { int s0 = 0, s1 = 0; const unsigned long long lt = (1ull << C.lane) - 1ull;
#pragma unroll
        for (int e = 0; e < 8; ++e) { const int slot = rt[RT_SEG + e] + rt[RT_BASE + e] + __popcll(bal[e] & lt) + (C.wave == 1 ? rt[RT_WC + e] : 0); if (e0 == e) s0 = slot; if (e1 == e) s1 = slot; }
        ((int*)(ws + WS_TOKS))[2 * tok] = s0; ((int*)(ws + WS_TOKS))[2 * tok + 1] = s1; rt[RT_LS + 2 * C.tid] = s0; rt[RT_LS + 2 * C.tid + 1] = s1;
        ((int*)(ws + WS_TOKOF))[s0] = tok; ((int*)(ws + WS_TOKOF))[s1] = tok; }
    __syncthreads();
    bf16* XG = (bf16*)(ws + WS_XG);
    float sav = 0.f;
    if (C.lane < 16) sav = ((const GAS float*)(ws + WS_SA))[128 * C.vcu + 16 * C.wave + C.lane];
    if (C.lane < 16) { const int tl = 16 * C.wave + C.lane; ((GAS float*)(ws + WS_SAG))[rt[RT_LS + 2 * tl]] = sav; ((GAS float*)(ws + WS_SAG))[rt[RT_LS + 2 * tl + 1]] = sav; }
}

__device__ __forceinline__ void kmean_phase(const Ctx& C0, const bf16* Kb) {
    const Ctx C = phase_ctx(C0);
    const int gw = C.vcu * NWAVES + C.wave;
    if (gw < 1024) { const int cb = gw & 7, n = (gw >> 3) & 15, b = gw >> 7;
        const GAS unsigned* kp = (const GAS unsigned*)(Kb + ((size_t)(b * SEQ + 256 * n)) * D + 128 * cb) + C.lane; float s0 = 0.f, s1 = 0.f;
#pragma unroll 16
        for (int i = 0; i < 256; ++i) { const unsigned w = kp[(size_t)i * (D / 2)]; s0 += bflo(w); s1 += bfhi(w); }
        const int col = 128 * cb + 2 * C.lane, h = col >> 6, d = col & 63;
        float* km = (float*)(wsp(C) + WS_KMEAN) + ((size_t)((b * NH + h) * 16 + n)) * 64 + d; km[0] = s0 * (1.f / 256.f); km[1] = s1 * (1.f / 256.f); }
}


namespace att {
typedef short bf16x8 __attribute__((ext_vector_type(8)));
typedef float f32x16 __attribute__((ext_vector_type(16)));
typedef short v4i16_t __attribute__((ext_vector_type(4)));
__device__ __forceinline__ unsigned cvtpk(float lo, float hi) { typedef float f2 __attribute__((ext_vector_type(2))); typedef __bf16 b2 __attribute__((ext_vector_type(2))); const f2 v = {lo, hi}; const b2 b = __builtin_convertvector(v, b2); return __builtin_bit_cast(unsigned, b); }
__device__ __forceinline__ float swap32(float x, int hi) { auto rr = __builtin_amdgcn_permlane32_swap(__float_as_uint(x), __float_as_uint(x), false, false); return __uint_as_float(hi ? rr[0] : rr[1]); }
__device__ __forceinline__ void dma_k_piece(const bf16* Kh, int kv0, int piece, LAS unsigned char* kslot, int lane) {
    const int row = 8 * piece + (lane >> 3);
    const bf16* src = Kh + (size_t)(kv0 + row) * D + ((lane & 7) ^ ((row >> 1) & 7)) * 8;
    __builtin_amdgcn_global_load_lds((const unsigned*)src, (LAS unsigned*)(kslot + piece * 1024), 16, 0, 0); }
__device__ __forceinline__ void dma_v_piece(const bf16* Vh, int kv0, int piece, LAS unsigned char* vslot, int lane) {
    const int row = 8 * piece + (lane >> 3);
    const bf16* src = Vh + (size_t)(kv0 + row) * D + ((lane & 7) ^ (((row >> 1) & 1) << 2)) * 8;
    __builtin_amdgcn_global_load_lds((const unsigned*)src, (LAS unsigned*)(vslot + piece * 1024), 16, 0, 0); }
__device__ __forceinline__ int kfrag_off(int d0, int r32, int hi) { return 128 * r32 + 16 * ((2 * d0 + hi) ^ ((r32 >> 1) & 7)); }
__device__ __forceinline__ void qkt(f32x16& p0, f32x16& p1, const LAS unsigned char* kslot, const bf16x8 (&qr)[4], int r32, int hi) {
    p0 = (f32x16){0.f, 0.f, 0.f, 0.f, 0.f, 0.f, 0.f, 0.f, 0.f, 0.f, 0.f, 0.f, 0.f, 0.f, 0.f, 0.f}; p1 = p0;
    bf16x8 kf[8];
#pragma unroll
    for (int d0 = 0; d0 < 4; ++d0) { const LAS unsigned char* kb = kslot + kfrag_off(d0, r32, hi); kf[2 * d0] = *(const LAS bf16x8*)(kb); kf[2 * d0 + 1] = *(const LAS bf16x8*)(kb + 4096); }
#pragma unroll
    for (int d0 = 0; d0 < 4; ++d0) { p0 = __builtin_amdgcn_mfma_f32_32x32x16_bf16(kf[2 * d0], qr[d0], p0, 0, 0, 0); p1 = __builtin_amdgcn_mfma_f32_32x32x16_bf16(kf[2 * d0 + 1], qr[d0], p1, 0, 0, 0); }
}
__device__ __forceinline__ v4i16_t vtr(const LAS unsigned char* p) { return __builtin_amdgcn_ds_read_tr16_b64_v4i16((LAS v4i16_t*)p); }
__device__ __forceinline__ void pvt(f32x16 (&o)[2], const LAS unsigned char* vslot, int lane, const v4u (&pw)[4]) {
    const int r = (lane & 15) >> 2, f = (r >> 1) & 1;
    const LAS unsigned char* vb0 = vslot + (4 * (lane >> 5) + r) * 128 + f * 64 + ((lane >> 4) & 1) * 32 + (lane & 3) * 8;
    const LAS unsigned char* vb1 = vslot + (4 * (lane >> 5) + r) * 128 + (f ^ 1) * 64 + ((lane >> 4) & 1) * 32 + (lane & 3) * 8;
    v4i16_t lo[8], hh[8];
#pragma unroll
    for (int i = 0; i < 4; ++i) { lo[i] = vtr(vb0 + i * 2048); hh[i] = vtr(vb0 + i * 2048 + 1024); lo[4 + i] = vtr(vb1 + i * 2048); hh[4 + i] = vtr(vb1 + i * 2048 + 1024); }
#pragma unroll
    for (int i = 0; i < 8; ++i) { const bf16x8 vf = (bf16x8){lo[i][0], lo[i][1], lo[i][2], lo[i][3], hh[i][0], hh[i][1], hh[i][2], hh[i][3]};
        o[i >> 2] = __builtin_amdgcn_mfma_f32_32x32x16_bf16(vf, __builtin_bit_cast(bf16x8, pw[i & 3]), o[i >> 2], 0, 0, 0); }
}
__device__ __forceinline__ void pack_p(v4u (&pw)[4], const f32x16& p0, const f32x16& p1) {
#pragma unroll
    for (int i = 0; i < 4; ++i) { pw[0][i] = cvtpk(p0[2 * i], p0[2 * i + 1]); pw[1][i] = cvtpk(p0[8 + 2 * i], p0[9 + 2 * i]); pw[2][i] = cvtpk(p1[2 * i], p1[2 * i + 1]); pw[3][i] = cvtpk(p1[8 + 2 * i], p1[9 + 2 * i]); }
}
__device__ __forceinline__ void store_o(bf16* Orow  , const f32x16 (&o)[2], float scale, int hi) {
#pragma unroll
    for (int dh = 0; dh < 2; ++dh)
#pragma unroll
        for (int gp = 0; gp < 2; ++gp) { float na[4], nb[4];
#pragma unroll
            for (int e = 0; e < 4; ++e) { auto rr = __builtin_amdgcn_permlane32_swap(__float_as_uint(o[dh][8 * gp + e] * scale), __float_as_uint(o[dh][8 * gp + 4 + e] * scale), false, false); na[e] = __uint_as_float(rr[0]); nb[e] = __uint_as_float(rr[1]); }
            const v4u w = (v4u){cvtpk(na[0], na[1]), cvtpk(na[2], na[3]), cvtpk(nb[0], nb[1]), cvtpk(nb[2], nb[3])};
            *(GAS v4u*)(Orow + 32 * dh + 8 * (2 * gp + hi)) = w; }
}
constexpr int BT_DMAX = 1119, BT_LEN = BT_DMAX + 1 + BT_PAD, BT_CS = 1424;
static_assert(BT_CS >= BT_LEN + 4 && BT_CS % 64 == 16, "bias table copies");
__device__ __forceinline__ const LAS float* bias_ptr(const LAS float* bt, int qrow, int hi, int tile) {
    const int jb = BT_DMAX - qrow + 64 * tile + 4 * hi, m = jb & 3, jc = jb > m ? jb : m;
    return bt + m * BT_CS - m + jc; }
__device__ __forceinline__ void store_o8(unsigned char* Orow  , const f32x16 (&o)[2], float scale, int hi) {
#pragma unroll
    for (int dh = 0; dh < 2; ++dh)
#pragma unroll
        for (int gp = 0; gp < 2; ++gp) { float na[4], nb[4];
#pragma unroll
            for (int e = 0; e < 4; ++e) { auto rr = __builtin_amdgcn_permlane32_swap(__float_as_uint(o[dh][8 * gp + e] * scale), __float_as_uint(o[dh][8 * gp + 4 + e] * scale), false, false); na[e] = __uint_as_float(rr[0]); nb[e] = __uint_as_float(rr[1]); }
            const v2u w = (v2u){pg8::pk4_fp8(na[0], na[1], na[2], na[3]), pg8::pk4_fp8(nb[0], nb[1], nb[2], nb[3])};
            *(GAS v2u*)(Orow + 32 * dh + 8 * (2 * gp + hi)) = w; }
}
}

#define MOBA_WAITBAR(N) do { if (!(VAR & 1)) asm volatile("s_waitcnt vmcnt(" #N ") lgkmcnt(0)\n\ts_barrier" ::: "memory"); } while (0)
__device__ __forceinline__ float vmax3(float a, float b, float c) { float r; asm("v_max3_f32 %0, %1, %2, %3" : "=v"(r) : "v"(a), "v"(b), "v"(c)); return r; }
__device__ __forceinline__ float vadd(float a, float b) { float r; asm("v_add_f32_e32 %0, %1, %2" : "=v"(r) : "v"(a), "v"(b)); return r; }
__device__ __forceinline__ float vmax(float a, float b) { float r; asm("v_max_f32_e32 %0, %1, %2" : "=v"(r) : "v"(a), "v"(b)); return r; }
__device__ __forceinline__ float vmul(float a, float b) { float r; asm("v_mul_f32_e32 %0, %1, %2" : "=v"(r) : "v"(a), "v"(b)); return r; }
#define MSB() __builtin_amdgcn_sched_barrier(0)
#define ME4(X, i) do { if (VAR & 8) break; X[i] = ex2(X[i]); X[(i) + 1] = ex2(X[(i) + 1]); X[(i) + 2] = ex2(X[(i) + 2]); X[(i) + 3] = ex2(X[(i) + 3]); } while (0)
#define MC2(W, j, X, i) do { if (VAR & 8) break; W[j] = att::cvtpk(X[i], X[(i) + 1]); W[(j) + 1] = att::cvtpk(X[(i) + 2], X[(i) + 3]); } while (0)
#define MMF(a, b, c) ((VAR & 4) ? (c) : __builtin_amdgcn_mfma_f32_32x32x16_bf16(a, b, c, 0, 0, 0))
template <int VAR>
__device__ __forceinline__ void moba_step(att::f32x16& A0, att::f32x16& A1, att::f32x16& B0, att::f32x16& B1, int s, int NT, int u, int wid, int lane, int qrow, unsigned selmask,
                                          float& mref, float& l, att::f32x16 (&o)[2], const LAS unsigned char* lds, const LAS float* bt, const att::bf16x8 (&qr)[4], att::bf16x8 (&kf)[8]) {
    const int r32 = lane & 31, hi = lane >> 5;
    const int s1 = (s + 1 < NT) ? s + 1 : s;
    const int t1 = (s1 < 4) ? 4 * u + s1 : s1 - 4;
    const bool mine = (s1 < 4) ? (2 * s1 <= wid) : (((selmask >> (t1 >> 2)) & 1u) != 0u);
    const unsigned q0w = hi ? 0u : (mine ? (__float_as_uint(-mref) >> 16) : 0xFF80u), k0w = hi ? 0u : 0x3F80u;
    const att::bf16x8 qaug = __builtin_bit_cast(att::bf16x8, (v4u){q0w, 0u, 0u, 0u}), kone = __builtin_bit_cast(att::bf16x8, (v4u){k0w, 0u, 0u, 0u});
    const LAS unsigned char* vsl = lds + (s % 5) * 16384 + 8192;
    const int s2 = (s + 2 < NT) ? s + 2 : NT - 1, t2 = (s2 < 4) ? 4 * u + s2 : s2 - 4;
    const LAS unsigned char* ksl2 = lds + (s2 % 5) * 16384;
    const LAS float* bp2 = att::bias_ptr(bt, qrow, hi, t2); asm volatile("" : "+v"(bp2));
#define MBL(g) do { const f32x4 x0_ = *(const LAS f32x4*)(bp2 + 8 * (g)), x1_ = *(const LAS f32x4*)(bp2 + 32 + 8 * (g)); \
        A0[4 * (g)] = x0_.x; A0[4 * (g) + 1] = x0_.y; A0[4 * (g) + 2] = x0_.z; A0[4 * (g) + 3] = x0_.w; A1[4 * (g)] = x1_.x; A1[4 * (g) + 1] = x1_.y; A1[4 * (g) + 2] = x1_.z; A1[4 * (g) + 3] = x1_.w; } while (0)
#define MKL(d0) do { const LAS unsigned char* kb_ = ksl2 + att::kfrag_off(d0, r32, hi); kf[2 * (d0)] = *(const LAS att::bf16x8*)(kb_); kf[2 * (d0) + 1] = *(const LAS att::bf16x8*)(kb_ + 4096); } while (0)
    const int vr = (lane & 15) >> 2, vf_ = (vr >> 1) & 1;
    const LAS unsigned char* vb0 = vsl + (4 * hi + vr) * 128 + vf_ * 64 + ((lane >> 4) & 1) * 32 + (lane & 3) * 8;
    const LAS unsigned char* vb1 = vsl + (4 * hi + vr) * 128 + (vf_ ^ 1) * 64 + ((lane >> 4) & 1) * 32 + (lane & 3) * 8;
    asm volatile("" : "+v"(vb0), "+v"(vb1));
    att::v4i16_t lo[8], hh[8]; v4u pw[4];
    MSB();
    B0 = MMF(kf[0], qr[0], B0); ME4(A0, 0);  MC2(pw[0], 0, A0, 0);  MSB();
    B1 = MMF(kf[1], qr[0], B1); ME4(A0, 4);  MC2(pw[0], 2, A0, 4);  MSB();
    B0 = MMF(kf[2], qr[1], B0); ME4(A0, 8);  MC2(pw[1], 0, A0, 8);  MSB();
    B1 = MMF(kf[3], qr[1], B1); ME4(A0, 12); MC2(pw[1], 2, A0, 12); MSB();
    B0 = MMF(kf[4], qr[2], B0); ME4(A1, 0);  MC2(pw[2], 0, A1, 0);  lo[0] = att::vtr(vb0); hh[0] = att::vtr(vb0 + 1024); lo[1] = att::vtr(vb0 + 2048); hh[1] = att::vtr(vb0 + 3072); MSB();
    B1 = MMF(kf[5], qr[2], B1); ME4(A1, 4);  MC2(pw[2], 2, A1, 4);  lo[2] = att::vtr(vb0 + 4096); hh[2] = att::vtr(vb0 + 5120); lo[3] = att::vtr(vb0 + 6144); hh[3] = att::vtr(vb0 + 7168); MSB();
    B0 = MMF(kf[6], qr[3], B0); ME4(A1, 8);  MC2(pw[3], 0, A1, 8);  lo[4] = att::vtr(vb1); hh[4] = att::vtr(vb1 + 1024); lo[5] = att::vtr(vb1 + 2048); hh[5] = att::vtr(vb1 + 3072); MSB();
    B1 = MMF(kf[7], qr[3], B1); ME4(A1, 12); MC2(pw[3], 2, A1, 12); lo[6] = att::vtr(vb1 + 4096); hh[6] = att::vtr(vb1 + 5120); lo[7] = att::vtr(vb1 + 6144); hh[7] = att::vtr(vb1 + 7168); MSB();
    B0 = MMF(kone, qaug, B0); MSB();
    B1 = MMF(kone, qaug, B1); MSB();
#define MVF(i) (att::bf16x8){lo[i][0], lo[i][1], lo[i][2], lo[i][3], hh[i][0], hh[i][1], hh[i][2], hh[i][3]}
#define MPW(k) __builtin_bit_cast(att::bf16x8, pw[k])
    float la, lb, lc, ld, ma, mb, mc, md;
    o[0] = MMF(MVF(0), MPW(0), o[0]); la = vadd(A0[0], A0[1]); lb = vadd(A1[0], A1[1]); lc = vadd(A0[2], A0[3]); ld = vadd(A1[2], A1[3]); la = vadd(la, A0[4]); lb = vadd(lb, A1[4]); MSB();
    o[0] = MMF(MVF(1), MPW(1), o[0]); lc = vadd(lc, A0[5]); ld = vadd(ld, A1[5]); la = vadd(la, A0[6]); lb = vadd(lb, A1[6]); lc = vadd(lc, A0[7]); ld = vadd(ld, A1[7]); la = vadd(la, A0[8]); lb = vadd(lb, A1[8]); MSB();
    o[0] = MMF(MVF(2), MPW(2), o[0]); lc = vadd(lc, A0[9]); ld = vadd(ld, A1[9]); la = vadd(la, A0[10]); lb = vadd(lb, A1[10]); lc = vadd(lc, A0[11]); ld = vadd(ld, A1[11]); la = vadd(la, A0[12]); lb = vadd(lb, A1[12]); MSB();
    o[0] = MMF(MVF(3), MPW(3), o[0]); lc = vadd(lc, A0[13]); ld = vadd(ld, A1[13]); la = vadd(la, A0[14]); lb = vadd(lb, A1[14]); lc = vadd(lc, A0[15]); ld = vadd(ld, A1[15]); la = vadd(la, lc); lb = vadd(lb, ld); MSB();
    o[1] = MMF(MVF(4), MPW(0), o[1]); MKL(0); MBL(0); ma = vmax3(B0[0], B0[1], B0[2]); mb = vmax3(B1[0], B1[1], B1[2]); mc = vmax3(B0[3], B0[4], B0[5]); md = vmax3(B1[3], B1[4], B1[5]); MSB();
    o[1] = MMF(MVF(5), MPW(1), o[1]); MKL(1); MBL(1); ma = vmax3(ma, B0[6], B0[7]); mb = vmax3(mb, B1[6], B1[7]); mc = vmax3(mc, B0[8], B0[9]); md = vmax3(md, B1[8], B1[9]); MSB();
    o[1] = MMF(MVF(6), MPW(2), o[1]); MKL(2); MBL(2); ma = vmax3(ma, B0[10], B0[11]); mb = vmax3(mb, B1[10], B1[11]); mc = vmax3(mc, B0[12], B0[13]); md = vmax3(md, B1[12], B1[13]); MSB();
    o[1] = MMF(MVF(7), MPW(3), o[1]); MKL(3); MBL(3); ma = vmax3(ma, B0[14], B0[15]); mb = vmax3(mb, B1[14], B1[15]); ma = vmax3(ma, mc, md); MSB();
#undef MVF
#undef MPW
#undef MBL
#undef MKL
    l += vadd(la, lb);
    float mx = vmax(ma, mb); mx = vmax(mx, att::swap32(mx, hi));
    const bool mv = mx > 8.0f;
    if (__any(mv)) {
        const float nref = mv ? __uint_as_float((__float_as_uint(mref + mx) + 0x8000u) & 0xffff0000u) : mref, d = nref - mref, f = ex2(-d); mref = nref; l *= f;
#pragma unroll
        for (int r = 0; r < 16; ++r) { o[0][r] *= f; o[1][r] *= f; B0[r] -= d; B1[r] -= d; } }
}
template <int VAR>
__device__ __forceinline__ void moba_phase(const Ctx& C0, const bf16* Q, const bf16* Kb, const bf16* Vb, bf16* O) {
    const Ctx C = phase_ctx(C0);
    const int lane = C.lane, r32 = lane & 31, hi = lane >> 5, wid = C.wave;
    unsigned char* const ws = wsp(C);
    const float* kmean = (const float*)(ws + WS_KMEAN); const float* btab = (const float*)(ws + WS_BIAS);
    LAS unsigned char* lds = C.lds;
    LAS float* bt = (LAS float*)(lds + 81920);
    const int bh = C.vcu >> 1, b = bh >> 4, h = bh & 15;
    for (int i = C.tid; i < 4 * att::BT_CS; i += NWAVES * 64) { const int m = i / att::BT_CS, j = i - m * att::BT_CS + m, d = att::BT_DMAX - j;
        bt[i] = (j >= att::BT_LEN || d < 0) ? -INFINITY : btab[h * 1024 + (d > 1023 ? 1023 : d)]; }
    const bf16* Kh = Kb + (size_t)b * SEQ * D + h * HD; const bf16* Vh = Vb + (size_t)b * SEQ * D + h * HD;
    LAS float* kml = (LAS float*)(lds + 81920 + 4 * att::BT_CS * 4);
#pragma unroll 1
    for (int nn = 0; nn < 2; ++nn) { const int n = 2 * wid + nn; const GAS v4u* kp = (const GAS v4u*)(Kh + (size_t)(256 * n + (lane >> 3)) * D) + (lane & 7); float sk[8];
#pragma unroll
        for (int j = 0; j < 8; ++j) sk[j] = 0.f;
#pragma unroll 16
        for (int i = 0; i < 32; ++i) { const v4u w = kp[(size_t)i * (8 * D / 8)];
            sk[0] += bflo(w.x); sk[1] += bfhi(w.x); sk[2] += bflo(w.y); sk[3] += bfhi(w.y); sk[4] += bflo(w.z); sk[5] += bfhi(w.z); sk[6] += bflo(w.w); sk[7] += bfhi(w.w); }
#pragma unroll
        for (int j = 0; j < 8; ++j) { float t = sk[j]; t += dppf<DPP_X8>(t); sk[j] = sum32x(sum16x(t)); }
        if (lane < 8) {
#pragma unroll
            for (int j = 0; j < 8; ++j) kml[n * 64 + 8 * lane + j] = sk[j] * (1.f / 256.f); } }
    __syncthreads();
    for (int iu = 0; iu < 8; ++iu) {
        const int sidx0 = 4 * (C.vcu & 1) + (iu >> 1), u = (iu & 1) ? 15 - sidx0 : sidx0;
        const int qrow = 256 * u + 32 * wid + r32, tok = b * SEQ + qrow;
#define MOBA_TILE(s) (((s) < 4) ? 4 * u + (s) : (s) - 4)
#define MOBA_DMA(s) do { if (VAR & 2) break; const int t_ = MOBA_TILE(s); att::dma_k_piece(Kh, 64 * t_, wid, lds + ((s) % 5) * 16384, lane); att::dma_v_piece(Vh, 64 * t_, wid, lds + ((s) % 5) * 16384 + 8192, lane); } while (0)
        MOBA_DMA(0); MOBA_DMA(1); MOBA_DMA(2); MOBA_DMA(3);
        att::bf16x8 qr[4];
#pragma unroll
        for (int d0 = 0; d0 < 4; ++d0) qr[d0] = *(const GAS att::bf16x8*)(Q + (size_t)tok * D + h * HD + d0 * 16 + hi * 8);
        unsigned selmask = 0;
        if (u <= 3) selmask = (1u << u) - 1u;
        else {
            const LAS float* km = kml + 8 * hi;
            float g[15];
#pragma unroll
            for (int n = 0; n < 15; ++n) {
                if (n < u) { float s = 0.f;
#pragma unroll
                    for (int d0 = 0; d0 < 4; ++d0) { const f32x4 a = *(const LAS f32x4*)(km + n * 64 + 16 * d0), c = *(const LAS f32x4*)(km + n * 64 + 16 * d0 + 4);
                        s += __uint_as_float((unsigned)(unsigned short)qr[d0][0] << 16) * a.x; s += __uint_as_float((unsigned)(unsigned short)qr[d0][1] << 16) * a.y;
                        s += __uint_as_float((unsigned)(unsigned short)qr[d0][2] << 16) * a.z; s += __uint_as_float((unsigned)(unsigned short)qr[d0][3] << 16) * a.w;
                        s += __uint_as_float((unsigned)(unsigned short)qr[d0][4] << 16) * c.x; s += __uint_as_float((unsigned)(unsigned short)qr[d0][5] << 16) * c.y;
                        s += __uint_as_float((unsigned)(unsigned short)qr[d0][6] << 16) * c.z; s += __uint_as_float((unsigned)(unsigned short)qr[d0][7] << 16) * c.w; }
                    g[n] = s + att::swap32(s, hi);
                } else g[n] = -INFINITY;
            }
#pragma unroll
            for (int r = 0; r < 3; ++r) { float best = -INFINITY; int bi = 0;
#pragma unroll
                for (int n = 0; n < 15; ++n) if (!((selmask >> n) & 1u) && g[n] > best) { best = g[n]; bi = n; }
                selmask |= 1u << bi; }
        }
        const int NT = 4 * u + 4;
        float mref = 0.f, l = 0.f; att::f32x16 o[2];
#pragma unroll
        for (int r = 0; r < 16; ++r) { o[0][r] = 0.f; o[1][r] = 0.f; }
        att::f32x16 a0, a1, b0, b1;
        att::bf16x8 kfn[8];
        MOBA_WAITBAR(4);
        {
            const LAS float* bp = att::bias_ptr(bt, qrow, hi, 4 * u); asm volatile("" : "+v"(bp));
#pragma unroll
            for (int g = 0; g < 4; ++g) { const f32x4 x0 = *(const LAS f32x4*)(bp + 8 * g), x1 = *(const LAS f32x4*)(bp + 32 + 8 * g);
                a0[4 * g] = x0.x; a0[4 * g + 1] = x0.y; a0[4 * g + 2] = x0.z; a0[4 * g + 3] = x0.w; a1[4 * g] = x1.x; a1[4 * g + 1] = x1.y; a1[4 * g + 2] = x1.z; a1[4 * g + 3] = x1.w; }
            att::bf16x8 kf[8];
#pragma unroll
            for (int d0 = 0; d0 < 4; ++d0) { const LAS unsigned char* kb = lds + att::kfrag_off(d0, r32, hi); kf[2 * d0] = *(const LAS att::bf16x8*)(kb); kf[2 * d0 + 1] = *(const LAS att::bf16x8*)(kb + 4096); }
#pragma unroll
            for (int d0 = 0; d0 < 4; ++d0) { a0 = MMF(kf[2 * d0], qr[d0], a0); a1 = MMF(kf[2 * d0 + 1], qr[d0], a1); }
            float mx = fmaxf(a0[0], a1[0]);
#pragma unroll
            for (int r = 1; r < 16; ++r) mx = fmaxf(mx, fmaxf(a0[r], a1[r]));
            mx = fmaxf(mx, att::swap32(mx, hi));
            mref = __uint_as_float((__float_as_uint(mx) + 0x8000u) & 0xffff0000u);
#pragma unroll
            for (int r = 0; r < 16; ++r) { a0[r] -= mref; a1[r] -= mref; }
            MSB();
            const LAS float* bq = att::bias_ptr(bt, qrow, hi, 4 * u + 1); asm volatile("" : "+v"(bq));
#pragma unroll
            for (int g = 0; g < 4; ++g) { const f32x4 x0 = *(const LAS f32x4*)(bq + 8 * g), x1 = *(const LAS f32x4*)(bq + 32 + 8 * g);
                b0[4 * g] = x0.x; b0[4 * g + 1] = x0.y; b0[4 * g + 2] = x0.z; b0[4 * g + 3] = x0.w; b1[4 * g] = x1.x; b1[4 * g + 1] = x1.y; b1[4 * g + 2] = x1.z; b1[4 * g + 3] = x1.w; }
#pragma unroll
            for (int d0 = 0; d0 < 4; ++d0) { const LAS unsigned char* kb = lds + 16384 + att::kfrag_off(d0, r32, hi); kfn[2 * d0] = *(const LAS att::bf16x8*)(kb); kfn[2 * d0 + 1] = *(const LAS att::bf16x8*)(kb + 4096); }
        }
        for (int s = 0; s < NT; s += 2) {
            if (s + 3 < NT) MOBA_WAITBAR(2); else MOBA_WAITBAR(0);
            if (s + 4 < NT) MOBA_DMA(s + 4);
            moba_step<VAR>(a0, a1, b0, b1, s, NT, u, wid, lane, qrow, selmask, mref, l, o, lds, bt, qr, kfn);
            if (s + 4 < NT) MOBA_WAITBAR(2); else MOBA_WAITBAR(0);
            if (s + 5 < NT) MOBA_DMA(s + 5);
            moba_step<VAR>(b0, b1, a0, a1, s + 1, NT, u, wid, lane, qrow, selmask, mref, l, o, lds, bt, qr, kfn);
        }
        l += att::swap32(l, hi);
        att::store_o8((unsigned char*)O + (size_t)tok * D + h * HD, o, OSCALE8 / l, hi);
        MOBA_WAITBAR(0);
    }
#undef MOBA_TILE
#undef MOBA_DMA
}

template <int SVAR>
__device__ __forceinline__ void sb_phase(const Ctx& C0, const bf16* Q, const bf16* Kb, const bf16* Vb, bf16* O) {
    const Ctx C = phase_ctx(C0);
    const int lane = C.lane, r32 = lane & 31, hi = lane >> 5, wid = C.wave;
    LAS unsigned char* wbuf = C.lds + wid * 16384;
    const int gw = C.vcu * NWAVES + wid;
    const int vr = (lane & 15) >> 2, vf_ = (vr >> 1) & 1;
    const int voff0 = (4 * hi + vr) * 128 + vf_ * 64 + ((lane >> 4) & 1) * 32 + (lane & 3) * 8, voff1 = (4 * hi + vr) * 128 + (vf_ ^ 1) * 64 + ((lane >> 4) & 1) * 32 + (lane & 3) * 8;
    for (int iu = 0; iu < 8; ++iu) {
        const int U = (C.vcu * 8 + iu) * NWAVES + wid, bh = U >> 7, qt = U & 127, b = bh >> 4, h = bh & 15;
        const int t = 32 * qt + r32, tok = b * SEQ + t;
        const bf16* Kh = Kb + (size_t)b * SEQ * D + h * HD; const bf16* Vh = Vb + (size_t)b * SEQ * D + h * HD;
#define SB_DMA(tk_, p_) do { _Pragma("unroll") for (int pc = 0; pc < 4; ++pc) att::dma_k_piece(Kh, 32 * (tk_), pc, wbuf + (p_) * 8192, lane); \
                             _Pragma("unroll") for (int pc = 0; pc < 4; ++pc) att::dma_v_piece(Vh, 32 * (tk_), pc, wbuf + (p_) * 8192 + 4096, lane); } while (0)
        asm volatile("s_waitcnt lgkmcnt(0)" ::: "memory");
        SB_DMA(qt, 0);
        att::bf16x8 qr[4];
#pragma unroll
        for (int d0 = 0; d0 < 4; ++d0) qr[d0] = *(const GAS att::bf16x8*)(Q + (size_t)tok * D + h * HD + d0 * 16 + hi * 8);
        float L = 1.f; att::f32x16 o[2];
#pragma unroll
        for (int r = 0; r < 16; ++r) { o[0][r] = 0.f; o[1][r] = 0.f; }
        int p = 0;
        for (int tk = qt; tk >= 0; --tk) {
            if (tk > 0) { asm volatile("s_waitcnt lgkmcnt(0)" ::: "memory"); SB_DMA(tk - 1, p ^ 1); asm volatile("s_waitcnt vmcnt(8)" ::: "memory"); }
            else asm volatile("s_waitcnt vmcnt(0)" ::: "memory");
            const LAS unsigned char* kslot = wbuf + p * 8192; const LAS unsigned char* vslot = kslot + 4096;
            att::bf16x8 kf[4];
#pragma unroll
            for (int d0 = 0; d0 < 4; ++d0) kf[d0] = *(const LAS att::bf16x8*)(kslot + att::kfrag_off(d0, r32, hi));
            att::f32x16 z;
#pragma unroll
            for (int r = 0; r < 16; ++r) z[r] = 0.f;
#pragma unroll
            for (int d0 = 0; d0 < 4; ++d0) z = __builtin_amdgcn_mfma_f32_32x32x16_bf16(kf[d0], qr[d0], z, 0, 0, 0);
            att::f32x16 s;
#pragma unroll
            for (int r = 0; r < 16; ++r) { const float e = ex2(z[r]); s[r] = __builtin_amdgcn_rcpf(1.0f + e); z[r] = 1.0f - s[r]; }
            if (tk == qt) { const int lim = r32 - 4 * hi;
#pragma unroll
                for (int r = 0; r < 16; ++r) { const int ko = (r & 3) + 8 * (r >> 2); if (!(ko < lim)) { s[r] = 1.f; z[r] = 0.f; } } }
            __builtin_amdgcn_sched_barrier(0);
            float Gs[4], E[4], T[4], EG[4];
#pragma unroll
            for (int gq = 0; gq < 4; ++gq) Gs[gq] = vmul(vmul(s[4 * gq], s[4 * gq + 1]), vmul(s[4 * gq + 2], s[4 * gq + 3]));
            E[3] = 1.f; E[2] = Gs[3]; E[1] = vmul(E[2], Gs[2]); E[0] = vmul(E[1], Gs[1]);
            EG[3] = Gs[3]; EG[2] = E[1]; EG[1] = E[0]; EG[0] = vmul(E[0], Gs[0]);
#pragma unroll
            for (int gq = 0; gq < 3; ++gq) T[gq] = vmul(E[gq], att::swap32(hi ? EG[gq] : E[gq], hi));
            T[3] = att::swap32(hi ? EG[3] : 1.f, hi);
            const float own = EG[0], tot = vmul(own, att::swap32(own, hi));
#pragma unroll
            for (int gq = 0; gq < 4; ++gq) { const float b3 = vmul(L, T[gq]), b2 = vmul(b3, s[4 * gq + 3]), b1 = vmul(b2, s[4 * gq + 2]), b0 = vmul(b1, s[4 * gq + 1]);
                z[4 * gq + 3] = vmul(z[4 * gq + 3], b3); z[4 * gq + 2] = vmul(z[4 * gq + 2], b2); z[4 * gq + 1] = vmul(z[4 * gq + 1], b1); z[4 * gq] = vmul(z[4 * gq], b0); }
            L = vmul(L, tot);
            v4u pw0, pw1;
#pragma unroll
            for (int i = 0; i < 4; ++i) { pw0[i] = att::cvtpk(z[2 * i], z[2 * i + 1]); pw1[i] = att::cvtpk(z[8 + 2 * i], z[9 + 2 * i]); }
            { const att::v4i16_t l00 = att::vtr(vslot + voff0), h00 = att::vtr(vslot + voff0 + 1024), l01 = att::vtr(vslot + voff0 + 2048), h01 = att::vtr(vslot + voff0 + 3072);
              const att::v4i16_t l10 = att::vtr(vslot + voff1), h10 = att::vtr(vslot + voff1 + 1024), l11 = att::vtr(vslot + voff1 + 2048), h11 = att::vtr(vslot + voff1 + 3072);
#define SB_VF(lo_, hh_) (att::bf16x8){lo_[0], lo_[1], lo_[2], lo_[3], hh_[0], hh_[1], hh_[2], hh_[3]}
              o[0] = __builtin_amdgcn_mfma_f32_32x32x16_bf16(SB_VF(l00, h00), __builtin_bit_cast(att::bf16x8, pw0), o[0], 0, 0, 0);
              o[0] = __builtin_amdgcn_mfma_f32_32x32x16_bf16(SB_VF(l01, h01), __builtin_bit_cast(att::bf16x8, pw1), o[0], 0, 0, 0);
              o[1] = __builtin_amdgcn_mfma_f32_32x32x16_bf16(SB_VF(l10, h10), __builtin_bit_cast(att::bf16x8, pw0), o[1], 0, 0, 0);
              o[1] = __builtin_amdgcn_mfma_f32_32x32x16_bf16(SB_VF(l11, h11), __builtin_bit_cast(att::bf16x8, pw1), o[1], 0, 0, 0);
#undef SB_VF
            }
            if (!__any(L >= 7.5e-37f)) break;
            p ^= 1;
        }
        att::store_o8((unsigned char*)O + (size_t)tok * D + h * HD, o, OSCALE8, hi);
#undef SB_DMA
    }
}

__device__ __forceinline__ float dot64(const v4u (&q)[8], const GAS v4u* kr) { float s = 0.f;
#pragma unroll
    for (int i = 0; i < 8; ++i) { const v4u k = kr[i];
        s += bflo(q[i].x) * bflo(k.x); s += bfhi(q[i].x) * bfhi(k.x); s += bflo(q[i].y) * bflo(k.y); s += bfhi(q[i].y) * bfhi(k.y);
        s += bflo(q[i].z) * bflo(k.z); s += bfhi(q[i].z) * bfhi(k.z); s += bflo(q[i].w) * bflo(k.w); s += bfhi(q[i].w) * bfhi(k.w); }
    return s; }
__device__ __forceinline__ void moba_naive(const Ctx& C0, const bf16* Q, const bf16* Kb, const bf16* Vb, bf16* O) {
    const Ctx C = phase_ctx(C0);
    LAS float* sc = (LAS float*)(C.lds + C.wave * 4096);
    const float* kmean = (const float*)(wsp(C) + WS_KMEAN); const float* btab = (const float*)(wsp(C) + WS_BIAS);
    const int gw = C.vcu * NWAVES + C.wave, lane = C.lane;
    for (int ip = 0; ip < 256; ++ip) {
        const int p = gw * 256 + ip, tok = p >> 4, h = p & 15, b = tok >> 12, qpos = tok & 4095, u = qpos >> 8;
        const bf16* qp = Q + (size_t)tok * D + h * HD;
        v4u qv[8];
#pragma unroll
        for (int i = 0; i < 8; ++i) qv[i] = ((const GAS v4u*)qp)[i];
        const float qd = __uint_as_float((unsigned)qp[lane] << 16);
        const float* km = kmean + (size_t)((b * NH + h) * 16) * 64 + lane;
        float g[15];
#pragma unroll
        for (int n = 0; n < 15; ++n) g[n] = (n < u) ? wave_sum(qd * km[n * 64]) : -INFINITY;
        unsigned mask = 0;
        if (u <= 3) mask = (1u << u) - 1u;
        else {
#pragma unroll
            for (int r = 0; r < 3; ++r) { float best = -INFINITY; int bi = 0;
#pragma unroll
                for (int n = 0; n < 15; ++n) if (!((mask >> n) & 1u) && g[n] > best) { best = g[n]; bi = n; }
                mask |= 1u << bi; }
        }
        mask |= 1u << u;
        const float* bt = btab + h * 1024;
        float mx = -INFINITY; int ns = 0;
        for (int n = 0; n <= u; ++n) { if (!((mask >> n) & 1u)) continue;
            for (int c4 = 0; c4 < 4; ++c4) { const int kpos = 256 * n + 64 * c4 + lane; const int dist = qpos - kpos;
                float s = dot64(qv, (const GAS v4u*)(Kb + (size_t)(b * SEQ + kpos) * D + h * HD));
                s += bt[dist < 0 ? 0 : (dist > 1023 ? 1023 : dist)];
                if (dist < 0) s = -INFINITY;
                sc[ns * 256 + 64 * c4 + lane] = s; mx = fmaxf(mx, s); }
            ++ns; }
        mx = wave_max(mx);
        LDS_WAIT(); asm volatile("" ::: "memory");
        float l = 0.f;
        for (int i = 0; i < ns * 4; ++i) { const float pz = ex2(sc[64 * i + lane] - mx); sc[64 * i + lane] = pz; l += pz; }
        l = wave_sum(l);
        LDS_WAIT(); asm volatile("" ::: "memory");
        float o = 0.f; int n2 = 0;
        for (int n = 0; n <= u; ++n) { if (!((mask >> n) & 1u)) continue;
            const bf16* vp = Vb + (size_t)(b * SEQ + 256 * n) * D + h * HD + lane;
#pragma unroll 8
            for (int i = 0; i < 256; ++i) o += sc[n2 * 256 + i] * __uint_as_float((unsigned)vp[(size_t)i * D] << 16);
            ++n2; }
        LDS_WAIT(); asm volatile("" ::: "memory");
        O[(size_t)tok * D + h * HD + lane] = (bf16)f2bf(o / l);
    }
}
__device__ __forceinline__ void sb_naive(const Ctx& C0, const bf16* Q, const bf16* Kb, const bf16* Vb, bf16* O) {
    const Ctx C = phase_ctx(C0);
    LAS float* sc = (LAS float*)(C.lds + C.wave * 4096);
    const int gw = C.vcu * NWAVES + C.wave, lane = C.lane;
    for (int ip = 0; ip < 256; ++ip) {
        const int p = gw * 256 + ip, tok = p >> 4, h = p & 15, b = tok >> 12, t = tok & 4095;
        const bf16* qp = Q + (size_t)tok * D + h * HD;
        v4u qv[8];
#pragma unroll
        for (int i = 0; i < 8; ++i) qv[i] = ((const GAS v4u*)qp)[i];
        float L = 0.f, o = 0.f;
        for (int c = (t - 1) >> 6; c >= 0; --c) {
            const int j = 64 * c + lane; const bool valid = j < t;
            const float z = dot64(qv, (const GAS v4u*)(Kb + (size_t)(b * SEQ + j) * D + h * HD));
            const float sp = valid ? (fmaxf(z, 0.f) + lg2(1.0f + ex2(-fabsf(z)))) : 0.f;
            float incl = sp;
#pragma unroll
            for (int off = 1; off < 64; off <<= 1) { const float tmp = __shfl_down(incl, off); if (lane + off < 64) incl += tmp; }
            const float excl = incl - sp;
            const float a = valid ? ex2(z - sp + L - excl) : 0.f;
            L -= __shfl(incl, 0);
            sc[lane] = a;
            LDS_WAIT(); asm volatile("" ::: "memory");
            const bf16* vp = Vb + (size_t)(b * SEQ + 64 * c) * D + h * HD + lane;
#pragma unroll 8
            for (int i = 0; i < 64; ++i) o += sc[i] * __uint_as_float((unsigned)vp[(size_t)i * D] << 16);
            LDS_WAIT(); asm volatile("" ::: "memory");
            if (L < -120.0f) break;
        }
        O[(size_t)tok * D + h * HD + lane] = (bf16)f2bf(o);
    }
}

#ifndef DUP_GEMM
#define DUP_GEMM 0
#endif
#ifndef DUP_ATT
#define DUP_ATT 0
#endif
#ifndef DUP_TOK
#define DUP_TOK 0
#endif
#ifndef DUP_MISC
#define DUP_MISC 0
#endif
#ifndef DUP_PRO
#define DUP_PRO 0
#endif
#ifndef SB_VAR
#define SB_VAR 0
#endif
#ifndef MOBA_VAR
#define MOBA_VAR 0
#endif
#ifndef NAIVE_MOBA
#define NAIVE_MOBA 0
#endif
#ifndef NAIVE_SB
#define NAIVE_SB 0
#endif
#ifndef DUP_BAR
#define DUP_BAR 0
#endif
#define GRID_BAR() do { xcd_barrier(bar); if (DUP_BAR) xcd_barrier(bar); } while (0)
#define LOCAL_BAR() do { if (reg32) xcd_barrier_local(bar); else xcd_barrier(bar); } while (0)
#define WSB(off) ((bf16*)(ws + (off)))
template <int l>
__device__ __forceinline__ void layer_body(const Ctx& C, const XcdBarrier& bar, LAS unsigned char* ring, const LAS int* rt, const int G, const int bx, const bool reg32) {
        if (l == 2) { void* xo = wsp(C) + WS_XBF; token_phase<true, true, false, false, true>(C, xo, xo, inp(C, IN_NMIX) + l * D, l * MODW + 0 * D, l * MODW + 1 * D, (bf16*)(wsp(C) + WS_XN), (l - 1) * MODW + 5 * D, nullptr); }
        else if (l == 0) token_phase<false, false, false, false, true, true>(C, inp(C, IN_X), nullptr, inp(C, IN_NMIX) + l * D, l * MODW + 0 * D, l * MODW + 1 * D, (bf16*)(wsp(C) + WS_XN), 0, nullptr);
        else token_phase<false, false, false, false, true>(C, wsp(C) + WS_XBF, nullptr, inp(C, IN_NMIX) + l * D, l * MODW + 0 * D, l * MODW + 1 * D, (bf16*)(wsp(C) + WS_XN), 0, nullptr);
        if (l == 2) GRID_BAR(); else LOCAL_BAR();
        if (l < 2) {
            { unsigned char* ws = wsp(C); pg8::Gemm g{WSB(WS_XN), (const bf16*)(ws + WS_WQKV + (size_t)l * 3 * D * D), NTOK, 3 * D, D / 2}; pg8::ScaleStage<pg8::StaticOrder> S; S.init(NTOK, 3 * D, G, bx); S.sA = (const float*)(ws + WS_SA); S.sB = (const float*)(ws + WS_SBQKV) + (size_t)l * 3 * D; S.buf = ring + SCALEBUF_OFF; S.cnt = 0;
              pg8::EpiBf16I8 E{WSB(WS_Q), D, D, (size_t)(WS_K - WS_Q) / 2, QSCALE, ring + SCALEBUF_OFF, 0};
              pg8::gemm_phase<pg8::EpiBf16I8, pg8::ScaleStage<pg8::StaticOrder>, true, true, 2>(ring, g, S, E); }
            LOCAL_BAR();
            { unsigned char* ws = wsp(C); if (NAIVE_MOBA) moba_naive(C, WSB(WS_Q), WSB(WS_K), WSB(WS_V), WSB(WS_Q)); else { if (DUP_ATT & 1) moba_phase<MOBA_VAR>(C, WSB(WS_Q), WSB(WS_K), WSB(WS_V), WSB(WS_HID)); moba_phase<0>(C, WSB(WS_Q), WSB(WS_K), WSB(WS_V), WSB(WS_HID)); } }
        } else {
            if (l == 2) { unsigned char* ws = wsp(C); pg8::Gemm g{WSB(WS_XN2), (const bf16*)(ws + WS_WKV), NTOK, 2 * D, D / 2}; pg8::ScaleStage<pg8::StaticOrder> S; S.init(NTOK, 2 * D, G, bx); S.sA = (const float*)(ws + WS_SA2); S.sB = (const float*)(ws + WS_SBKV); S.buf = ring + SCALEBUF_OFF; S.cnt = 0;
              pg8::EpiBf16I8 E{WSB(WS_KSH), D, D, (size_t)(WS_VSH - WS_KSH) / 2, 1.0f, ring + SCALEBUF_OFF, 0};
              pg8::gemm_phase<pg8::EpiBf16I8, pg8::ScaleStage<pg8::StaticOrder>, true, true, 2>(ring, g, S, E); }
            { unsigned char* ws = wsp(C); pg8::Gemm g{WSB(WS_XN), (const bf16*)(ws + WS_WQ + (size_t)(l - 2) * D * D), NTOK, D, D / 2}; pg8::ScaleStage<pg8::StaticOrder> S; S.init(NTOK, D, G, bx); S.sA = (const float*)(ws + WS_SA); S.sB = (const float*)(ws + WS_SBQ) + (size_t)(l - 2) * D; S.buf = ring + SCALEBUF_OFF; S.cnt = 0;
              pg8::EpiBf16I8 E{WSB(WS_Q), D, D, 0, QSCALE, ring + SCALEBUF_OFF, 0};
              pg8::gemm_phase<pg8::EpiBf16I8, pg8::ScaleStage<pg8::StaticOrder>, true, true, 2>(ring, g, S, E); }
            LOCAL_BAR();
            { unsigned char* ws = wsp(C); if (NAIVE_SB) sb_naive(C, WSB(WS_Q), WSB(WS_KSH), WSB(WS_VSH), WSB(WS_Q)); else { if (DUP_ATT & 2) sb_phase<SB_VAR>(C, WSB(WS_Q), WSB(WS_KSH), WSB(WS_VSH), WSB(WS_HID)); sb_phase<0>(C, WSB(WS_Q), WSB(WS_KSH), WSB(WS_VSH), WSB(WS_HID)); } }
        }
        LOCAL_BAR();
        { unsigned char* ws = wsp(C);
          const bf16* wo = (const bf16*)((l < 2) ? ws + WS_WO + (size_t)l * D * D : ws + WS_WBO + (size_t)(l - 2) * D * D);
          pg8::Gemm g{WSB(WS_HID), wo, NTOK, D, D / 2}; pg8::StaticOrder S; S.init(NTOK, D, G, bx);
          if (l == 0) { pg8::EpiResidB<true> E{inp(C, IN_X), WSB(WS_XBF), (const float*)(ws + WS_MOD) + l * MODW + 2 * D, MODLD, 1.0f / (OSCALE8 * WSCALE8)};
              pg8::gemm_phase<pg8::EpiResidB<true>, pg8::StaticOrder, true, true, 1>(ring, g, S, E); }
          else { pg8::EpiResidB<false> E{WSB(WS_XBF), WSB(WS_XBF), (const float*)(ws + WS_MOD) + l * MODW + 2 * D, MODLD, 1.0f / (OSCALE8 * WSCALE8)};
              pg8::gemm_phase<pg8::EpiResidB<false>, pg8::StaticOrder, true, true, 1>(ring, g, S, E); } }
        LOCAL_BAR();
        if (l & 1) token_phase<false, false, true, false, true>(C, wsp(C) + WS_XBF, nullptr, inp(C, IN_NFFN) + l * D, l * MODW + 3 * D, l * MODW + 4 * D, (bf16*)(wsp(C) + WS_XN), 0, inp(C, IN_RW) + (size_t)(l >> 1) * D * NE);
        else token_phase<false, false, false, false, true>(C, wsp(C) + WS_XBF, nullptr, inp(C, IN_NFFN) + l * D, l * MODW + 3 * D, l * MODW + 4 * D, (bf16*)(wsp(C) + WS_XN), 0, nullptr);
        if (l & 1) GRID_BAR(); else LOCAL_BAR();
        if (!(l & 1)) {
            { unsigned char* ws = wsp(C); pg8::Gemm g{WSB(WS_XN), (const bf16*)(ws + WS_W13 + (size_t)(l >> 1) * 2 * FF * D), NTOK, 2 * FF, D / 2}; pg8::ScaleStage<pg8::StaticOrder> S; S.init(NTOK, 2 * FF, G, bx); S.sA = (const float*)(ws + WS_SA); S.sB = (const float*)(ws + WS_SB13) + (size_t)(l >> 1) * 2 * FF; S.buf = ring + SCALEBUF_OFF; S.cnt = 0;
              pg8::EpiSwiGluI8 E{ws + WS_HID, FF, 2 * FF / 256, ring + SCALEBUF_OFF, HSCALE8, 0};
              pg8::gemm_phase<pg8::EpiSwiGluI8, pg8::ScaleStage<pg8::StaticOrder>, true, true, 2>(ring, g, S, E); }
            LOCAL_BAR();
            { unsigned char* ws = wsp(C); pg8::Gemm g{WSB(WS_HID), (const bf16*)(ws + WS_W2 + (size_t)(l >> 1) * D * FF), NTOK, D, FF / 2}; pg8::StaticOrder S; S.init(NTOK, D, G, bx);
              pg8::EpiResidB<false> E{WSB(WS_XBF), WSB(WS_XBF), (const float*)(ws + WS_MOD) + l * MODW + 5 * D, MODLD, 1.0f / (HSCALE8 * WSCALE8)};
              pg8::gemm_phase<pg8::EpiResidB<false>, pg8::StaticOrder, true, true, 1>(ring, g, S, E); }
            LOCAL_BAR();
        } else {
            for (int dup = 0; dup <= DUP_MISC; ++dup) { if (dup) __syncthreads(); route_phase(C, (const bf16*)(wsp(C) + WS_XN)); }
            GRID_BAR();
            const int ntiles = __builtin_amdgcn_readfirstlane(rt[RT_NT]);
            { unsigned char* ws = wsp(C); pg8::Gemm g{WSB(WS_XN), (const bf16*)(ws + WS_MW13 + (size_t)(l >> 1) * NE * 2 * FFE * D), MAXTILES * 256, 2 * FFE, D / 2}; pg8::ScaleStage<pg8::MoeGatherOrder> S; S.init(ntiles, 2 * FFE / 256, G, bx, rt + RT_TEXP); S.tokof = (const int*)(ws + WS_TOKOF); S.sA = (const float*)(ws + WS_SAG); S.sB = (const float*)(ws + WS_SBM13) + (size_t)(l >> 1) * NE * 2 * FFE; S.buf = ring + SCALEBUF_OFF; S.cnt = 0;
              pg8::EpiSwiGluI8 E{ws + WS_HID, FFE, 2 * FFE / 256, ring + SCALEBUF_OFF, HSCALE8, 0};
              pg8::gemm_phase<pg8::EpiSwiGluI8, pg8::ScaleStage<pg8::MoeGatherOrder>, true, true, 2>(ring, g, S, E); }
            GRID_BAR();
            { unsigned char* ws = wsp(C); pg8::Gemm g{WSB(WS_HID), (const bf16*)(ws + WS_MW2 + (size_t)(l >> 1) * NE * D * FFE), MAXTILES * 256, D, FFE / 2, 0}; pg8::MoeOrder S; S.init(ntiles < 256 ? ntiles : 256, D / 256, G, bx, rt + RT_TEXP);
              pg8::EpiBf16 E{WSB(WS_XG), D, 0, 0, 1.0f, D / 256, 1.0f / (HSCALE8 * WSCALE8)};
              pg8::gemm_phase<pg8::EpiBf16, pg8::MoeOrder, true, true, 1>(ring, g, S, E); }
            if (ntiles > 256) { unsigned char* ws = wsp(C); pg8::Gemm g{WSB(WS_HID), (const bf16*)(ws + WS_MW2 + (size_t)(l >> 1) * NE * D * FFE), MAXTILES * 256, D, FFE / 2 / TAIL_NS, FFE / 2}; pg8::TailOrder S; S.init(ntiles - 256, D / 256, TAIL_NS, G, bx, rt + RT_TEXP);
              pg8::EpiPlaneF32 E{(float*)(ws + WS_YT), D / 256, 1.0f / (HSCALE8 * WSCALE8), (size_t)TAIL_ROWS * D};
              pg8::gemm_phase<pg8::EpiPlaneF32, pg8::TailOrder, true, true, 1>(ring, g, S, E); }
            GRID_BAR();
        }
    }

struct Args { const float* in[21]; float* out; unsigned char* ws; };
__global__ void __launch_bounds__(NWAVES * 64, 2) yoco_fwd(Args args) {
    extern __shared__ __attribute__((aligned(16))) unsigned char lds[];
    Ctx C;
    C.lds = (LAS unsigned char*)lds; C.tid = threadIdx.x; C.lane = C.tid & 63; C.wave = __builtin_amdgcn_readfirstlane(C.tid >> 6);
    C.G = gridDim.x; { const int bx = blockIdx.x; C.vcu = (C.G % 8 == 0) ? (bx % 8) * (C.G / 8) + bx / 8 : bx; }
    for (int u = C.tid; u < (LDS_BYTES - LDSCTL_OFF) / 4; u += NWAVES * 64) ((LAS unsigned*)(C.lds + LDSCTL_OFF))[u] = 0u;
    __syncthreads();
    if (C.tid < IN_COUNT) ((LAS unsigned long long*)(C.lds + PTR_OFF))[C.tid] = ((const unsigned long long*)__builtin_amdgcn_kernarg_segment_ptr())[C.tid];
    __syncthreads();
    XcdBarrier bar = xcd_barrier_post((unsigned*)((gu32*)(wsp(C) + WS_CTL) + CW_BAR), (volatile LAS unsigned*)(C.lds + MISC_OFF) + 8);
    LAS unsigned char* ring = C.lds + RING_OFF;
    const LAS int* rt = (const LAS int*)(C.lds + ROUTE_OFF);
    const int G = C.G, bx = (int)blockIdx.x;

    for (int dup = 0; dup <= DUP_PRO; ++dup) { if (dup) __syncthreads(); p0_prologue(C); } GRID_BAR();

    const bool reg32 = __builtin_amdgcn_readfirstlane((int)bar.st[2]) == 2;
    int bxv = bx;
    if (reg32) { const int rank = __builtin_amdgcn_readfirstlane((int)bar.st[3]) - 1, xcc = (int)bar.x; C.vcu = xcc * 32 + rank; bxv = rank * 8 + xcc; }

    layer_body<0>(C, bar, ring, rt, G, bxv, reg32);
    layer_body<1>(C, bar, ring, rt, G, bxv, reg32);
    layer_body<2>(C, bar, ring, rt, G, bxv, reg32);
    layer_body<3>(C, bar, ring, rt, G, bxv, reg32);
    token_phase<true, false, false, true>(C, wsp(C) + WS_XBF, outp(C), inp(C, IN_FNG), 0, 0, nullptr, 3 * MODW + 5 * D, nullptr);
}

extern "C" void kernel_launch(void* const* d_in, const int* in_sizes, int n_in, void* d_out, int out_size, void* d_ws, size_t ws_size, hipStream_t stream) {
    static int grid = 0;
    if (grid == 0) {
        if (n_in != 21 || in_sizes[0] != NTOK * D || out_size != NTOK * D || ws_size < WS_END) { fprintf(stderr, "kernel_launch: unexpected shapes (n_in %d, in0 %d, out %d, ws %zu); nothing launched\n", n_in, n_in > 0 ? in_sizes[0] : -1, out_size, ws_size); grid = -1; return; }
        int dev = 0, cus = 0, per_cu = 0;
        if (hipGetDevice(&dev) != hipSuccess || hipDeviceGetAttribute(&cus, hipDeviceAttributeMultiprocessorCount, dev) != hipSuccess) { fprintf(stderr, "kernel_launch: device query failed\n"); grid = -1; return; }
        if (hipFuncSetAttribute((const void*)yoco_fwd, hipFuncAttributeMaxDynamicSharedMemorySize, LDS_BYTES) != hipSuccess) { fprintf(stderr, "kernel_launch: hipFuncSetAttribute failed\n"); grid = -1; return; }
        if (hipOccupancyMaxActiveBlocksPerMultiprocessor(&per_cu, (const void*)yoco_fwd, NWAVES * 64, LDS_BYTES) != hipSuccess || per_cu < 1)
            fprintf(stderr, "kernel_launch: note: occupancy query reports %d workgroups per CU\n", per_cu);
        (void)hipGetLastError();
        if (cus < 256) { fprintf(stderr, "kernel_launch: this kernel needs 256 CUs (found %d); nothing launched\n", cus); grid = -1; return; }
        grid = 256;
    }
    if (grid < 0) return;
    if (hipMemsetAsync((char*)d_ws + WS_CTL, 0, CTL_ZERO_BYTES, stream) != hipSuccess) { fprintf(stderr, "kernel_launch: hipMemsetAsync failed\n"); return; }
    Args a{};
    for (int i = 0; i < 21; ++i) a.in[i] = (const float*)d_in[i];
    a.out = (float*)d_out; a.ws = (unsigned char*)d_ws;
    hipLaunchKernelGGL(yoco_fwd, dim3(grid), dim3(NWAVES * 64), LDS_BYTES, stream, a);
    const hipError_t le = hipPeekAtLastError();
    if (le != hipSuccess) fprintf(stderr, "kernel_launch: launch failed: %s\n", hipGetErrorName(le));
}
```

```cpp
#include <hip/hip_runtime.h>
#include <cstdio>
#include <cstdint>
namespace pg8 {
#define PG8_LAS __attribute__((address_space(3)))
#define PG8_GAS __attribute__((address_space(1)))
typedef unsigned short bf16_t;
typedef short bf16x8 __attribute__((ext_vector_type(8)));
typedef float f32x4 __attribute__((ext_vector_type(4)));
typedef unsigned u32x4 __attribute__((ext_vector_type(4)));
constexpr int BM = 256, BK = 64, HALF = 128, HTB = HALF * BK * 2  , STAGE_BYTES = 8 * HTB, NXCD = 8, WGM = 8;

__host__ __device__ __forceinline__ int lds_byte(int r, int c) { const int st = (r >> 4) * 2 + (c >> 5), rr = r & 15, cc = c & 31, ob = rr * 64 + cc * 2; return st * 1024 + (ob ^ (((ob >> 9) & 1) << 5)); }
__host__ __device__ __forceinline__ void stage_rc(int b, int& R, int& C) { const int st = b / 1024, sb = b % 1024, swz = sb ^ (((sb >> 9) & 1) << 5); R = (st >> 1) * 16 + swz / 64; C = (st & 1) * 32 + (swz % 64) / 2; }
__host__ __device__ __forceinline__ int perm32(int rho) { const int n = rho >> 4, i = rho & 15; return 8 * (i >> 2) + 4 * n + (i & 3); }

struct Unit { int pm, pn, ks; };
struct Gemm { const bf16_t* A; const bf16_t* Bt; int M, N, K, ld; };

struct StaticOrder {
    static constexpr bool SPLITK = false;
    int nM, nN, nwg, G, c;
    __host__ __device__ void init(int M, int N, int G_, int c_) { nM = M / BM; nN = N / BM; nwg = nM * nN; G = G_; c = c_; }
    __host__ __device__ bool next(int i, Unit& u) const {
        const long L = (long)i * G + c; if (L >= nwg) return false;
        int wgid = (int)L; { const int q = nwg / NXCD, r = nwg % NXCD, xcd = wgid % NXCD, off = wgid / NXCD; wgid = (xcd < r ? xcd * (q + 1) : r * (q + 1) + (xcd - r) * q) + off; }
        const int nig = WGM * nN, gid = wgid / nig, fm = gid * WGM, gsz = (nM - fm) < WGM ? (nM - fm) : WGM;
        u.pm = fm + ((wgid % nig) % gsz); u.pn = (wgid % nig) / gsz; return true;
    }
    __device__ __forceinline__ void a_ready(const Unit&) const {}
    __device__ __forceinline__ void done(const Unit&) const {}
};
struct MoeOrder {
    static constexpr bool SPLITK = false;
    int nM, nN, nwg, G, c; const PG8_LAS int* texp;
    __device__ void init(int ntiles, int nN_, int G_, int c_, const PG8_LAS int* t) { nM = ntiles; nN = nN_; nwg = nM * nN; G = G_; c = c_; texp = t; }
    __device__ bool next(int i, Unit& u) const {
        const long L = (long)i * G + c; if (L >= nwg) return false;
        int wgid = (int)L; { const int q = nwg / NXCD, r = nwg % NXCD, xcd = wgid % NXCD, off = wgid / NXCD; wgid = (xcd < r ? xcd * (q + 1) : r * (q + 1) + (xcd - r) * q) + off; }
        const int nig = WGM * nN, gid = wgid / nig, fm = gid * WGM, gsz = (nM - fm) < WGM ? (nM - fm) : WGM;
        u.pm = fm + ((wgid % nig) % gsz); const int pnl = (wgid % nig) / gsz;
        const int e = __builtin_amdgcn_readfirstlane(texp[u.pm]); u.pn = e * nN + pnl; return true;
    }
    __device__ __forceinline__ void a_ready(const Unit&) const {}
    __device__ __forceinline__ void done(const Unit&) const {}
};

struct TailOrder {
    static constexpr bool SPLITK = true;
    int nN, nS, nwg, G, c; const PG8_LAS int* texp;
    __device__ void init(int ntail, int nN_, int nS_, int G_, int c_, const PG8_LAS int* t) { nN = nN_; nS = nS_; nwg = ntail * nN_ * nS_; G = G_; c = c_; texp = t; }
    __device__ bool next(int i, Unit& u) const {
        const long L = (long)i * G + c; if (L >= nwg) return false;
        const int id = (int)L, rest = id / nS; u.ks = id - rest * nS; const int tl = rest / nN, pnl = rest - tl * nN; u.pm = 256 + tl;
        const int e = __builtin_amdgcn_readfirstlane(texp[u.pm]); u.pn = e * nN + pnl; return true;
    }
    __device__ __forceinline__ void a_ready(const Unit&) const {}
    __device__ __forceinline__ void done(const Unit&) const {}
};
template <class Base> struct ScaleStage : Base {
    const float* sA; const float* sB; PG8_LAS unsigned char* buf; mutable int cnt;
    __device__ __forceinline__ void a_ready(const Unit& u) const {
        if (threadIdx.x < 64) { PG8_LAS unsigned char* d = buf + (cnt & 1) * 2048;
            __builtin_amdgcn_global_load_lds((const unsigned*)(sA + (size_t)u.pm * BM + threadIdx.x * 4), (PG8_LAS unsigned*)d, 16, 0, 0);
            __builtin_amdgcn_global_load_lds((const unsigned*)(sB + (size_t)u.pn * BM + threadIdx.x * 4), (PG8_LAS unsigned*)(d + 1024), 16, 0, 0); }
        ++cnt; }
};
__device__ __forceinline__ unsigned cvt_pk_bf16(float lo, float hi) { unsigned r; asm volatile("v_cvt_pk_bf16_f32 %0, %1, %2" : "=v"(r) : "v"(lo), "v"(hi)); return r; }

typedef int i32x8 __attribute__((ext_vector_type(8)));
typedef int i32x4 __attribute__((ext_vector_type(4)));
typedef unsigned u32x2 __attribute__((ext_vector_type(2)));
__device__ __forceinline__ i32x8 cat8(bf16x8 a, bf16x8 b) { const i32x4 x = __builtin_bit_cast(i32x4, a), y = __builtin_bit_cast(i32x4, b); return __builtin_shufflevector(x, y, 0, 1, 2, 3, 4, 5, 6, 7); }
__device__ __forceinline__ void mfma8(f32x4& acc, const i32x8 a, const i32x8 b, const int sc) { asm volatile("v_mfma_scale_f32_16x16x128_f8f6f4 %0, %1, %2, %0, %3, %3 op_sel_hi:[0,0,0]" : "+v"(acc) : "v"(a), "v"(b), "v"(sc)); }
__device__ __forceinline__ void mfma8z(f32x4& acc, const i32x8 a, const i32x8 b, const int sc) { asm volatile("v_mfma_scale_f32_16x16x128_f8f6f4 %0, %1, %2, 0, %3, %3 op_sel_hi:[0,0,0]" : "=&v"(acc) : "v"(a), "v"(b), "v"(sc)); }
__device__ __forceinline__ unsigned pk4_fp8(float a, float b, float c, float d) {
    a = __builtin_amdgcn_fmed3f(a, -448.f, 448.f); b = __builtin_amdgcn_fmed3f(b, -448.f, 448.f); c = __builtin_amdgcn_fmed3f(c, -448.f, 448.f); d = __builtin_amdgcn_fmed3f(d, -448.f, 448.f);
    int w = 0; w = __builtin_amdgcn_cvt_pk_fp8_f32(a, b, w, false); w = __builtin_amdgcn_cvt_pk_fp8_f32(c, d, w, true); return (unsigned)w; }
struct EpiBf16 {
    static constexpr bool PERM = true, AFTER_DRAIN = false;
    bf16_t* O; int ldc; int split_cols; size_t split_stride; float scale0; int ntn; float scale_all;
    __device__ __forceinline__ void operator()(const f32x4 (&acc)[2][2][4][2], const Unit& u, int wr, int wc, int fr, int fq) const {
        const int row0 = u.pm * BM + wr * 64 + fr; int colt = (ntn ? (u.pn % ntn) : u.pn) * BM; bf16_t* base = O;
        float sc = scale_all; if (split_cols) { const int t = colt / split_cols; base += (size_t)t * split_stride; colt -= t * split_cols; if (t == 0) sc *= scale0; }
        const int col0 = colt + wc * 32 + 8 * fq;
#pragma unroll
        for (int ai = 0; ai < 2; ++ai)
#pragma unroll
            for (int m = 0; m < 4; ++m) { bf16_t* rowp = base + (size_t)(row0 + ai * HALF + m * 16) * ldc + col0;
#pragma unroll
                for (int bj = 0; bj < 2; ++bj) { f32x4 v0 = acc[ai][bj][m][0] * sc, v1 = acc[ai][bj][m][1] * sc;
                    u32x4 w; w.x = cvt_pk_bf16(v0[0], v0[1]); w.y = cvt_pk_bf16(v0[2], v0[3]); w.z = cvt_pk_bf16(v1[0], v1[1]); w.w = cvt_pk_bf16(v1[2], v1[3]);
                    *(PG8_GAS u32x4*)(rowp + bj * HALF) = w; } }
    }
};
struct EpiBf16I8 {
    static constexpr bool PERM = true, AFTER_DRAIN = false;
    bf16_t* O; int ldc; int split_cols; size_t split_stride; float scale0; PG8_LAS unsigned char* sbuf; mutable int cnt;
    __device__ __forceinline__ void operator()(const f32x4 (&acc)[2][2][4][2], const Unit& u, int wr, int wc, int fr, int fq) const {
        const int row0 = u.pm * BM + wr * 64 + fr; int colt = u.pn * BM; bf16_t* base = O;
        float sc = 1.0f; if (split_cols) { const int t = colt / split_cols; base += (size_t)t * split_stride; colt -= t * split_cols; if (t == 0) sc = scale0; }
        const int col0 = colt + wc * 32 + 8 * fq;
        const PG8_LAS float* sa = (const PG8_LAS float*)(sbuf + (cnt & 1) * 2048) + wr * 64 + fr; const PG8_LAS float* sb = (const PG8_LAS float*)(sbuf + (cnt & 1) * 2048 + 1024) + wc * 32 + 8 * fq; ++cnt;
        f32x4 sv[2][2];
#pragma unroll
        for (int bj = 0; bj < 2; ++bj)
#pragma unroll
            for (int n = 0; n < 2; ++n) sv[bj][n] = *(const PG8_LAS f32x4*)(sb + bj * HALF + 4 * n) * sc;
#pragma unroll
        for (int ai = 0; ai < 2; ++ai)
#pragma unroll
            for (int m = 0; m < 4; ++m) { const int r = row0 + ai * HALF + m * 16; bf16_t* rowp = base + (size_t)r * ldc + col0; const float a = sa[ai * HALF + m * 16];
#pragma unroll
                for (int bj = 0; bj < 2; ++bj) { const f32x4 v0 = __builtin_convertvector(__builtin_bit_cast(i32x4, acc[ai][bj][m][0]), f32x4) * (sv[bj][0] * a), v1 = __builtin_convertvector(__builtin_bit_cast(i32x4, acc[ai][bj][m][1]), f32x4) * (sv[bj][1] * a);
                    u32x4 w; w.x = cvt_pk_bf16(v0[0], v0[1]); w.y = cvt_pk_bf16(v0[2], v0[3]); w.z = cvt_pk_bf16(v1[0], v1[1]); w.w = cvt_pk_bf16(v1[2], v1[3]);
                    *(PG8_GAS u32x4*)(rowp + bj * HALF) = w; } }
    }
};
__device__ __forceinline__ float silu_mul2(float t, float u2) { return (t * u2) * __builtin_amdgcn_rcpf(1.0f + __builtin_amdgcn_exp2f(t)); }
__device__ __forceinline__ float silu_mul(float g, float u) { const float e = __builtin_amdgcn_exp2f(g * -1.4426950408889634f); return g * u * __builtin_amdgcn_rcpf(1.0f + e); }
struct EpiSwiGlu {
    static constexpr bool PERM = true, AFTER_DRAIN = false;
    unsigned char* O; int ldc; int ntn; float ascale, hscale;
    __device__ __forceinline__ void operator()(const f32x4 (&acc)[2][2][4][2], const Unit& u, int wr, int wc, int fr, int fq) const {
        const int row0 = u.pm * BM + wr * 64 + fr; const int col0 = (u.pn % ntn) * HALF + wc * 32 + 8 * fq;
#pragma unroll
        for (int ai = 0; ai < 2; ++ai)
#pragma unroll
            for (int m = 0; m < 4; ++m) { unsigned char* rowp = O + (size_t)(row0 + ai * HALF + m * 16) * ldc + col0;
                const f32x4 g0 = acc[ai][0][m][0] * ascale, g1 = acc[ai][0][m][1] * ascale, u0 = acc[ai][1][m][0] * (ascale * hscale), u1 = acc[ai][1][m][1] * (ascale * hscale);
                u32x2 w; w.x = pk4_fp8(silu_mul(g0[0], u0[0]), silu_mul(g0[1], u0[1]), silu_mul(g0[2], u0[2]), silu_mul(g0[3], u0[3]));
                w.y = pk4_fp8(silu_mul(g1[0], u1[0]), silu_mul(g1[1], u1[1]), silu_mul(g1[2], u1[2]), silu_mul(g1[3], u1[3]));
                *(PG8_GAS u32x2*)rowp = w; }
    }
};
struct EpiSwiGluI8 {
    static constexpr bool PERM = true, AFTER_DRAIN = false;
    unsigned char* O; int ldc; int ntn; PG8_LAS unsigned char* sbuf; float hscale; mutable int cnt;
    __device__ __forceinline__ void operator()(const f32x4 (&acc)[2][2][4][2], const Unit& u, int wr, int wc, int fr, int fq) const {
        const int row0 = u.pm * BM + wr * 64 + fr; const int col0 = (u.pn % ntn) * HALF + wc * 32 + 8 * fq;
        const PG8_LAS float* sa = (const PG8_LAS float*)(sbuf + (cnt & 1) * 2048) + wr * 64 + fr; const PG8_LAS float* sb = (const PG8_LAS float*)(sbuf + (cnt & 1) * 2048 + 1024) + wc * 32 + 8 * fq; ++cnt;
        const f32x4 sg0 = *(const PG8_LAS f32x4*)(sb) * -1.4426950408889634f, sg1 = *(const PG8_LAS f32x4*)(sb + 4) * -1.4426950408889634f;
        const f32x4 su0 = *(const PG8_LAS f32x4*)(sb + HALF) * (hscale * -0.6931471805599453f), su1 = *(const PG8_LAS f32x4*)(sb + HALF + 4) * (hscale * -0.6931471805599453f);
#pragma unroll
        for (int ai = 0; ai < 2; ++ai)
#pragma unroll
            for (int m = 0; m < 4; ++m) { const int r = row0 + ai * HALF + m * 16; unsigned char* rowp = O + (size_t)r * ldc + col0; const float a = sa[ai * HALF + m * 16];
                const f32x4 g0 = __builtin_convertvector(__builtin_bit_cast(i32x4, acc[ai][0][m][0]), f32x4) * (sg0 * a), g1 = __builtin_convertvector(__builtin_bit_cast(i32x4, acc[ai][0][m][1]), f32x4) * (sg1 * a);
                const f32x4 u0 = __builtin_convertvector(__builtin_bit_cast(i32x4, acc[ai][1][m][0]), f32x4) * (su0 * a), u1 = __builtin_convertvector(__builtin_bit_cast(i32x4, acc[ai][1][m][1]), f32x4) * (su1 * a);
                u32x2 w; w.x = pk4_fp8(silu_mul2(g0[0], u0[0]), silu_mul2(g0[1], u0[1]), silu_mul2(g0[2], u0[2]), silu_mul2(g0[3], u0[3]));
                w.y = pk4_fp8(silu_mul2(g1[0], u1[0]), silu_mul2(g1[1], u1[1]), silu_mul2(g1[2], u1[2]), silu_mul2(g1[3], u1[3]));
                *(PG8_GAS u32x2*)rowp = w; }
    }
};
struct EpiPlaneF32 {
    static constexpr bool PERM = true, AFTER_DRAIN = false;
    float* O; int ntn; float scale; size_t plane;
    __device__ __forceinline__ void operator()(const f32x4 (&acc)[2][2][4][2], const Unit& u, int wr, int wc, int fr, int fq) const {
        const int row0 = (u.pm - 256) * BM + wr * 64 + fr, col0 = (u.pn % ntn) * BM + wc * 32 + 8 * fq; float* base = O + (size_t)u.ks * plane;
#pragma unroll
        for (int ai = 0; ai < 2; ++ai)
#pragma unroll
            for (int m = 0; m < 4; ++m) { float* rowp = base + (size_t)(row0 + ai * HALF + m * 16) * 1024 + col0;
#pragma unroll
                for (int bj = 0; bj < 2; ++bj) { *(PG8_GAS f32x4*)(rowp + bj * HALF) = acc[ai][bj][m][0] * scale; *(PG8_GAS f32x4*)(rowp + bj * HALF + 4) = acc[ai][bj][m][1] * scale; } }
    }
};
template <bool XIN_F32> struct EpiResidB {
    static constexpr bool PERM = true, AFTER_DRAIN = false;
    const void* xin; bf16_t* out; const float* gate; int gstride; float ascale;
    __device__ __forceinline__ void operator()(const f32x4 (&acc)[2][2][4][2], const Unit& u, int wr, int wc, int fr, int fq) const {
        const int row0 = u.pm * BM + wr * 64 + fr, col0 = u.pn * BM + wc * 32 + 8 * fq; const float* gp = gate + (size_t)(u.pm >> 4) * gstride + col0;
        f32x4 gv[2][2];
#pragma unroll
        for (int bj = 0; bj < 2; ++bj)
#pragma unroll
            for (int n = 0; n < 2; ++n) gv[bj][n] = *(const PG8_GAS f32x4*)(gp + bj * HALF + 4 * n) * ascale;
#pragma unroll
        for (int ai = 0; ai < 2; ++ai)
#pragma unroll
            for (int m = 0; m < 4; ++m) { const size_t off = (size_t)(row0 + ai * HALF + m * 16) * 1024 + col0;
#pragma unroll
                for (int bj = 0; bj < 2; ++bj) { f32x4 xa, xb;
                    if (XIN_F32) { xa = *(const PG8_GAS f32x4*)((const float*)xin + off + bj * HALF); xb = *(const PG8_GAS f32x4*)((const float*)xin + off + bj * HALF + 4); }
                    else { const u32x4 w = *(const PG8_GAS u32x4*)((const bf16_t*)xin + off + bj * HALF);
                        xa = (f32x4){__uint_as_float(w.x << 16), __uint_as_float(w.x & 0xffff0000u), __uint_as_float(w.y << 16), __uint_as_float(w.y & 0xffff0000u)};
                        xb = (f32x4){__uint_as_float(w.z << 16), __uint_as_float(w.z & 0xffff0000u), __uint_as_float(w.w << 16), __uint_as_float(w.w & 0xffff0000u)}; }
                    const f32x4 r0 = xa + gv[bj][0] * acc[ai][bj][m][0], r1 = xb + gv[bj][1] * acc[ai][bj][m][1];
                    u32x4 o; o.x = cvt_pk_bf16(r0[0], r0[1]); o.y = cvt_pk_bf16(r0[2], r0[3]); o.z = cvt_pk_bf16(r1[0], r1[1]); o.w = cvt_pk_bf16(r1[2], r1[3]);
                    *(PG8_GAS u32x4*)(out + off + bj * HALF) = o; }
                if (m & 1) asm volatile("" ::: "memory"); }
    }
};

template <class Epi, class Sched, bool ALIGN_EPI = false, bool SP2 = false, int MODE = 0>
__device__ __forceinline__ void gemm_phase(PG8_LAS unsigned char* lds, const Gemm g, const Sched& S, const Epi& E) {
    int tid_ = threadIdx.x; asm volatile("" : "+v"(tid_));
    const int tid = tid_, wid = __builtin_amdgcn_readfirstlane(tid >> 6), lane = tid & 63, wr = wid >> 2, wc = wid & 3, fr = lane & 15, fq = lane >> 4;
    const int K = g.K, nt = K / BK, LD = g.ld ? g.ld : K;
    unsigned voffA[2], voffB[2];
#pragma unroll
    for (int i = 0; i < 2; ++i) { int R, C; stage_rc(tid * 16 + i * 8192, R, C); const int Rb = Epi::PERM ? ((R & ~31) + perm32(R & 31)) : R;
        voffA[i] = (unsigned)(R * LD + C) * 2u; voffB[i] = (unsigned)(Rb * LD + C) * 2u; }
    const size_t kstep = (size_t)(BK * 2);
    const size_t hstep = (size_t)HALF * LD * 2;
    const size_t tstep = 2 * hstep;
    const unsigned ldsw = (unsigned)wid * 1024u;
    const int aoff = lds_byte(wr * 64 + fr, fq * 8), boff = lds_byte(wc * 32 + fr, fq * 8);
#define PG8_SA(b, h) (((b) * 2 + (h)) * HTB)
#define PG8_SB(b, h) ((4 + (b) * 2 + (h)) * HTB)
#define PG8_STAGE(bufoff, gbase, voff) do { _Pragma("unroll") for (int _i = 0; _i < 2; ++_i) { unsigned vo_ = (voff)[_i]; asm volatile("" : "+v"(vo_));   \
        __builtin_amdgcn_global_load_lds((const unsigned*)((const char*)(gbase) + vo_), (PG8_LAS unsigned*)(lds + (bufoff) + ldsw + _i * 8192), 16, 0, 0); } } while (0)
#define PG8_LDA(dst, b, h) do { _Pragma("unroll") for (int m = 0; m < 4; ++m) _Pragma("unroll") for (int k = 0; k < 2; ++k) dst[m][k] = *(const PG8_LAS bf16x8*)(lds + PG8_SA(b, h) + aoff + m * 2048 + k * 1024); } while (0)
#define PG8_LDB(dst, b, h) do { _Pragma("unroll") for (int n = 0; n < 2; ++n) _Pragma("unroll") for (int k = 0; k < 2; ++k) dst[n][k] = *(const PG8_LAS bf16x8*)(lds + PG8_SB(b, h) + boff + n * 2048 + k * 1024); } while (0)
#define PG8_MMA(Z, ai, bj, At, Bt) do { __builtin_amdgcn_s_setprio(1); \
        if constexpr (MODE == 1) { _Pragma("unroll") for (int m = 0; m < 4; ++m) _Pragma("unroll") for (int n = 0; n < 2; ++n) { \
            if constexpr (Z) mfma8z(acc[ai][bj][m][n], cat8(Bt[n][0], Bt[n][1]), cat8(At[m][0], At[m][1]), sc8); else mfma8(acc[ai][bj][m][n], cat8(Bt[n][0], Bt[n][1]), cat8(At[m][0], At[m][1]), sc8); } } \
        else if constexpr (MODE == 2) { _Pragma("unroll") for (int m = 0; m < 4; ++m) _Pragma("unroll") for (int n = 0; n < 2; ++n) _Pragma("unroll") for (int k = 0; k < 2; ++k) \
            acc[ai][bj][m][n] = __builtin_bit_cast(f32x4, __builtin_amdgcn_mfma_i32_16x16x64_i8(__builtin_bit_cast(i32x4, Bt[n][k]), __builtin_bit_cast(i32x4, At[m][k]), (Z && k == 0) ? (i32x4){0, 0, 0, 0} : __builtin_bit_cast(i32x4, acc[ai][bj][m][n]), 0, 0, 0)); } \
        else { _Pragma("unroll") for (int m = 0; m < 4; ++m) _Pragma("unroll") for (int n = 0; n < 2; ++n) _Pragma("unroll") for (int k = 0; k < 2; ++k) \
            acc[ai][bj][m][n] = __builtin_amdgcn_mfma_f32_16x16x32_bf16(Bt[n][k], At[m][k], (Z && k == 0) ? (f32x4){0.f, 0.f, 0.f, 0.f} : acc[ai][bj][m][n], 0, 0, 0); } __builtin_amdgcn_s_setprio(0); } while (0)
#define PG8_WAIT_V(n) asm volatile("s_waitcnt vmcnt(" #n ")" ::: "memory")
#define PG8_WAIT_L(n) asm volatile("s_waitcnt lgkmcnt(" #n ")" ::: "memory")
#define PG8_BAR __builtin_amdgcn_s_barrier()
#define PG8_SCHED __builtin_amdgcn_sched_barrier(0)
#define PG8_KITER(ZF) do { \
            const bool last = (t == nt - 2); \
            const char* a1 = cA + (size_t)(t + 1) * kstep; \
            const char* a2 = last ? nA : cA + (size_t)(t + 2) * kstep; const char* b2 = last ? nB : cB + (size_t)(t + 2) * kstep; \
            const char* a3 = a2 + kstep; const char* b3 = b2 + kstep; \
            if (last && has_next) S.a_ready(nxt); \
            if constexpr (SP2) { \
            PG8_LDB(B0, 0, 0); PG8_LDB(B1, 0, 1); PG8_SCHED; PG8_LDA(At, 0, 0); PG8_STAGE(PG8_SA(1, 1), a1 + hstep, voffA); \
            PG8_WAIT_V(8); PG8_WAIT_L(0); PG8_BAR; PG8_MMA(ZF, 0, 0, At, B0); PG8_MMA(ZF, 0, 1, At, B1); PG8_BAR; PG8_SCHED; \
            PG8_LDA(At, 0, 1); PG8_STAGE(PG8_SB(0, 0), b2, voffB); PG8_STAGE(PG8_SB(0, 1), b2 + hstep, voffB); PG8_STAGE(PG8_SA(0, 0), a2, voffA); \
            PG8_WAIT_V(8); PG8_WAIT_L(0); PG8_BAR; PG8_MMA(ZF, 1, 0, At, B0); PG8_MMA(ZF, 1, 1, At, B1); PG8_BAR; PG8_SCHED; \
            PG8_LDB(B0, 1, 0); PG8_LDB(B1, 1, 1); PG8_SCHED; PG8_LDA(At, 1, 0); PG8_STAGE(PG8_SA(0, 1), a2 + hstep, voffA); \
            PG8_WAIT_V(8); PG8_WAIT_L(0); PG8_BAR; PG8_MMA(false, 0, 0, At, B0); PG8_MMA(false, 0, 1, At, B1); PG8_BAR; PG8_SCHED; \
            PG8_LDA(At, 1, 1); PG8_STAGE(PG8_SB(1, 0), b3, voffB); PG8_STAGE(PG8_SB(1, 1), b3 + hstep, voffB); PG8_STAGE(PG8_SA(1, 0), a3, voffA); \
            PG8_WAIT_V(8); PG8_WAIT_L(0); PG8_BAR; PG8_MMA(false, 1, 0, At, B0); PG8_MMA(false, 1, 1, At, B1); PG8_BAR; PG8_SCHED; \
            } else { \
            PG8_LDB(B0, 0, 0); PG8_SCHED; PG8_LDA(At, 0, 0); PG8_STAGE(PG8_SA(1, 1), a1 + hstep, voffA); \
            PG8_WAIT_L(8); PG8_BAR; PG8_WAIT_L(0); PG8_MMA(ZF, 0, 0, At, B0); PG8_BAR; PG8_SCHED; \
            PG8_LDB(B1, 0, 1); PG8_STAGE(PG8_SB(0, 0), b2, voffB); \
            PG8_BAR; PG8_WAIT_L(0); PG8_MMA(ZF, 0, 1, At, B1); PG8_BAR; \
            PG8_LDA(At, 0, 1); PG8_STAGE(PG8_SA(0, 0), a2, voffA); \
            PG8_BAR; PG8_WAIT_L(0); PG8_MMA(ZF, 1, 0, At, B0); PG8_BAR; PG8_SCHED; \
            PG8_STAGE(PG8_SB(0, 1), b2 + hstep, voffB); \
            PG8_WAIT_V(6); PG8_BAR; PG8_MMA(ZF, 1, 1, At, B1); PG8_BAR; \
            PG8_LDB(B0, 1, 0); PG8_SCHED; PG8_LDA(At, 1, 0); PG8_STAGE(PG8_SA(0, 1), a2 + hstep, voffA); \
            PG8_WAIT_L(8); PG8_BAR; PG8_WAIT_L(0); PG8_MMA(false, 0, 0, At, B0); PG8_BAR; PG8_SCHED; \
            PG8_LDB(B1, 1, 1); PG8_STAGE(PG8_SB(1, 0), b3, voffB); \
            PG8_BAR; PG8_WAIT_L(0); PG8_MMA(false, 0, 1, At, B1); PG8_BAR; \
            PG8_LDA(At, 1, 1); PG8_STAGE(PG8_SA(1, 0), a3, voffA); \
            PG8_BAR; PG8_WAIT_L(0); PG8_MMA(false, 1, 0, At, B0); PG8_BAR; PG8_SCHED; \
            PG8_STAGE(PG8_SB(1, 1), b3 + hstep, voffB); \
            PG8_WAIT_V(6); PG8_BAR; PG8_MMA(false, 1, 1, At, B1); PG8_BAR; \
            } \
        } while (0)
    int sc8 = 0x7f7f7f7f; asm volatile("" : "+v"(sc8));
    Unit cur, nxt; int ui = 0;
    if (!S.next(0, cur)) return;
    f32x4 acc[2][2][4][2];
    bf16x8 At[4][2], B0[2][2], B1[2][2];
    const char* cA = (const char*)g.A + (size_t)cur.pm * tstep; const char* cB = (const char*)g.Bt + (size_t)cur.pn * tstep;
    if constexpr (Sched::SPLITK) { cA += (size_t)cur.ks * K * 2; cB += (size_t)cur.ks * K * 2; }
    S.a_ready(cur);
    if constexpr (SP2) {
        PG8_STAGE(PG8_SB(0, 0), cB, voffB); PG8_STAGE(PG8_SB(0, 1), cB + hstep, voffB); PG8_STAGE(PG8_SA(0, 0), cA, voffA); PG8_STAGE(PG8_SA(0, 1), cA + hstep, voffA);
        if (wr == 1) PG8_BAR;
        PG8_WAIT_V(2); PG8_BAR;
        PG8_STAGE(PG8_SB(1, 0), cB + kstep, voffB); PG8_STAGE(PG8_SA(1, 0), cA + kstep, voffA); PG8_STAGE(PG8_SB(1, 1), cB + hstep + kstep, voffB);
        PG8_WAIT_V(6); PG8_BAR;
    } else {
        PG8_STAGE(PG8_SB(0, 0), cB, voffB); PG8_STAGE(PG8_SA(0, 0), cA, voffA); PG8_STAGE(PG8_SB(0, 1), cB + hstep, voffB); PG8_STAGE(PG8_SA(0, 1), cA + hstep, voffA);
        if (wr == 1) PG8_BAR;
        PG8_WAIT_V(4); PG8_BAR;
        PG8_STAGE(PG8_SB(1, 0), cB + kstep, voffB); PG8_STAGE(PG8_SA(1, 0), cA + kstep, voffA); PG8_STAGE(PG8_SB(1, 1), cB + hstep + kstep, voffB);
        PG8_WAIT_V(6); PG8_BAR;
    }
    for (;;) {
        const bool has_next = S.next(ui + 1, nxt);
        const char* nA = has_next ? (const char*)g.A + (size_t)nxt.pm * tstep : cA; const char* nB = has_next ? (const char*)g.Bt + (size_t)nxt.pn * tstep : cB;
        if constexpr (Sched::SPLITK) { if (has_next) { nA += (size_t)nxt.ks * K * 2; nB += (size_t)nxt.ks * K * 2; } }
        { const int t = 0; PG8_KITER(true); }
#pragma nounroll
        for (int t = 2; t < nt; t += 2) { PG8_KITER(false); }
        if constexpr (MODE == 1) asm volatile("s_nop 15\n\ts_nop 7" ::: "memory");
        if constexpr (ALIGN_EPI) { if (wr == 0) PG8_BAR; }
        if constexpr (!Epi::AFTER_DRAIN) { E(acc, cur, wr, wc, fr, fq); S.done(cur); }
        if (!has_next) break;
        cur = nxt; cA = nA; cB = nB; ++ui;
        if constexpr (ALIGN_EPI) { if (wr == 1) PG8_BAR; }
    }
    PG8_WAIT_V(0);
    if constexpr (!ALIGN_EPI) { if (wr == 0) PG8_BAR; }
    PG8_BAR;
    if constexpr (Epi::AFTER_DRAIN) { E.fused(acc, cur, wr, wc, fr, fq, lds, wid, lane); S.done(cur); }
#undef PG8_SA
#undef PG8_SB
#undef PG8_STAGE
#undef PG8_LDA
#undef PG8_LDB
#undef PG8_MMA
#undef PG8_KITER
#undef PG8_WAIT_V
#undef PG8_WAIT_L
#undef PG8_BAR
#undef PG8_SCHED
}
}

constexpr int NWAVES = 8;
constexpr int NB = 8, SEQ = 4096, D = 1024, NH = 16, HD = 64, NTOK = NB * SEQ;
constexpr int FF = 2816, FFE = 3584, NE = 8;
constexpr int MODW = 6 * D, MODLD = 4 * MODW + 2 * D;
constexpr int KVMOD = 4 * MODW;
constexpr float RMS_EPS = 1e-6f;
constexpr float LOG2E = 1.4426950408889634f;
constexpr float QSCALE = 0.125f * LOG2E;
constexpr float ASCALE8 = 4.0f, WSCALE8 = 128.0f, HSCALE8 = 4.0f, OSCALE8 = 16.0f;
constexpr int BT_PAD = 256;
constexpr int MAXTILES = 264;

constexpr size_t MiB = 1u << 20;
constexpr size_t WS_CTL = 0, CTL_ZERO_BYTES = 64 * 1024;
constexpr size_t WS_MOD = 1 * MiB;
constexpr size_t WS_BIAS = 2 * MiB;
constexpr size_t WS_KMEAN = 2 * MiB + 256 * 1024;
constexpr size_t WS_TOKE = 3 * MiB;
constexpr size_t WS_TOKW = WS_TOKE + 128 * 1024;
constexpr size_t WS_TOKS = WS_TOKW + 256 * 1024;
constexpr size_t WS_HIST = WS_TOKS + 256 * 1024;
constexpr size_t WS_SA = 4 * MiB, WS_SAG = 4 * MiB + 256 * 1024;
constexpr size_t WS_SA2 = 4 * MiB + 640 * 1024;
constexpr size_t WS_SBQKV = 5 * MiB + 576 * 1024, WS_SBKV = WS_SBQKV + 32 * 1024, WS_SBQ = WS_SBKV + 16 * 1024;
constexpr size_t WS_SB13 = 5 * MiB, WS_SBM13 = 5 * MiB + 64 * 1024;
constexpr size_t WS_WQKV = 8 * MiB, WS_WO = 20 * MiB, WS_WKV = 24 * MiB, WS_WQ = 28 * MiB, WS_WBO = 32 * MiB, WS_W13 = 36 * MiB, WS_W2 = 58 * MiB, WS_MW13 = 70 * MiB, WS_MW2 = 294 * MiB;
constexpr size_t WS_XN = 408 * MiB, WS_XN2 = 440 * MiB, WS_XBF = 472 * MiB;
constexpr size_t WS_Q = 536 * MiB, WS_K = 600 * MiB, WS_V = 664 * MiB, WS_KSH = 728 * MiB, WS_VSH = 792 * MiB, WS_HID = 856 * MiB, WS_END = 1320 * MiB;
constexpr int TAIL_NS = 2, TAIL_ROWS = (MAXTILES - 256) * 256;
constexpr size_t WS_YT = WS_KSH;
constexpr size_t WS_XG = WS_Q;
static_assert((size_t)MAXTILES * 256 * D * 2 <= WS_KSH - WS_Q && (size_t)MAXTILES * 256 * FFE * 2 <= WS_END - WS_HID && WS_MW2 + (size_t)16 * D * FFE * 2 <= WS_XN, "d_ws map");
constexpr int CW_TMO = 0, CW_CODE = 1, CW_BAR = 4096;

constexpr int RING_OFF = 0, RING_BYTES = 131072;
constexpr int LDSCTL_OFF = RING_BYTES, MISC_OFF = LDSCTL_OFF + 320;
constexpr int ROUTE_OFF = RING_BYTES + 1024;
constexpr int RT_CNT = 0, RT_BASE = 8, RT_SEG = 16, RT_NT = 25, RT_TEXP = 32, RT_WC = 320, RT_LS = 336, RT_HIST = 600;
constexpr int PTR_OFF = RING_BYTES + 512;
constexpr int SCALEBUF_OFF = RING_BYTES + 4096;
constexpr int LDS_BYTES = 147456;
static_assert(ROUTE_OFF + (RT_HIST + 8) * 4 <= LDS_BYTES, "LDS map");

#define GAS __attribute__((address_space(1)))
#define LAS __attribute__((address_space(3)))
typedef unsigned short bf16;
typedef unsigned v4u __attribute__((ext_vector_type(4)));
typedef unsigned v2u __attribute__((ext_vector_type(2)));
typedef float f32x4 __attribute__((ext_vector_type(4)));
typedef float f32x2 __attribute__((ext_vector_type(2)));
typedef GAS unsigned gu32;
#define RLX_AGENT __ATOMIC_RELAXED, __HIP_MEMORY_SCOPE_AGENT
#define LDS_WAIT() asm volatile("s_waitcnt lgkmcnt(0)" ::: "memory")
#define VM_WAIT() asm volatile("s_waitcnt vmcnt(0)" ::: "memory")
__device__ __forceinline__ unsigned f2bf(float f) { unsigned u = __builtin_bit_cast(unsigned, f); return (u + 0x7fffu + ((u >> 16) & 1u)) >> 16; }
__device__ __forceinline__ unsigned pk2(float lo, float hi) { return f2bf(lo) | (f2bf(hi) << 16); }
__device__ __forceinline__ float bflo(unsigned w) { return __uint_as_float(w << 16); }
__device__ __forceinline__ float bfhi(unsigned w) { return __uint_as_float(w & 0xffff0000u); }
template <int CTRL> __device__ __forceinline__ float dppf(float v) { return __uint_as_float((unsigned)__builtin_amdgcn_update_dpp(0, (int)__float_as_uint(v), CTRL, 0xf, 0xf, true)); }
template <int CTRL> __device__ __forceinline__ int dppi(int v) { return __builtin_amdgcn_update_dpp(0, v, CTRL, 0xf, 0xf, true); }
#define DPP_X1 0xB1
#define DPP_X2 0x4E
#define DPP_HM 0x141
#define DPP_RM 0x140
#define DPP_X8 0x128
__device__ __forceinline__ float sum16x(float v) { const auto r = __builtin_amdgcn_permlane16_swap(__float_as_uint(v), __float_as_uint(v), false, false); return __uint_as_float(r[0]) + __uint_as_float(r[1]); }
__device__ __forceinline__ float sum32x(float v) { const auto r = __builtin_amdgcn_permlane32_swap(__float_as_uint(v), __float_as_uint(v), false, false); return __uint_as_float(r[0]) + __uint_as_float(r[1]); }
__device__ __forceinline__ float max16x(float v) { const auto r = __builtin_amdgcn_permlane16_swap(__float_as_uint(v), __float_as_uint(v), false, false); return fmaxf(__uint_as_float(r[0]), __uint_as_float(r[1])); }
__device__ __forceinline__ float max32x(float v) { const auto r = __builtin_amdgcn_permlane32_swap(__float_as_uint(v), __float_as_uint(v), false, false); return fmaxf(__uint_as_float(r[0]), __uint_as_float(r[1])); }
__device__ __forceinline__ int isum16x(int v) { const auto r = __builtin_amdgcn_permlane16_swap((unsigned)v, (unsigned)v, false, false); return (int)(r[0] + r[1]); }
__device__ __forceinline__ int isum32x(int v) { const auto r = __builtin_amdgcn_permlane32_swap((unsigned)v, (unsigned)v, false, false); return (int)(r[0] + r[1]); }
__device__ __forceinline__ float wave_sum(float v) { v += dppf<DPP_X1>(v); v += dppf<DPP_X2>(v); v += dppf<DPP_HM>(v); v += dppf<DPP_RM>(v); return sum32x(sum16x(v)); }
__device__ __forceinline__ float wave_max(float v) { v = fmaxf(v, dppf<DPP_X1>(v)); v = fmaxf(v, dppf<DPP_X2>(v)); v = fmaxf(v, dppf<DPP_HM>(v)); v = fmaxf(v, dppf<DPP_RM>(v)); return max32x(max16x(v)); }
__device__ __forceinline__ int wave_isum(int v) { v += dppi<DPP_X1>(v); v += dppi<DPP_X2>(v); v += dppi<DPP_HM>(v); v += dppi<DPP_RM>(v); return isum32x(isum16x(v)); }
__device__ __forceinline__ float max_x8_16_32(float v) { v = fmaxf(v, dppf<DPP_X8>(v)); return max32x(max16x(v)); }
__device__ __forceinline__ float ex2(float x) { return __builtin_amdgcn_exp2f(x); }
__device__ __forceinline__ float lg2(float x) { return __builtin_amdgcn_logf(x); }

#define XB_TMO      128
#define XB_XCNT(j)  (256  + 64 * (j))
#define XB_XSUB(j)  (1280 + 64 * (j))
#define XB_XGEN(j)  (2304 + 64 * (j))
#define XB_TOP      3328
#define XB_TOPGEN   3392
#define XB_LSUB(j)  (3456 + 64 * (j))
#define XB_LGEN(j)  (4480 + 64 * (j))
#define XCD_BAR_WORDS 5504
#define XB_SPIN_CAP (1u << 18)

__device__ __forceinline__ unsigned xb_ld(unsigned* p)              { return __hip_atomic_load(p, __ATOMIC_RELAXED, __HIP_MEMORY_SCOPE_AGENT); }
__device__ __forceinline__ unsigned xb_add(unsigned* p, unsigned v) { return __hip_atomic_fetch_add(p, v, __ATOMIC_RELAXED, __HIP_MEMORY_SCOPE_AGENT); }
__device__ __forceinline__ unsigned xb_xcc_id() { return (unsigned)__builtin_amdgcn_s_getreg((3 << 11) | 20) & 0xFu; }
#define XB_SPIN(cond, bar) do { unsigned _sp = 0; while (cond) { __builtin_amdgcn_s_sleep(1); \
    if ((++_sp & 255u) == 0u) { if (xb_ld(&(bar)[XB_TMO])) break; if (_sp > XB_SPIN_CAP) { atomicAdd(&(bar)[XB_TMO], 1u); break; } } } } while (0)

struct XcdBarrier {
    unsigned* bar; unsigned x;
    volatile LAS unsigned* st;
};

__device__ __forceinline__ XcdBarrier xcd_barrier_post(unsigned* bar, volatile LAS unsigned* st) {
    XcdBarrier b; b.bar = bar; b.x = xb_xcc_id(); b.st = st;
    if (threadIdx.x == 0) st[3] = 1u + xb_add(&bar[XB_XCNT(b.x)], 1u);
    return b;
}
__device__ __forceinline__ void xcd_barrier_complete(unsigned* bar, unsigned x, unsigned& nloc, unsigned& nx, unsigned& reg32) {
    const unsigned G = gridDim.x * gridDim.y * gridDim.z;
    unsigned sum, cnt, mine, n32, sp = 0u;
    for (;;) {
        sum = 0u; cnt = 0u; mine = 0u; n32 = 0u;
#pragma unroll
        for (unsigned j = 0; j < 16; ++j) { const unsigned c = xb_ld(&bar[XB_XCNT(j)]); sum += c; cnt += (c > 0u) ? 1u : 0u; n32 += (c == 32u && j < 8u) ? 1u : 0u; mine = (j == x) ? c : mine; }
        if (sum == G) break;
        __builtin_amdgcn_s_sleep(1);
        if ((++sp & 255u) == 0u) { if (xb_ld(&bar[XB_TMO])) break; if (sp > XB_SPIN_CAP) { atomicAdd(&bar[XB_TMO], 1u); break; } }
    }
    nloc = mine > 0u ? mine : 1u; nx = cnt > 0u ? cnt : 1u;
    reg32 = (sum == G && G == 256u && n32 == 8u) ? 1u : 0u;
}

__device__ __forceinline__ void xcd_barrier(const XcdBarrier& b) {
    asm volatile("s_waitcnt vmcnt(0)" ::: "memory");
    __syncthreads();
    if (threadIdx.x == 0) {
        unsigned* bar = b.bar;
        __builtin_amdgcn_s_waitcnt(0);
        unsigned nloc = b.st[0], nx = b.st[1];
        if (nloc == 0u) { unsigned r32; xcd_barrier_complete(bar, b.x, nloc, nx, r32); b.st[0] = nloc; b.st[1] = nx; b.st[2] = 1u + r32; }
        const unsigned old = xb_add(&bar[XB_XSUB(b.x)], 1u);
        const unsigned gen = old / nloc;
        if (old + 1u == (gen + 1u) * nloc) {
            __builtin_amdgcn_fence(__ATOMIC_RELEASE, "agent");
            asm volatile("s_waitcnt vmcnt(0)" ::: "memory");
            const unsigned og = xb_add(&bar[XB_TOP], 1u);
            const unsigned tg = og / nx;
            if (og + 1u == (tg + 1u) * nx) xb_add(&bar[XB_TOPGEN], 1u);
            else XB_SPIN(xb_ld(&bar[XB_TOPGEN]) == tg, bar);
            __builtin_amdgcn_fence(__ATOMIC_ACQUIRE, "agent");
            xb_add(&bar[XB_XGEN(b.x)], 1u);
            asm volatile("s_waitcnt vmcnt(0)" ::: "memory");
        } else {
            XB_SPIN(xb_ld(&bar[XB_XGEN(b.x)]) == gen, bar);
            __builtin_amdgcn_fence(__ATOMIC_ACQUIRE, "agent");
            asm volatile("s_waitcnt vmcnt(0)" ::: "memory");
        }
    }
    __syncthreads();
}

__device__ __forceinline__ void xcd_barrier_local(const XcdBarrier& b) {
    asm volatile("s_waitcnt vmcnt(0)" ::: "memory");
    __syncthreads();
    if (threadIdx.x == 0) {
        unsigned* bar = b.bar;
        __builtin_amdgcn_s_waitcnt(0);
        const unsigned old = xb_add(&bar[XB_LSUB(b.x)], 1u);
        const unsigned gen = old >> 5;
        if (((old + 1u) & 31u) == 0u) xb_add(&bar[XB_LGEN(b.x)], 1u);
        else XB_SPIN(xb_ld(&bar[XB_LGEN(b.x)]) == gen, bar);
        __builtin_amdgcn_fence(__ATOMIC_ACQUIRE, "agent");
        asm volatile("s_waitcnt vmcnt(0)" ::: "memory");
    }
    __syncthreads();
}

struct Ctx { LAS unsigned char* lds; int tid, lane, wave, vcu, G; };
__device__ __forceinline__ Ctx phase_ctx(const Ctx& C0) { Ctx C = C0; int t = C0.tid; asm volatile("" : "+v"(t)); C.tid = t; C.lane = t & 63; return C; }
enum { IN_X = 0, IN_C, IN_RELB, IN_MODW, IN_MODB, IN_NMIX, IN_NFFN, IN_AWQKV, IN_AWO, IN_KVNG, IN_KVMW, IN_KVMB, IN_BWKV, IN_BWQ, IN_BWO, IN_W13, IN_W2, IN_RW, IN_MW13, IN_MW2, IN_FNG, IN_OUT, IN_WS, IN_COUNT };
__device__ __forceinline__ unsigned long long ptr_bits(const Ctx& C, int k) {
    volatile LAS unsigned long long* t = (volatile LAS unsigned long long*)(C.lds + PTR_OFF);
    const unsigned long long v = t[k];
    const unsigned lo = __builtin_amdgcn_readfirstlane((unsigned)v), hi = __builtin_amdgcn_readfirstlane((unsigned)(v >> 32));
    return ((unsigned long long)hi << 32) | lo; }
__device__ __forceinline__ const float* inp(const Ctx& C, int k) { return (const float*)ptr_bits(C, k); }
__device__ __forceinline__ float* outp(const Ctx& C) { return (float*)ptr_bits(C, IN_OUT); }
__device__ __forceinline__ unsigned char* wsp(const Ctx& C) { return (unsigned char*)ptr_bits(C, IN_WS); }

__device__ __forceinline__ void tr_load(f32x4 (&v)[8], const float* W, int N, int cs, int k0, int lane) {
#pragma unroll
    for (int i = 0; i < 8; ++i) v[i] = *(const GAS f32x4*)(W + (size_t)(k0 + 8 * i + (lane >> 3)) * N + cs + 4 * (lane & 7));
}
template <bool F8>
__device__ __forceinline__ void tr_item(const f32x4 (&v)[8], int K, bf16* WT, int rd, int k0, LAS float* scr, int lane) {
#pragma unroll
    for (int i = 0; i < 8; ++i) { LAS float* d = scr + (8 * i + (lane >> 3)) * 33 + 4 * (lane & 7); d[0] = v[i].x; d[1] = v[i].y; d[2] = v[i].z; d[3] = v[i].w; }
    LDS_WAIT(); asm volatile("" ::: "memory");
    const int c = lane & 7;
    if (F8) {
#pragma unroll
        for (int j = 0; j < 4; ++j) { const int n = (lane >> 3) + 8 * j; const LAS float* s = scr + (8 * c) * 33 + n;
            v2u o; o.x = pg8::pk4_fp8(s[0 * 33] * WSCALE8, s[1 * 33] * WSCALE8, s[2 * 33] * WSCALE8, s[3 * 33] * WSCALE8); o.y = pg8::pk4_fp8(s[4 * 33] * WSCALE8, s[5 * 33] * WSCALE8, s[6 * 33] * WSCALE8, s[7 * 33] * WSCALE8);
            *(GAS v2u*)((unsigned char*)WT + (size_t)(rd + n) * K + k0 + 8 * c) = o; }
    } else {
#pragma unroll
        for (int j = 0; j < 4; ++j) { const int n = (lane >> 3) + 8 * j; const LAS float* s = scr + (8 * c) * 33 + n;
            v4u o; o.x = pk2(s[0 * 33], s[1 * 33]); o.y = pk2(s[2 * 33], s[3 * 33]); o.z = pk2(s[4 * 33], s[5 * 33]); o.w = pk2(s[6 * 33], s[7 * 33]);
            *(GAS v4u*)(WT + (size_t)(rd + n) * K + k0 + 8 * c) = o; }
    }
    LDS_WAIT(); asm volatile("" ::: "memory");
}
template <bool F8>
__device__ __forceinline__ void tr_group(const float* src, bf16* dst, int K, int N, int F, int cnt, int& it, int NTW, LAS float* scr, int lane) {
    const int nblk = N / 32, ipm = (K / 64) * nblk, total = cnt * ipm;
#define TRG_LOAD(vv, it_) do { const int mi_ = (it_) / ipm, r_ = (it_) - mi_ * ipm, kb_ = r_ / nblk, rd_ = 32 * (r_ - kb_ * nblk); int cs_ = rd_; \
        if (F) { const int j_ = rd_ >> 8, w_ = rd_ & 255; cs_ = (w_ < 128) ? 128 * j_ + w_ : F + 128 * j_ + (w_ - 128); } tr_load(vv, src + (size_t)mi_ * K * N, N, cs_, 64 * kb_, lane); } while (0)
    f32x4 v[8], vn[8];
    if (it < total) TRG_LOAD(v, it);
    for (; it < total; it += NTW) {
        const int mi = it / ipm, r = it - mi * ipm, kb = r / nblk, nb = r - kb * nblk, rd = 32 * nb;
        if (it + NTW < total) TRG_LOAD(vn, it + NTW);
        tr_item<F8>(v, K, F8 ? (bf16*)((unsigned char*)dst + (size_t)mi * K * N) : dst + (size_t)mi * K * N, rd, 64 * kb, scr, lane);
#pragma unroll
        for (int i = 0; i < 8; ++i) v[i] = vn[i];
    }
#undef TRG_LOAD
    it -= total;
}
__device__ __forceinline__ unsigned q8b(float x) { return __float_as_uint(x + 12582912.0f) & 0xffu; }
__device__ __forceinline__ void tr_group_i8(const float* src, unsigned char* dst, float* sBout, int K, int N, int F, int cnt, int& it, int NTW, LAS float* scr, int lane) {
    const int nblk = N / 32, total = cnt * nblk;
    for (; it < total; it += NTW) {
        const int mi = it / nblk, nb = it - mi * nblk, rd = 32 * nb;
        int cs = rd; if (F) { const int j = rd >> 8, w = rd & 255; cs = (w < 128) ? 128 * j + w : F + 128 * j + (w - 128); }
        const float* W = src + (size_t)mi * K * N + cs + 4 * (lane & 7);
        f32x4 mx = (f32x4){0.f, 0.f, 0.f, 0.f};
#pragma unroll 2
        for (int kb = 0; kb < K / 64; ++kb) {
#pragma unroll
            for (int i = 0; i < 8; ++i) { const f32x4 v = *(const GAS f32x4*)(W + (size_t)(64 * kb + 8 * i + (lane >> 3)) * N);
                mx.x = fmaxf(mx.x, fabsf(v.x)); mx.y = fmaxf(mx.y, fabsf(v.y)); mx.z = fmaxf(mx.z, fabsf(v.z)); mx.w = fmaxf(mx.w, fabsf(v.w)); } }
        mx.x = max_x8_16_32(mx.x); mx.y = max_x8_16_32(mx.y); mx.z = max_x8_16_32(mx.z); mx.w = max_x8_16_32(mx.w);
        f32x4 inv, sc;
        inv.x = mx.x > 0.f ? 127.0f / mx.x : 0.f; inv.y = mx.y > 0.f ? 127.0f / mx.y : 0.f; inv.z = mx.z > 0.f ? 127.0f / mx.z : 0.f; inv.w = mx.w > 0.f ? 127.0f / mx.w : 0.f;
        sc = mx * (1.0f / 127.0f);
        if ((lane >> 3) == 0) *(GAS f32x4*)(sBout + (size_t)mi * N + rd + 4 * (lane & 7)) = sc;
        unsigned char* WT = dst + ((size_t)mi * N + rd) * K;
        for (int kb = 0; kb < K / 64; ++kb) {
            f32x4 v[8];
#pragma unroll
            for (int i = 0; i < 8; ++i) v[i] = *(const GAS f32x4*)(W + (size_t)(64 * kb + 8 * i + (lane >> 3)) * N);
#pragma unroll
            for (int i = 0; i < 8; ++i) { LAS float* d = scr + (8 * i + (lane >> 3)) * 33 + 4 * (lane & 7); d[0] = v[i].x * inv.x; d[1] = v[i].y * inv.y; d[2] = v[i].z * inv.z; d[3] = v[i].w * inv.w; }
            LDS_WAIT(); asm volatile("" ::: "memory");
            const int c = lane & 7;
#pragma unroll
            for (int j = 0; j < 4; ++j) { const int n = (lane >> 3) + 8 * j; const LAS float* s = scr + (8 * c) * 33 + n;
                v2u o; o.x = q8b(s[0 * 33]) | (q8b(s[1 * 33]) << 8) | (q8b(s[2 * 33]) << 16) | (q8b(s[3 * 33]) << 24); o.y = q8b(s[4 * 33]) | (q8b(s[5 * 33]) << 8) | (q8b(s[6 * 33]) << 16) | (q8b(s[7 * 33]) << 24);
                *(GAS v2u*)(WT + (size_t)n * K + 64 * kb + 8 * c) = o; }
            LDS_WAIT(); asm volatile("" ::: "memory");
        }
    }
    it -= total;
}
__device__ __forceinline__ void i8_wg_group(const Ctx& C, const float* src, unsigned char* dst, float* sBout, int N, int F, int cnt, int& it, LAS float* scr) {
    constexpr int K = D;
    const int lane = C.lane, nblk = N / 32, total = cnt * nblk;
    LAS float* pmax = (LAS float*)(C.lds + 69632);
#define I8WG_SRC(it_) ([&](int i_) { const int mi_ = i_ / nblk, rd_ = 32 * (i_ - mi_ * nblk); int cs_ = rd_; if (F) { const int j_ = rd_ >> 8, w_ = rd_ & 255; cs_ = (w_ < 128) ? 128 * j_ + w_ : F + 128 * j_ + (w_ - 128); } \
        return src + (size_t)mi_ * K * N + (size_t)(128 * C.wave + (lane >> 3)) * N + cs_ + 4 * (lane & 7); })(it_)
    f32x4 v[16], vn[16];
    if (it < total) { const float* W0 = I8WG_SRC(it);
#pragma unroll
        for (int i = 0; i < 16; ++i) v[i] = *(const GAS f32x4*)(W0 + (size_t)(8 * i) * N); }
    for (; it < total; it += C.G) {
        const int mi = it / nblk, nb = it - mi * nblk, rd = 32 * nb, par = (it / C.G) & 1;
        f32x4 mx = (f32x4){0.f, 0.f, 0.f, 0.f};
#pragma unroll
        for (int i = 0; i < 16; ++i) { mx.x = fmaxf(mx.x, fabsf(v[i].x)); mx.y = fmaxf(mx.y, fabsf(v[i].y)); mx.z = fmaxf(mx.z, fabsf(v[i].z)); mx.w = fmaxf(mx.w, fabsf(v[i].w)); }
        mx.x = max_x8_16_32(mx.x); mx.y = max_x8_16_32(mx.y); mx.z = max_x8_16_32(mx.z); mx.w = max_x8_16_32(mx.w);
        if (lane < 8) *(LAS f32x4*)(pmax + (par * 8 + C.wave) * 32 + 4 * lane) = mx;
        __syncthreads();
        if (it + C.G < total) { const float* Wn = I8WG_SRC(it + C.G);
#pragma unroll
            for (int i = 0; i < 16; ++i) vn[i] = *(const GAS f32x4*)(Wn + (size_t)(8 * i) * N); }
#pragma unroll
        for (int w = 0; w < 8; ++w) { const f32x4 p = *(const LAS f32x4*)(pmax + (par * 8 + w) * 32 + 4 * (lane & 7)); mx.x = fmaxf(mx.x, p.x); mx.y = fmaxf(mx.y, p.y); mx.z = fmaxf(mx.z, p.z); mx.w = fmaxf(mx.w, p.w); }
        f32x4 inv;
        inv.x = mx.x > 0.f ? 127.0f / mx.x : 0.f; inv.y = mx.y > 0.f ? 127.0f / mx.y : 0.f; inv.z = mx.z > 0.f ? 127.0f / mx.z : 0.f; inv.w = mx.w > 0.f ? 127.0f / mx.w : 0.f;
        if (C.wave == 0 && lane < 8) *(GAS f32x4*)(sBout + (size_t)mi * N + rd + 4 * lane) = mx * (1.0f / 127.0f);
        unsigned char* WT = dst + ((size_t)mi * N + rd) * K + 128 * C.wave;
#pragma unroll
        for (int hf = 0; hf < 2; ++hf) {
#pragma unroll
            for (int i = 0; i < 8; ++i) { LAS float* d = scr + (8 * i + (lane >> 3)) * 33 + 4 * (lane & 7); const f32x4 x = v[8 * hf + i]; d[0] = x.x * inv.x; d[1] = x.y * inv.y; d[2] = x.z * inv.z; d[3] = x.w * inv.w; }
            LDS_WAIT(); asm volatile("" ::: "memory");
            const int c = lane & 7;
#pragma unroll
            for (int j = 0; j < 4; ++j) { const int n = (lane >> 3) + 8 * j; const LAS float* sp = scr + (8 * c) * 33 + n;
                v2u o; o.x = q8b(sp[0 * 33]) | (q8b(sp[1 * 33]) << 8) | (q8b(sp[2 * 33]) << 16) | (q8b(sp[3 * 33]) << 24); o.y = q8b(sp[4 * 33]) | (q8b(sp[5 * 33]) << 8) | (q8b(sp[6 * 33]) << 16) | (q8b(sp[7 * 33]) << 24);
                *(GAS v2u*)(WT + (size_t)n * K + 64 * hf + 8 * c) = o; }
            LDS_WAIT(); asm volatile("" ::: "memory");
        }
#pragma unroll
        for (int i = 0; i < 16; ++i) v[i] = vn[i];
    }
#undef I8WG_SRC
    it -= total;
}
__device__ __forceinline__ void gemv_mod(const Ctx& C, int w) {
    const float* Wm; const float* bias; int N, j0, ooff;
    if (w < 192) { const int l = w / 48, cb = w % 48; Wm = inp(C, IN_MODW) + (size_t)l * D * MODW; bias = inp(C, IN_MODB) + l * MODW; N = MODW; j0 = 128 * cb; ooff = l * MODW + j0; }
    else { const int cb = w - 192; Wm = inp(C, IN_KVMW); bias = inp(C, IN_KVMB); N = 2 * D; j0 = 128 * cb; ooff = KVMOD + j0; }
    const LAS f32x4* tab = (const LAS f32x4*)(C.lds + 65536) + 2 * 128 * C.wave;
    const GAS f32x2* wp = (const GAS f32x2*)(Wm + (size_t)(128 * C.wave) * N + j0) + C.lane;
    const size_t rs = (size_t)(N / 2);
    float a0[8], a1[8];
#pragma unroll
    for (int b = 0; b < 8; ++b) { a0[b] = 0.f; a1[b] = 0.f; }
#pragma unroll 16
    for (int k = 0; k < 128; ++k) {
        const f32x2 wv = wp[(size_t)k * rs]; const f32x4 s0 = tab[2 * k], s1 = tab[2 * k + 1];
        a0[0] += s0.x * wv.x; a1[0] += s0.x * wv.y; a0[1] += s0.y * wv.x; a1[1] += s0.y * wv.y; a0[2] += s0.z * wv.x; a1[2] += s0.z * wv.y; a0[3] += s0.w * wv.x; a1[3] += s0.w * wv.y;
        a0[4] += s1.x * wv.x; a1[4] += s1.x * wv.y; a0[5] += s1.y * wv.x; a1[5] += s1.y * wv.y; a0[6] += s1.z * wv.x; a1[6] += s1.z * wv.y; a0[7] += s1.w * wv.x; a1[7] += s1.w * wv.y;
    }
    LAS float* part = (LAS float*)(C.lds + 98304);
#pragma unroll
    for (int b = 0; b < 8; ++b) *(LAS f32x2*)(part + (C.wave * 8 + b) * 128 + 2 * C.lane) = (f32x2){a0[b], a1[b]};
    __syncthreads();
    float* mod = (float*)(wsp(C) + WS_MOD);
#pragma unroll
    for (int j = 0; j < 2; ++j) { const int idx = C.tid + 512 * j, b = idx >> 7, col = idx & 127; float s = bias[j0 + col];
#pragma unroll
        for (int ww = 0; ww < 8; ++ww) s += part[(ww * 8 + b) * 128 + col];
        mod[(size_t)b * MODLD + ooff + col] = s; }
    __syncthreads();
}
__device__ __forceinline__ void p0_prologue(const Ctx& C0) {
    const Ctx C = phase_ctx(C0);
    const int wg = (int)blockIdx.x;
    if (wg < 208) {
        LAS float* tab = (LAS float*)(C.lds + 65536);
        for (int idx = C.tid; idx < NB * D; idx += NWAVES * 64) { const int b = idx >> 10, k = idx & 1023; const float v = inp(C, IN_C)[idx]; tab[k * 8 + b] = v / (1.0f + __expf(-v)); }
        __syncthreads();
        gemv_mod(C, wg);
    } else if (wg < 224 && C.wave == 7) {
        const int h = wg - 208; float* bt = (float*)(wsp(C) + WS_BIAS) + h * 1024;
        for (int i = 0; i < 16; ++i) { const int d = C.lane + 64 * i; int bk;
            if (d < 16) bk = d; else { bk = 16 + (int)(logf((float)d / 16.0f) / 4.1588830833596715f * 16.0f); bk = bk > 31 ? 31 : bk; }
            bt[d] = inp(C, IN_RELB)[bk * NH + h] * LOG2E; }
    }
    {
        LAS float* scr = (LAS float*)(C.lds + C.wave * 8704);
        unsigned char* ws = wsp(C);
        int itg = wg;
        i8_wg_group(C, inp(C, IN_MW13), ws + WS_MW13, (float*)(ws + WS_SBM13), 2 * FFE, FFE, 16, itg, scr);
        i8_wg_group(C, inp(C, IN_W13), ws + WS_W13, (float*)(ws + WS_SB13), 2 * FF, FF, 2, itg, scr);
        i8_wg_group(C, inp(C, IN_AWQKV), ws + WS_WQKV, (float*)(ws + WS_SBQKV), 3 * D, 0, 2, itg, scr);
        i8_wg_group(C, inp(C, IN_BWKV), ws + WS_WKV, (float*)(ws + WS_SBKV), 2 * D, 0, 1, itg, scr);
        i8_wg_group(C, inp(C, IN_BWQ), ws + WS_WQ, (float*)(ws + WS_SBQ), D, 0, 2, itg, scr);
        int it = wg * NWAVES + C.wave; const int NTW = C.G * NWAVES;
        tr_group<true>(inp(C, IN_MW2), (bf16*)(ws + WS_MW2), FFE, D, 0, 16, it, NTW, scr, C.lane);
        tr_group<true>(inp(C, IN_W2), (bf16*)(ws + WS_W2), FF, D, 0, 2, it, NTW, scr, C.lane);
        tr_group<true>(inp(C, IN_AWO), (bf16*)(ws + WS_WO), D, D, 0, 2, it, NTW, scr, C.lane);
        tr_group<true>(inp(C, IN_BWO), (bf16*)(ws + WS_WBO), D, D, 0, 2, it, NTW, scr, C.lane);
    }
}

__device__ __forceinline__ void tail_row(v2u (&y)[4], const unsigned char* ws, int ts, int lane) {
    f32x4 p[TAIL_NS][4];
#pragma unroll
    for (int k = 0; k < TAIL_NS; ++k)
#pragma unroll
        for (int j = 0; j < 4; ++j) p[k][j] = ((const GAS f32x4*)((const float*)(ws + WS_YT) + ((size_t)k * TAIL_ROWS + ts) * D) + lane)[64 * j];
#pragma unroll
    for (int j = 0; j < 4; ++j) { f32x4 a = p[0][j];
#pragma unroll
        for (int k = 1; k < TAIL_NS; ++k) a += p[k][j];
        y[j] = (v2u){pk2(a.x, a.y), pk2(a.z, a.w)}; }
}
template <bool COMBINE, bool KV2, bool ROUTER, bool FINAL, bool F8OUT = false, bool XIN_F32 = false>
__device__ __forceinline__ void token_phase(const Ctx& C0, const void* xin, void* xout, const float* gnorm, int off_sh, int off_sc, bf16* XNo, int off_gf, const float* router) {
    const Ctx C = phase_ctx(C0);
    const int gw = C.vcu * NWAVES + C.wave, r0 = gw * 16, b = r0 >> 12, lane = C.lane;
    unsigned char* const ws = wsp(C);
    const float* modb = (const float*)(ws + WS_MOD) + (size_t)b * MODLD;
    const float* kvng = KV2 ? inp(C, IN_KVNG) : nullptr;
    f32x4 A[4], Bv[4], A2[4], B2[4], GF[4];
#pragma unroll
    for (int j = 0; j < 4; ++j) { const int col = 256 * j + 4 * lane;
        const f32x4 g = *(const f32x4*)(gnorm + col);
        if (FINAL) { A[j] = g; Bv[j] = (f32x4){0.f, 0.f, 0.f, 0.f}; }
        else { const f32x4 sc = *(const f32x4*)(modb + off_sc + col); A[j] = g * (sc + 1.0f); Bv[j] = *(const f32x4*)(modb + off_sh + col); }
        if (KV2) { const f32x4 g2 = *(const f32x4*)(kvng + col), sc2 = *(const f32x4*)(modb + KVMOD + D + col); A2[j] = g2 * (sc2 + 1.0f); B2[j] = *(const f32x4*)(modb + KVMOD + col); }
        if (COMBINE) GF[j] = *(const f32x4*)(modb + off_gf + col);
    }
    LAS int* rt = (LAS int*)(C.lds + ROUTE_OFF);
    if (ROUTER) {
        LAS float* rw = (LAS float*)C.lds;
        for (int i = C.tid; i < D * NE; i += NWAVES * 64) rw[i] = router[i];
        if (C.tid < 8) rt[RT_HIST + C.tid] = 0;
        __syncthreads();
    }
    int cnt[8];
#pragma unroll
    for (int e = 0; e < 8; ++e) cnt[e] = 0;
    const bf16* Y2 = (const bf16*)(ws + WS_XG);
    const int* tslot = (const int*)(ws + WS_TOKS); const float* tw = (const float*)(ws + WS_TOKW);
    constexpr int RG = 4;
    for (int i0 = 0; i0 < 16; i0 += RG) {
      f32x4 vin[RG][4]; v2u ya_[RG][4], yc_[RG][4]; float w0_[RG], w1_[RG]; int sl0_[RG], sl1_[RG];
#pragma unroll
      for (int rr = 0; rr < RG; ++rr) { const int row = r0 + i0 + rr;
        if (XIN_F32) { const GAS f32x4* xr = (const GAS f32x4*)((const float*)xin + (size_t)row * D) + lane;
#pragma unroll
            for (int j = 0; j < 4; ++j) vin[rr][j] = xr[64 * j];
        } else { const GAS v2u* xr = (const GAS v2u*)((const bf16*)xin + (size_t)row * D) + lane;
#pragma unroll
            for (int j = 0; j < 4; ++j) { const v2u w = xr[64 * j]; vin[rr][j] = (f32x4){bflo(w.x), bfhi(w.x), bflo(w.y), bfhi(w.y)}; } }
        if (COMBINE) {
            const int s0 = tslot[2 * row], s1 = tslot[2 * row + 1]; w0_[rr] = tw[2 * row]; w1_[rr] = tw[2 * row + 1]; sl0_[rr] = __builtin_amdgcn_readfirstlane(s0); sl1_[rr] = __builtin_amdgcn_readfirstlane(s1);
            const GAS v2u* y0 = (const GAS v2u*)(Y2 + (size_t)(s0 < 65536 ? s0 : 0) * D) + lane; const GAS v2u* y1 = (const GAS v2u*)(Y2 + (size_t)(s1 < 65536 ? s1 : 0) * D) + lane;
#pragma unroll
            for (int j = 0; j < 4; ++j) { ya_[rr][j] = y0[64 * j]; yc_[rr][j] = y1[64 * j]; } } }
      if (COMBINE) {
        int anyt = 0;
#pragma unroll
        for (int rr = 0; rr < RG; ++rr) anyt |= (sl0_[rr] | sl1_[rr]) >> 16;
        if (anyt) {
#pragma unroll
            for (int rr = 0; rr < RG; ++rr) {
                if (sl0_[rr] >= 65536) { tail_row(ya_[rr], ws, sl0_[rr] - 65536, lane); asm volatile("" ::: "memory"); }
                if (sl1_[rr] >= 65536) { tail_row(yc_[rr], ws, sl1_[rr] - 65536, lane); asm volatile("" ::: "memory"); } } } }
#pragma unroll
      for (int rr = 0; rr < RG; ++rr) {
        const int row = r0 + i0 + rr;
        f32x4 v[4];
#pragma unroll
        for (int j = 0; j < 4; ++j) v[j] = vin[rr][j];
        if (COMBINE) {
#pragma unroll
            for (int j = 0; j < 4; ++j) { const v2u a = ya_[rr][j], c = yc_[rr][j];
                f32x4 ya = (f32x4){bflo(a.x), bfhi(a.x), bflo(a.y), bfhi(a.y)}, yc = (f32x4){bflo(c.x), bfhi(c.x), bflo(c.y), bfhi(c.y)};
                v[j] = v[j] + GF[j] * (ya * w0_[rr] + yc * w1_[rr]); }
            if (!FINAL) { GAS v2u* xo = (GAS v2u*)((bf16*)xout + (size_t)row * D) + lane;
#pragma unroll
                for (int j = 0; j < 4; ++j) xo[64 * j] = (v2u){pk2(v[j].x, v[j].y), pk2(v[j].z, v[j].w)}; }
        }
        float ss = 0.f;
#pragma unroll
        for (int j = 0; j < 4; ++j) ss += (v[j].x * v[j].x + v[j].y * v[j].y) + (v[j].z * v[j].z + v[j].w * v[j].w);
        const float rstd = 1.0f / sqrtf(wave_sum(ss) * (1.0f / D) + RMS_EPS);
        f32x4 hv[4];
#pragma unroll
        for (int j = 0; j < 4; ++j) hv[j] = (v[j] * rstd) * A[j] + Bv[j];
        if (FINAL) { GAS f32x4* xo = (GAS f32x4*)((float*)xout + (size_t)row * D) + lane;
#pragma unroll
            for (int j = 0; j < 4; ++j) xo[64 * j] = hv[j];
        } else if (F8OUT) { GAS unsigned* o4 = (GAS unsigned*)((unsigned char*)XNo + (size_t)row * D) + lane;
            float am = 0.f;
#pragma unroll
            for (int j = 0; j < 4; ++j) am = fmaxf(am, fmaxf(fmaxf(fabsf(hv[j].x), fabsf(hv[j].y)), fmaxf(fabsf(hv[j].z), fabsf(hv[j].w))));
            am = wave_max(am); const float inv = am > 0.f ? 127.0f / am : 0.f;
            if (lane == 0) ((float*)(ws + WS_SA))[row] = am * (1.0f / 127.0f);
#pragma unroll
            for (int j = 0; j < 4; ++j) o4[64 * j] = q8b(hv[j].x * inv) | (q8b(hv[j].y * inv) << 8) | (q8b(hv[j].z * inv) << 16) | (q8b(hv[j].w * inv) << 24);
        } else { GAS v2u* o8 = (GAS v2u*)(XNo + (size_t)row * D) + lane;
#pragma unroll
            for (int j = 0; j < 4; ++j) o8[64 * j] = (v2u){pk2(hv[j].x, hv[j].y), pk2(hv[j].z, hv[j].w)}; }
        if (KV2) { GAS unsigned* o4 = (GAS unsigned*)(ws + WS_XN2 + (size_t)row * D) + lane; f32x4 h2[4]; float am = 0.f;
#pragma unroll
            for (int j = 0; j < 4; ++j) { h2[j] = (v[j] * rstd) * A2[j] + B2[j]; am = fmaxf(am, fmaxf(fmaxf(fabsf(h2[j].x), fabsf(h2[j].y)), fmaxf(fabsf(h2[j].z), fabsf(h2[j].w)))); }
            am = wave_max(am); const float inv = am > 0.f ? 127.0f / am : 0.f;
            if (lane == 0) ((float*)(ws + WS_SA2))[row] = am * (1.0f / 127.0f);
#pragma unroll
            for (int j = 0; j < 4; ++j) o4[64 * j] = q8b(h2[j].x * inv) | (q8b(h2[j].y * inv) << 8) | (q8b(h2[j].z * inv) << 16) | (q8b(h2[j].w * inv) << 24); }
        if (ROUTER) {
            const LAS f32x4* rw = (const LAS f32x4*)C.lds;
            f32x4 p0 = (f32x4){0.f, 0.f, 0.f, 0.f}, p1 = p0;
#pragma unroll
            for (int j = 0; j < 4; ++j) { const int col = 256 * j + 4 * lane;
                p0 += rw[2 * col + 0] * hv[j].x; p1 += rw[2 * col + 1] * hv[j].x; p0 += rw[2 * col + 2] * hv[j].y; p1 += rw[2 * col + 3] * hv[j].y;
                p0 += rw[2 * col + 4] * hv[j].z; p1 += rw[2 * col + 5] * hv[j].z; p0 += rw[2 * col + 6] * hv[j].w; p1 += rw[2 * col + 7] * hv[j].w; }
            float p[8] = {wave_sum(p0.x), wave_sum(p0.y), wave_sum(p0.z), wave_sum(p0.w), wave_sum(p1.x), wave_sum(p1.y), wave_sum(p1.z), wave_sum(p1.w)};
            int e0 = 0; float v0 = p[0];
#pragma unroll
            for (int e = 1; e < 8; ++e) if (p[e] > v0) { v0 = p[e]; e0 = e; }
            int e1 = 0; float v1 = -INFINITY;
#pragma unroll
            for (int e = 0; e < 8; ++e) if (e != e0 && p[e] > v1) { v1 = p[e]; e1 = e; }
            const float w0 = 1.0f / (1.0f + __expf(v1 - v0)), w1 = 1.0f - w0;
            if (lane == 0) { ((int*)(ws + WS_TOKE))[row] = e0 | (e1 << 8); *(f32x2*)((float*)(ws + WS_TOKW) + 2 * row) = (f32x2){w0, w1}; }
#pragma unroll
            for (int e = 0; e < 8; ++e) cnt[e] += (e == e0 || e == e1) ? 1 : 0;
        }
      }
    }
    if (ROUTER) {
        if (lane == 0) {
#pragma unroll
            for (int e = 0; e < 8; ++e) __hip_atomic_fetch_add(rt + RT_HIST + e, cnt[e], __ATOMIC_RELAXED, __HIP_MEMORY_SCOPE_WORKGROUP);
        }
        __syncthreads();
        if (C.tid < 8) ((int*)(ws + WS_HIST))[C.vcu * 8 + C.tid] = rt[RT_HIST + C.tid];
    }
}

__device__ __forceinline__ void route_phase(const Ctx& C0, const bf16* XN) {
    const Ctx C = phase_ctx(C0);
    LAS int* rt = (LAS int*)(C.lds + ROUTE_OFF);
    unsigned char* const ws = wsp(C);
    const int* hist = (const int*)(ws + WS_HIST);
    { const int e = C.wave; int tot = 0, pre = 0;
#pragma unroll
      for (int i = 0; i < 4; ++i) { const int wg = C.lane + 64 * i; const int v = hist[wg * 8 + e]; tot += v; pre += (wg < C.vcu) ? v : 0; }
      tot = wave_isum(tot); pre = wave_isum(pre);
      if (C.lane == 0) { rt[RT_CNT + e] = tot; rt[RT_BASE + e] = pre; } }
    __syncthreads();
    { int tp[9]; tp[0] = 0;
#pragma unroll
        for (int e = 0; e < 8; ++e) tp[e + 1] = tp[e] + ((rt[RT_CNT + e] + 255) >> 8);
        if (C.tid < 9) { int v = 0;
#pragma unroll
            for (int e = 0; e < 9; ++e) v = (C.tid == e) ? tp[e] : v;
            rt[RT_SEG + C.tid] = v * 256; }
        if (C.tid == 9) rt[RT_NT] = tp[8] < MAXTILES ? tp[8] : MAXTILES;
        if (C.tid < MAXTILES && C.tid < tp[8]) { int e = 0;
#pragma unroll
            for (int k = 1; k < 8; ++k) e += (C.tid >= tp[k]) ? 1 : 0;
            rt[RT_TEXP + C.tid] = e; } }
    __syncthreads();
    const int tok = 128 * C.vcu + (C.tid & 127);
    int e0 = -1, e1 = -1; if (C.tid < 128) { const int ee = ((const int*)(ws + WS_TOKE))[tok]; e0 = ee & 255; e1 = ee >> 8; }
    unsigned long long bal[8];
#pragma unroll
    for (int e = 0; e < 8; ++e) bal[e] = __ballot((e0 == e) || (e1 == e));
    if (C.tid == 0) {
#pragma unroll
        for (int e = 0; e < 8; ++e) rt[RT_WC + e] = __popcll(bal[e]);
    }
    __syncthreads();
    if (C.tid < 128) { int s0 = 0, s1 = 0; const unsigned long long lt = (1ull << C.lane) - 1ull;
#pragma unroll
        for (int e = 0; e < 8; ++e) { const int slot = rt[RT_SEG + e] + rt[RT_BASE + e] + __popcll(bal[e] & lt) + (C.wave == 1 ? rt[RT_WC + e] : 0); if (e0 == e) s0 = slot; if (e1 == e) s1 = slot; }
        ((int*)(ws + WS_TOKS))[2 * tok] = s0; ((int*)(ws + WS_TOKS))[2 * tok + 1] = s1; rt[RT_LS + 2 * C.tid] = s0; rt[RT_LS + 2 * C.tid + 1] = s1; }
    __syncthreads();
    bf16* XG = (bf16*)(ws + WS_XG);
    v4u rowv[16]; float sav = 0.f;
#pragma unroll
    for (int i = 0; i < 16; ++i) { const int t2 = 128 * C.vcu + 16 * C.wave + i; rowv[i] = ((const GAS v4u*)((const unsigned char*)XN + (size_t)t2 * D))[C.lane]; }
    if (C.lane < 16) sav = ((const GAS float*)(ws + WS_SA))[128 * C.vcu + 16 * C.wave + C.lane];
#pragma unroll
    for (int i = 0; i < 16; ++i) { const int tl = 16 * C.wave + i; const int s0 = rt[RT_LS + 2 * tl], s1 = rt[RT_LS + 2 * tl + 1];
        ((GAS v4u*)((unsigned char*)XG + (size_t)s0 * D))[C.lane] = rowv[i]; ((GAS v4u*)((unsigned char*)XG + (size_t)s1 * D))[C.lane] = rowv[i]; }
    if (C.lane < 16) { const int tl = 16 * C.wave + C.lane; ((GAS float*)(ws + WS_SAG))[rt[RT_LS + 2 * tl]] = sav; ((GAS float*)(ws + WS_SAG))[rt[RT_LS + 2 * tl + 1]] = sav; }
}

__device__ __forceinline__ void kmean_phase(const Ctx& C0, const bf16* Kb) {
    const Ctx C = phase_ctx(C0);
    const int gw = C.vcu * NWAVES + C.wave;
    if (gw < 1024) { const int cb = gw & 7, n = (gw >> 3) & 15, b = gw >> 7;
        const GAS unsigned* kp = (const GAS unsigned*)(Kb + ((size_t)(b * SEQ + 256 * n)) * D + 128 * cb) + C.lane; float s0 = 0.f, s1 = 0.f;
#pragma unroll 16
        for (int i = 0; i < 256; ++i) { const unsigned w = kp[(size_t)i * (D / 2)]; s0 += bflo(w); s1 += bfhi(w); }
        const int col = 128 * cb + 2 * C.lane, h = col >> 6, d = col & 63;
        float* km = (float*)(wsp(C) + WS_KMEAN) + ((size_t)((b * NH + h) * 16 + n)) * 64 + d; km[0] = s0 * (1.f / 256.f); km[1] = s1 * (1.f / 256.f); }
}


namespace att {
typedef short bf16x8 __attribute__((ext_vector_type(8)));
typedef float f32x16 __attribute__((ext_vector_type(16)));
typedef short v4i16_t __attribute__((ext_vector_type(4)));
__device__ __forceinline__ unsigned cvtpk(float lo, float hi) { typedef float f2 __attribute__((ext_vector_type(2))); typedef __bf16 b2 __attribute__((ext_vector_type(2))); const f2 v = {lo, hi}; const b2 b = __builtin_convertvector(v, b2); return __builtin_bit_cast(unsigned, b); }
__device__ __forceinline__ float swap32(float x, int hi) { auto rr = __builtin_amdgcn_permlane32_swap(__float_as_uint(x), __float_as_uint(x), false, false); return __uint_as_float(hi ? rr[0] : rr[1]); }
__device__ __forceinline__ void dma_k_piece(const bf16* Kh, int kv0, int piece, LAS unsigned char* kslot, int lane) {
    const int row = 8 * piece + (lane >> 3);
    const bf16* src = Kh + (size_t)(kv0 + row) * D + ((lane & 7) ^ ((row >> 1) & 7)) * 8;
    __builtin_amdgcn_global_load_lds((const unsigned*)src, (LAS unsigned*)(kslot + piece * 1024), 16, 0, 0); }
__device__ __forceinline__ void dma_v_piece(const bf16* Vh, int kv0, int piece, LAS unsigned char* vslot, int lane) {
    const int row = 8 * piece + (lane >> 3);
    const bf16* src = Vh + (size_t)(kv0 + row) * D + ((lane & 7) ^ (((row >> 1) & 1) << 2)) * 8;
    __builtin_amdgcn_global_load_lds((const unsigned*)src, (LAS unsigned*)(vslot + piece * 1024), 16, 0, 0); }
__device__ __forceinline__ int kfrag_off(int d0, int r32, int hi) { return 128 * r32 + 16 * ((2 * d0 + hi) ^ ((r32 >> 1) & 7)); }
__device__ __forceinline__ void qkt(f32x16& p0, f32x16& p1, const LAS unsigned char* kslot, const bf16x8 (&qr)[4], int r32, int hi) {
    p0 = (f32x16){0.f, 0.f, 0.f, 0.f, 0.f, 0.f, 0.f, 0.f, 0.f, 0.f, 0.f, 0.f, 0.f, 0.f, 0.f, 0.f}; p1 = p0;
    bf16x8 kf[8];
#pragma unroll
    for (int d0 = 0; d0 < 4; ++d0) { const LAS unsigned char* kb = kslot + kfrag_off(d0, r32, hi); kf[2 * d0] = *(const LAS bf16x8*)(kb); kf[2 * d0 + 1] = *(const LAS bf16x8*)(kb + 4096); }
#pragma unroll
    for (int d0 = 0; d0 < 4; ++d0) { p0 = __builtin_amdgcn_mfma_f32_32x32x16_bf16(kf[2 * d0], qr[d0], p0, 0, 0, 0); p1 = __builtin_amdgcn_mfma_f32_32x32x16_bf16(kf[2 * d0 + 1], qr[d0], p1, 0, 0, 0); }
}
__device__ __forceinline__ v4i16_t vtr(const LAS unsigned char* p) { return __builtin_amdgcn_ds_read_tr16_b64_v4i16((LAS v4i16_t*)p); }
__device__ __forceinline__ void pvt(f32x16 (&o)[2], const LAS unsigned char* vslot, int lane, const v4u (&pw)[4]) {
    const int r = (lane & 15) >> 2, f = (r >> 1) & 1;
    const LAS unsigned char* vb0 = vslot + (4 * (lane >> 5) + r) * 128 + f * 64 + ((lane >> 4) & 1) * 32 + (lane & 3) * 8;
    const LAS unsigned char* vb1 = vslot + (4 * (lane >> 5) + r) * 128 + (f ^ 1) * 64 + ((lane >> 4) & 1) * 32 + (lane & 3) * 8;
    v4i16_t lo[8], hh[8];
#pragma unroll
    for (int i = 0; i < 4; ++i) { lo[i] = vtr(vb0 + i * 2048); hh[i] = vtr(vb0 + i * 2048 + 1024); lo[4 + i] = vtr(vb1 + i * 2048); hh[4 + i] = vtr(vb1 + i * 2048 + 1024); }
#pragma unroll
    for (int i = 0; i < 8; ++i) { const bf16x8 vf = (bf16x8){lo[i][0], lo[i][1], lo[i][2], lo[i][3], hh[i][0], hh[i][1], hh[i][2], hh[i][3]};
        o[i >> 2] = __builtin_amdgcn_mfma_f32_32x32x16_bf16(vf, __builtin_bit_cast(bf16x8, pw[i & 3]), o[i >> 2], 0, 0, 0); }
}
__device__ __forceinline__ void pack_p(v4u (&pw)[4], const f32x16& p0, const f32x16& p1) {
#pragma unroll
    for (int i = 0; i < 4; ++i) { pw[0][i] = cvtpk(p0[2 * i], p0[2 * i + 1]); pw[1][i] = cvtpk(p0[8 + 2 * i], p0[9 + 2 * i]); pw[2][i] = cvtpk(p1[2 * i], p1[2 * i + 1]); pw[3][i] = cvtpk(p1[8 + 2 * i], p1[9 + 2 * i]); }
}
__device__ __forceinline__ void store_o(bf16* Orow  , const f32x16 (&o)[2], float scale, int hi) {
#pragma unroll
    for (int dh = 0; dh < 2; ++dh)
#pragma unroll
        for (int gp = 0; gp < 2; ++gp) { float na[4], nb[4];
#pragma unroll
            for (int e = 0; e < 4; ++e) { auto rr = __builtin_amdgcn_permlane32_swap(__float_as_uint(o[dh][8 * gp + e] * scale), __float_as_uint(o[dh][8 * gp + 4 + e] * scale), false, false); na[e] = __uint_as_float(rr[0]); nb[e] = __uint_as_float(rr[1]); }
            const v4u w = (v4u){cvtpk(na[0], na[1]), cvtpk(na[2], na[3]), cvtpk(nb[0], nb[1]), cvtpk(nb[2], nb[3])};
            *(GAS v4u*)(Orow + 32 * dh + 8 * (2 * gp + hi)) = w; }
}
constexpr int BT_DMAX = 1119, BT_LEN = BT_DMAX + 1 + BT_PAD, BT_CS = 1424;
static_assert(BT_CS >= BT_LEN + 4 && BT_CS % 64 == 16, "bias table copies");
__device__ __forceinline__ const LAS float* bias_ptr(const LAS float* bt, int qrow, int hi, int tile) {
    const int jb = BT_DMAX - qrow + 64 * tile + 4 * hi, m = jb & 3, jc = jb > m ? jb : m;
    return bt + m * BT_CS - m + jc; }
__device__ __forceinline__ void store_o8(unsigned char* Orow  , const f32x16 (&o)[2], float scale, int hi) {
#pragma unroll
    for (int dh = 0; dh < 2; ++dh)
#pragma unroll
        for (int gp = 0; gp < 2; ++gp) { float na[4], nb[4];
#pragma unroll
            for (int e = 0; e < 4; ++e) { auto rr = __builtin_amdgcn_permlane32_swap(__float_as_uint(o[dh][8 * gp + e] * scale), __float_as_uint(o[dh][8 * gp + 4 + e] * scale), false, false); na[e] = __uint_as_float(rr[0]); nb[e] = __uint_as_float(rr[1]); }
            const v2u w = (v2u){pg8::pk4_fp8(na[0], na[1], na[2], na[3]), pg8::pk4_fp8(nb[0], nb[1], nb[2], nb[3])};
            *(GAS v2u*)(Orow + 32 * dh + 8 * (2 * gp + hi)) = w; }
}
}

#define MOBA_WAITBAR(N) do { if (!(VAR & 1)) asm volatile("s_waitcnt vmcnt(" #N ") lgkmcnt(0)\n\ts_barrier" ::: "memory"); } while (0)
__device__ __forceinline__ float vmax3(float a, float b, float c) { float r; asm("v_max3_f32 %0, %1, %2, %3" : "=v"(r) : "v"(a), "v"(b), "v"(c)); return r; }
__device__ __forceinline__ float vadd(float a, float b) { float r; asm("v_add_f32_e32 %0, %1, %2" : "=v"(r) : "v"(a), "v"(b)); return r; }
__device__ __forceinline__ float vmax(float a, float b) { float r; asm("v_max_f32_e32 %0, %1, %2" : "=v"(r) : "v"(a), "v"(b)); return r; }
__device__ __forceinline__ float vmul(float a, float b) { float r; asm("v_mul_f32_e32 %0, %1, %2" : "=v"(r) : "v"(a), "v"(b)); return r; }
#define MSB() __builtin_amdgcn_sched_barrier(0)
#define ME4(X, i) do { if (VAR & 8) break; X[i] = ex2(X[i]); X[(i) + 1] = ex2(X[(i) + 1]); X[(i) + 2] = ex2(X[(i) + 2]); X[(i) + 3] = ex2(X[(i) + 3]); } while (0)
#define MC2(W, j, X, i) do { if (VAR & 8) break; W[j] = att::cvtpk(X[i], X[(i) + 1]); W[(j) + 1] = att::cvtpk(X[(i) + 2], X[(i) + 3]); } while (0)
#define MMF(a, b, c) ((VAR & 4) ? (c) : __builtin_amdgcn_mfma_f32_32x32x16_bf16(a, b, c, 0, 0, 0))
template <int VAR>
__device__ __forceinline__ void moba_step(att::f32x16& A0, att::f32x16& A1, att::f32x16& B0, att::f32x16& B1, int s, int NT, int u, int wid, int lane, int qrow, unsigned selmask,
                                          float& mref, float& l, att::f32x16 (&o)[2], const LAS unsigned char* lds, const LAS float* bt, const att::bf16x8 (&qr)[4], att::bf16x8 (&kf)[8]) {
    const int r32 = lane & 31, hi = lane >> 5;
    const int s1 = (s + 1 < NT) ? s + 1 : s;
    const int t1 = (s1 < 4) ? 4 * u + s1 : s1 - 4;
    const bool mine = (s1 < 4) ? (2 * s1 <= wid) : (((selmask >> (t1 >> 2)) & 1u) != 0u);
    const unsigned q0w = hi ? 0u : (mine ? (__float_as_uint(-mref) >> 16) : 0xFF80u), k0w = hi ? 0u : 0x3F80u;
    const att::bf16x8 qaug = __builtin_bit_cast(att::bf16x8, (v4u){q0w, 0u, 0u, 0u}), kone = __builtin_bit_cast(att::bf16x8, (v4u){k0w, 0u, 0u, 0u});
    const LAS unsigned char* vsl = lds + (s % 5) * 16384 + 8192;
    const int s2 = (s + 2 < NT) ? s + 2 : NT - 1, t2 = (s2 < 4) ? 4 * u + s2 : s2 - 4;
    const LAS unsigned char* ksl2 = lds + (s2 % 5) * 16384;
    const LAS float* bp2 = att::bias_ptr(bt, qrow, hi, t2); asm volatile("" : "+v"(bp2));
#define MBL(g) do { const f32x4 x0_ = *(const LAS f32x4*)(bp2 + 8 * (g)), x1_ = *(const LAS f32x4*)(bp2 + 32 + 8 * (g)); \
        A0[4 * (g)] = x0_.x; A0[4 * (g) + 1] = x0_.y; A0[4 * (g) + 2] = x0_.z; A0[4 * (g) + 3] = x0_.w; A1[4 * (g)] = x1_.x; A1[4 * (g) + 1] = x1_.y; A1[4 * (g) + 2] = x1_.z; A1[4 * (g) + 3] = x1_.w; } while (0)
#define MKL(d0) do { const LAS unsigned char* kb_ = ksl2 + att::kfrag_off(d0, r32, hi); kf[2 * (d0)] = *(const LAS att::bf16x8*)(kb_); kf[2 * (d0) + 1] = *(const LAS att::bf16x8*)(kb_ + 4096); } while (0)
    const int vr = (lane & 15) >> 2, vf_ = (vr >> 1) & 1;
    const LAS unsigned char* vb0 = vsl + (4 * hi + vr) * 128 + vf_ * 64 + ((lane >> 4) & 1) * 32 + (lane & 3) * 8;
    const LAS unsigned char* vb1 = vsl + (4 * hi + vr) * 128 + (vf_ ^ 1) * 64 + ((lane >> 4) & 1) * 32 + (lane & 3) * 8;
    asm volatile("" : "+v"(vb0), "+v"(vb1));
    att::v4i16_t lo[8], hh[8]; v4u pw[4];
    MSB();
    B0 = MMF(kf[0], qr[0], B0); ME4(A0, 0);  MC2(pw[0], 0, A0, 0);  MSB();
    B1 = MMF(kf[1], qr[0], B1); ME4(A0, 4);  MC2(pw[0], 2, A0, 4);  MSB();
    B0 = MMF(kf[2], qr[1], B0); ME4(A0, 8);  MC2(pw[1], 0, A0, 8);  MSB();
    B1 = MMF(kf[3], qr[1], B1); ME4(A0, 12); MC2(pw[1], 2, A0, 12); MSB();
    B0 = MMF(kf[4], qr[2], B0); ME4(A1, 0);  MC2(pw[2], 0, A1, 0);  lo[0] = att::vtr(vb0); hh[0] = att::vtr(vb0 + 1024); lo[1] = att::vtr(vb0 + 2048); hh[1] = att::vtr(vb0 + 3072); MSB();
    B1 = MMF(kf[5], qr[2], B1); ME4(A1, 4);  MC2(pw[2], 2, A1, 4);  lo[2] = att::vtr(vb0 + 4096); hh[2] = att::vtr(vb0 + 5120); lo[3] = att::vtr(vb0 + 6144); hh[3] = att::vtr(vb0 + 7168); MSB();
    B0 = MMF(kf[6], qr[3], B0); ME4(A1, 8);  MC2(pw[3], 0, A1, 8);  lo[4] = att::vtr(vb1); hh[4] = att::vtr(vb1 + 1024); lo[5] = att::vtr(vb1 + 2048); hh[5] = att::vtr(vb1 + 3072); MSB();
    B1 = MMF(kf[7], qr[3], B1); ME4(A1, 12); MC2(pw[3], 2, A1, 12); lo[6] = att::vtr(vb1 + 4096); hh[6] = att::vtr(vb1 + 5120); lo[7] = att::vtr(vb1 + 6144); hh[7] = att::vtr(vb1 + 7168); MSB();
    B0 = MMF(kone, qaug, B0); MSB();
    B1 = MMF(kone, qaug, B1); MSB();
#define MVF(i) (att::bf16x8){lo[i][0], lo[i][1], lo[i][2], lo[i][3], hh[i][0], hh[i][1], hh[i][2], hh[i][3]}
#define MPW(k) __builtin_bit_cast(att::bf16x8, pw[k])
    float la, lb, lc, ld, ma, mb, mc, md;
    o[0] = MMF(MVF(0), MPW(0), o[0]); la = vadd(A0[0], A0[1]); lb = vadd(A1[0], A1[1]); lc = vadd(A0[2], A0[3]); ld = vadd(A1[2], A1[3]); la = vadd(la, A0[4]); lb = vadd(lb, A1[4]); MSB();
    o[0] = MMF(MVF(1), MPW(1), o[0]); lc = vadd(lc, A0[5]); ld = vadd(ld, A1[5]); la = vadd(la, A0[6]); lb = vadd(lb, A1[6]); lc = vadd(lc, A0[7]); ld = vadd(ld, A1[7]); la = vadd(la, A0[8]); lb = vadd(lb, A1[8]); MSB();
    o[0] = MMF(MVF(2), MPW(2), o[0]); lc = vadd(lc, A0[9]); ld = vadd(ld, A1[9]); la = vadd(la, A0[10]); lb = vadd(lb, A1[10]); lc = vadd(lc, A0[11]); ld = vadd(ld, A1[11]); la = vadd(la, A0[12]); lb = vadd(lb, A1[12]); MSB();
    o[0] = MMF(MVF(3), MPW(3), o[0]); lc = vadd(lc, A0[13]); ld = vadd(ld, A1[13]); la = vadd(la, A0[14]); lb = vadd(lb, A1[14]); lc = vadd(lc, A0[15]); ld = vadd(ld, A1[15]); la = vadd(la, lc); lb = vadd(lb, ld); MSB();
    o[1] = MMF(MVF(4), MPW(0), o[1]); MKL(0); MBL(0); ma = vmax3(B0[0], B0[1], B0[2]); mb = vmax3(B1[0], B1[1], B1[2]); mc = vmax3(B0[3], B0[4], B0[5]); md = vmax3(B1[3], B1[4], B1[5]); MSB();
    o[1] = MMF(MVF(5), MPW(1), o[1]); MKL(1); MBL(1); ma = vmax3(ma, B0[6], B0[7]); mb = vmax3(mb, B1[6], B1[7]); mc = vmax3(mc, B0[8], B0[9]); md = vmax3(md, B1[8], B1[9]); MSB();
    o[1] = MMF(MVF(6), MPW(2), o[1]); MKL(2); MBL(2); ma = vmax3(ma, B0[10], B0[11]); mb = vmax3(mb, B1[10], B1[11]); mc = vmax3(mc, B0[12], B0[13]); md = vmax3(md, B1[12], B1[13]); MSB();
    o[1] = MMF(MVF(7), MPW(3), o[1]); MKL(3); MBL(3); ma = vmax3(ma, B0[14], B0[15]); mb = vmax3(mb, B1[14], B1[15]); ma = vmax3(ma, mc, md); MSB();
#undef MVF
#undef MPW
#undef MBL
#undef MKL
    l += vadd(la, lb);
    float mx = vmax(ma, mb); mx = vmax(mx, att::swap32(mx, hi));
    const bool mv = mx > 8.0f;
    if (__any(mv)) {
        const float nref = mv ? __uint_as_float((__float_as_uint(mref + mx) + 0x8000u) & 0xffff0000u) : mref, d = nref - mref, f = ex2(-d); mref = nref; l *= f;
#pragma unroll
        for (int r = 0; r < 16; ++r) { o[0][r] *= f; o[1][r] *= f; B0[r] -= d; B1[r] -= d; } }
}
template <int VAR>
__device__ __forceinline__ void moba_phase(const Ctx& C0, const bf16* Q, const bf16* Kb, const bf16* Vb, bf16* O) {
    const Ctx C = phase_ctx(C0);
    const int lane = C.lane, r32 = lane & 31, hi = lane >> 5, wid = C.wave;
    unsigned char* const ws = wsp(C);
    const float* kmean = (const float*)(ws + WS_KMEAN); const float* btab = (const float*)(ws + WS_BIAS);
    LAS unsigned char* lds = C.lds;
    LAS float* bt = (LAS float*)(lds + 81920);
    const int bh = C.vcu >> 1, b = bh >> 4, h = bh & 15;
    for (int i = C.tid; i < 4 * att::BT_CS; i += NWAVES * 64) { const int m = i / att::BT_CS, j = i - m * att::BT_CS + m, d = att::BT_DMAX - j;
        bt[i] = (j >= att::BT_LEN || d < 0) ? -INFINITY : btab[h * 1024 + (d > 1023 ? 1023 : d)]; }
    const bf16* Kh = Kb + (size_t)b * SEQ * D + h * HD; const bf16* Vh = Vb + (size_t)b * SEQ * D + h * HD;
    LAS float* kml = (LAS float*)(lds + 81920 + 4 * att::BT_CS * 4);
#pragma unroll 1
    for (int nn = 0; nn < 2; ++nn) { const int n = 2 * wid + nn; const GAS v4u* kp = (const GAS v4u*)(Kh + (size_t)(256 * n + (lane >> 3)) * D) + (lane & 7); float sk[8];
#pragma unroll
        for (int j = 0; j < 8; ++j) sk[j] = 0.f;
#pragma unroll 16
        for (int i = 0; i < 32; ++i) { const v4u w = kp[(size_t)i * (8 * D / 8)];
            sk[0] += bflo(w.x); sk[1] += bfhi(w.x); sk[2] += bflo(w.y); sk[3] += bfhi(w.y); sk[4] += bflo(w.z); sk[5] += bfhi(w.z); sk[6] += bflo(w.w); sk[7] += bfhi(w.w); }
#pragma unroll
        for (int j = 0; j < 8; ++j) { float t = sk[j]; t += dppf<DPP_X8>(t); sk[j] = sum32x(sum16x(t)); }
        if (lane < 8) {
#pragma unroll
            for (int j = 0; j < 8; ++j) kml[n * 64 + 8 * lane + j] = sk[j] * (1.f / 256.f); } }
    __syncthreads();
    for (int iu = 0; iu < 8; ++iu) {
        const int sidx0 = 4 * (C.vcu & 1) + (iu >> 1), u = (iu & 1) ? 15 - sidx0 : sidx0;
        const int qrow = 256 * u + 32 * wid + r32, tok = b * SEQ + qrow;
#define MOBA_TILE(s) (((s) < 4) ? 4 * u + (s) : (s) - 4)
#define MOBA_DMA(s) do { if (VAR & 2) break; const int t_ = MOBA_TILE(s); att::dma_k_piece(Kh, 64 * t_, wid, lds + ((s) % 5) * 16384, lane); att::dma_v_piece(Vh, 64 * t_, wid, lds + ((s) % 5) * 16384 + 8192, lane); } while (0)
        MOBA_DMA(0); MOBA_DMA(1); MOBA_DMA(2); MOBA_DMA(3);
        att::bf16x8 qr[4];
#pragma unroll
        for (int d0 = 0; d0 < 4; ++d0) qr[d0] = *(const GAS att::bf16x8*)(Q + (size_t)tok * D + h * HD + d0 * 16 + hi * 8);
        unsigned selmask = 0;
        if (u <= 3) selmask = (1u << u) - 1u;
        else {
            const LAS float* km = kml + 8 * hi;
            float g[15];
#pragma unroll
            for (int n = 0; n < 15; ++n) {
                if (n < u) { float s = 0.f;
#pragma unroll
                    for (int d0 = 0; d0 < 4; ++d0) { const f32x4 a = *(const LAS f32x4*)(km + n * 64 + 16 * d0), c = *(const LAS f32x4*)(km + n * 64 + 16 * d0 + 4);
                        s += __uint_as_float((unsigned)(unsigned short)qr[d0][0] << 16) * a.x; s += __uint_as_float((unsigned)(unsigned short)qr[d0][1] << 16) * a.y;
                        s += __uint_as_float((unsigned)(unsigned short)qr[d0][2] << 16) * a.z; s += __uint_as_float((unsigned)(unsigned short)qr[d0][3] << 16) * a.w;
                        s += __uint_as_float((unsigned)(unsigned short)qr[d0][4] << 16) * c.x; s += __uint_as_float((unsigned)(unsigned short)qr[d0][5] << 16) * c.y;
                        s += __uint_as_float((unsigned)(unsigned short)qr[d0][6] << 16) * c.z; s += __uint_as_float((unsigned)(unsigned short)qr[d0][7] << 16) * c.w; }
                    g[n] = s + att::swap32(s, hi);
                } else g[n] = -INFINITY;
            }
#pragma unroll
            for (int r = 0; r < 3; ++r) { float best = -INFINITY; int bi = 0;
#pragma unroll
                for (int n = 0; n < 15; ++n) if (!((selmask >> n) & 1u) && g[n] > best) { best = g[n]; bi = n; }
                selmask |= 1u << bi; }
        }
        const int NT = 4 * u + 4;
        float mref = 0.f, l = 0.f; att::f32x16 o[2];
#pragma unroll
        for (int r = 0; r < 16; ++r) { o[0][r] = 0.f; o[1][r] = 0.f; }
        att::f32x16 a0, a1, b0, b1;
        att::bf16x8 kfn[8];
        MOBA_WAITBAR(4);
        {
            const LAS float* bp = att::bias_ptr(bt, qrow, hi, 4 * u); asm volatile("" : "+v"(bp));
#pragma unroll
            for (int g = 0; g < 4; ++g) { const f32x4 x0 = *(const LAS f32x4*)(bp + 8 * g), x1 = *(const LAS f32x4*)(bp + 32 + 8 * g);
                a0[4 * g] = x0.x; a0[4 * g + 1] = x0.y; a0[4 * g + 2] = x0.z; a0[4 * g + 3] = x0.w; a1[4 * g] = x1.x; a1[4 * g + 1] = x1.y; a1[4 * g + 2] = x1.z; a1[4 * g + 3] = x1.w; }
            att::bf16x8 kf[8];
#pragma unroll
            for (int d0 = 0; d0 < 4; ++d0) { const LAS unsigned char* kb = lds + att::kfrag_off(d0, r32, hi); kf[2 * d0] = *(const LAS att::bf16x8*)(kb); kf[2 * d0 + 1] = *(const LAS att::bf16x8*)(kb + 4096); }
#pragma unroll
            for (int d0 = 0; d0 < 4; ++d0) { a0 = MMF(kf[2 * d0], qr[d0], a0); a1 = MMF(kf[2 * d0 + 1], qr[d0], a1); }
            float mx = fmaxf(a0[0], a1[0]);
#pragma unroll
            for (int r = 1; r < 16; ++r) mx = fmaxf(mx, fmaxf(a0[r], a1[r]));
            mx = fmaxf(mx, att::swap32(mx, hi));
            mref = __uint_as_float((__float_as_uint(mx) + 0x8000u) & 0xffff0000u);
#pragma unroll
            for (int r = 0; r < 16; ++r) { a0[r] -= mref; a1[r] -= mref; }
            MSB();
            const LAS float* bq = att::bias_ptr(bt, qrow, hi, 4 * u + 1); asm volatile("" : "+v"(bq));
#pragma unroll
            for (int g = 0; g < 4; ++g) { const f32x4 x0 = *(const LAS f32x4*)(bq + 8 * g), x1 = *(const LAS f32x4*)(bq + 32 + 8 * g);
                b0[4 * g] = x0.x; b0[4 * g + 1] = x0.y; b0[4 * g + 2] = x0.z; b0[4 * g + 3] = x0.w; b1[4 * g] = x1.x; b1[4 * g + 1] = x1.y; b1[4 * g + 2] = x1.z; b1[4 * g + 3] = x1.w; }
#pragma unroll
            for (int d0 = 0; d0 < 4; ++d0) { const LAS unsigned char* kb = lds + 16384 + att::kfrag_off(d0, r32, hi); kfn[2 * d0] = *(const LAS att::bf16x8*)(kb); kfn[2 * d0 + 1] = *(const LAS att::bf16x8*)(kb + 4096); }
        }
        for (int s = 0; s < NT; s += 2) {
            if (s + 3 < NT) MOBA_WAITBAR(2); else MOBA_WAITBAR(0);
            if (s + 4 < NT) MOBA_DMA(s + 4);
            moba_step<VAR>(a0, a1, b0, b1, s, NT, u, wid, lane, qrow, selmask, mref, l, o, lds, bt, qr, kfn);
            if (s + 4 < NT) MOBA_WAITBAR(2); else MOBA_WAITBAR(0);
            if (s + 5 < NT) MOBA_DMA(s + 5);
            moba_step<VAR>(b0, b1, a0, a1, s + 1, NT, u, wid, lane, qrow, selmask, mref, l, o, lds, bt, qr, kfn);
        }
        l += att::swap32(l, hi);
        att::store_o8((unsigned char*)O + (size_t)tok * D + h * HD, o, OSCALE8 / l, hi);
        MOBA_WAITBAR(0);
    }
#undef MOBA_TILE
#undef MOBA_DMA
}

template <int SVAR>
__device__ __forceinline__ void sb_phase(const Ctx& C0, const bf16* Q, const bf16* Kb, const bf16* Vb, bf16* O) {
    const Ctx C = phase_ctx(C0);
    const int lane = C.lane, r32 = lane & 31, hi = lane >> 5, wid = C.wave;
    LAS unsigned char* wbuf = C.lds + wid * 16384;
    const int gw = C.vcu * NWAVES + wid;
    const int vr = (lane & 15) >> 2, vf_ = (vr >> 1) & 1;
    const int voff0 = (4 * hi + vr) * 128 + vf_ * 64 + ((lane >> 4) & 1) * 32 + (lane & 3) * 8, voff1 = (4 * hi + vr) * 128 + (vf_ ^ 1) * 64 + ((lane >> 4) & 1) * 32 + (lane & 3) * 8;
    for (int iu = 0; iu < 8; ++iu) {
        const int U = (C.vcu * 8 + iu) * NWAVES + wid, bh = U >> 7, qt = U & 127, b = bh >> 4, h = bh & 15;
        const int t = 32 * qt + r32, tok = b * SEQ + t;
        const bf16* Kh = Kb + (size_t)b * SEQ * D + h * HD; const bf16* Vh = Vb + (size_t)b * SEQ * D + h * HD;
#define SB_DMA(tk_, p_) do { _Pragma("unroll") for (int pc = 0; pc < 4; ++pc) att::dma_k_piece(Kh, 32 * (tk_), pc, wbuf + (p_) * 8192, lane); \
                             _Pragma("unroll") for (int pc = 0; pc < 4; ++pc) att::dma_v_piece(Vh, 32 * (tk_), pc, wbuf + (p_) * 8192 + 4096, lane); } while (0)
        asm volatile("s_waitcnt lgkmcnt(0)" ::: "memory");
        SB_DMA(qt, 0);
        att::bf16x8 qr[4];
#pragma unroll
        for (int d0 = 0; d0 < 4; ++d0) qr[d0] = *(const GAS att::bf16x8*)(Q + (size_t)tok * D + h * HD + d0 * 16 + hi * 8);
        float L = 1.f; att::f32x16 o[2];
#pragma unroll
        for (int r = 0; r < 16; ++r) { o[0][r] = 0.f; o[1][r] = 0.f; }
        int p = 0;
        for (int tk = qt; tk >= 0; --tk) {
            if (tk > 0) { asm volatile("s_waitcnt lgkmcnt(0)" ::: "memory"); SB_DMA(tk - 1, p ^ 1); asm volatile("s_waitcnt vmcnt(8)" ::: "memory"); }
            else asm volatile("s_waitcnt vmcnt(0)" ::: "memory");
            const LAS unsigned char* kslot = wbuf + p * 8192; const LAS unsigned char* vslot = kslot + 4096;
            att::bf16x8 kf[4];
#pragma unroll
            for (int d0 = 0; d0 < 4; ++d0) kf[d0] = *(const LAS att::bf16x8*)(kslot + att::kfrag_off(d0, r32, hi));
            att::f32x16 z;
#pragma unroll
            for (int r = 0; r < 16; ++r) z[r] = 0.f;
#pragma unroll
            for (int d0 = 0; d0 < 4; ++d0) z = __builtin_amdgcn_mfma_f32_32x32x16_bf16(kf[d0], qr[d0], z, 0, 0, 0);
            att::f32x16 s;
#pragma unroll
            for (int r = 0; r < 16; ++r) { const float e = ex2(z[r]); s[r] = __builtin_amdgcn_rcpf(1.0f + e); z[r] = 1.0f - s[r]; }
            if (tk == qt) { const int lim = r32 - 4 * hi;
#pragma unroll
                for (int r = 0; r < 16; ++r) { const int ko = (r & 3) + 8 * (r >> 2); if (!(ko < lim)) { s[r] = 1.f; z[r] = 0.f; } } }
            __builtin_amdgcn_sched_barrier(0);
            float Gs[4], E[4], T[4], EG[4];
#pragma unroll
            for (int gq = 0; gq < 4; ++gq) Gs[gq] = vmul(vmul(s[4 * gq], s[4 * gq + 1]), vmul(s[4 * gq + 2], s[4 * gq + 3]));
            E[3] = 1.f; E[2] = Gs[3]; E[1] = vmul(E[2], Gs[2]); E[0] = vmul(E[1], Gs[1]);
            EG[3] = Gs[3]; EG[2] = E[1]; EG[1] = E[0]; EG[0] = vmul(E[0], Gs[0]);
#pragma unroll
            for (int gq = 0; gq < 3; ++gq) T[gq] = vmul(E[gq], att::swap32(hi ? EG[gq] : E[gq], hi));
            T[3] = att::swap32(hi ? EG[3] : 1.f, hi);
            const float own = EG[0], tot = vmul(own, att::swap32(own, hi));
#pragma unroll
            for (int gq = 0; gq < 4; ++gq) { const float b3 = vmul(L, T[gq]), b2 = vmul(b3, s[4 * gq + 3]), b1 = vmul(b2, s[4 * gq + 2]), b0 = vmul(b1, s[4 * gq + 1]);
                z[4 * gq + 3] = vmul(z[4 * gq + 3], b3); z[4 * gq + 2] = vmul(z[4 * gq + 2], b2); z[4 * gq + 1] = vmul(z[4 * gq + 1], b1); z[4 * gq] = vmul(z[4 * gq], b0); }
            L = vmul(L, tot);
            v4u pw0, pw1;
#pragma unroll
            for (int i = 0; i < 4; ++i) { pw0[i] = att::cvtpk(z[2 * i], z[2 * i + 1]); pw1[i] = att::cvtpk(z[8 + 2 * i], z[9 + 2 * i]); }
            { const att::v4i16_t l00 = att::vtr(vslot + voff0), h00 = att::vtr(vslot + voff0 + 1024), l01 = att::vtr(vslot + voff0 + 2048), h01 = att::vtr(vslot + voff0 + 3072);
              const att::v4i16_t l10 = att::vtr(vslot + voff1), h10 = att::vtr(vslot + voff1 + 1024), l11 = att::vtr(vslot + voff1 + 2048), h11 = att::vtr(vslot + voff1 + 3072);
#define SB_VF(lo_, hh_) (att::bf16x8){lo_[0], lo_[1], lo_[2], lo_[3], hh_[0], hh_[1], hh_[2], hh_[3]}
              o[0] = __builtin_amdgcn_mfma_f32_32x32x16_bf16(SB_VF(l00, h00), __builtin_bit_cast(att::bf16x8, pw0), o[0], 0, 0, 0);
              o[0] = __builtin_amdgcn_mfma_f32_32x32x16_bf16(SB_VF(l01, h01), __builtin_bit_cast(att::bf16x8, pw1), o[0], 0, 0, 0);
              o[1] = __builtin_amdgcn_mfma_f32_32x32x16_bf16(SB_VF(l10, h10), __builtin_bit_cast(att::bf16x8, pw0), o[1], 0, 0, 0);
              o[1] = __builtin_amdgcn_mfma_f32_32x32x16_bf16(SB_VF(l11, h11), __builtin_bit_cast(att::bf16x8, pw1), o[1], 0, 0, 0);
#undef SB_VF
            }
            if (!__any(L >= 7.5e-37f)) break;
            p ^= 1;
        }
        att::store_o8((unsigned char*)O + (size_t)tok * D + h * HD, o, OSCALE8, hi);
#undef SB_DMA
    }
}

__device__ __forceinline__ float dot64(const v4u (&q)[8], const GAS v4u* kr) { float s = 0.f;
#pragma unroll
    for (int i = 0; i < 8; ++i) { const v4u k = kr[i];
        s += bflo(q[i].x) * bflo(k.x); s += bfhi(q[i].x) * bfhi(k.x); s += bflo(q[i].y) * bflo(k.y); s += bfhi(q[i].y) * bfhi(k.y);
        s += bflo(q[i].z) * bflo(k.z); s += bfhi(q[i].z) * bfhi(k.z); s += bflo(q[i].w) * bflo(k.w); s += bfhi(q[i].w) * bfhi(k.w); }
    return s; }
__device__ __forceinline__ void moba_naive(const Ctx& C0, const bf16* Q, const bf16* Kb, const bf16* Vb, bf16* O) {
    const Ctx C = phase_ctx(C0);
    LAS float* sc = (LAS float*)(C.lds + C.wave * 4096);
    const float* kmean = (const float*)(wsp(C) + WS_KMEAN); const float* btab = (const float*)(wsp(C) + WS_BIAS);
    const int gw = C.vcu * NWAVES + C.wave, lane = C.lane;
    for (int ip = 0; ip < 256; ++ip) {
        const int p = gw * 256 + ip, tok = p >> 4, h = p & 15, b = tok >> 12, qpos = tok & 4095, u = qpos >> 8;
        const bf16* qp = Q + (size_t)tok * D + h * HD;
        v4u qv[8];
#pragma unroll
        for (int i = 0; i < 8; ++i) qv[i] = ((const GAS v4u*)qp)[i];
        const float qd = __uint_as_float((unsigned)qp[lane] << 16);
        const float* km = kmean + (size_t)((b * NH + h) * 16) * 64 + lane;
        float g[15];
#pragma unroll
        for (int n = 0; n < 15; ++n) g[n] = (n < u) ? wave_sum(qd * km[n * 64]) : -INFINITY;
        unsigned mask = 0;
        if (u <= 3) mask = (1u << u) - 1u;
        else {
#pragma unroll
            for (int r = 0; r < 3; ++r) { float best = -INFINITY; int bi = 0;
#pragma unroll
                for (int n = 0; n < 15; ++n) if (!((mask >> n) & 1u) && g[n] > best) { best = g[n]; bi = n; }
                mask |= 1u << bi; }
        }
        mask |= 1u << u;
        const float* bt = btab + h * 1024;
        float mx = -INFINITY; int ns = 0;
        for (int n = 0; n <= u; ++n) { if (!((mask >> n) & 1u)) continue;
            for (int c4 = 0; c4 < 4; ++c4) { const int kpos = 256 * n + 64 * c4 + lane; const int dist = qpos - kpos;
                float s = dot64(qv, (const GAS v4u*)(Kb + (size_t)(b * SEQ + kpos) * D + h * HD));
                s += bt[dist < 0 ? 0 : (dist > 1023 ? 1023 : dist)];
                if (dist < 0) s = -INFINITY;
                sc[ns * 256 + 64 * c4 + lane] = s; mx = fmaxf(mx, s); }
            ++ns; }
        mx = wave_max(mx);
        LDS_WAIT(); asm volatile("" ::: "memory");
        float l = 0.f;
        for (int i = 0; i < ns * 4; ++i) { const float pz = ex2(sc[64 * i + lane] - mx); sc[64 * i + lane] = pz; l += pz; }
        l = wave_sum(l);
        LDS_WAIT(); asm volatile("" ::: "memory");
        float o = 0.f; int n2 = 0;
        for (int n = 0; n <= u; ++n) { if (!((mask >> n) & 1u)) continue;
            const bf16* vp = Vb + (size_t)(b * SEQ + 256 * n) * D + h * HD + lane;
#pragma unroll 8
            for (int i = 0; i < 256; ++i) o += sc[n2 * 256 + i] * __uint_as_float((unsigned)vp[(size_t)i * D] << 16);
            ++n2; }
        LDS_WAIT(); asm volatile("" ::: "memory");
        O[(size_t)tok * D + h * HD + lane] = (bf16)f2bf(o / l);
    }
}
__device__ __forceinline__ void sb_naive(const Ctx& C0, const bf16* Q, const bf16* Kb, const bf16* Vb, bf16* O) {
    const Ctx C = phase_ctx(C0);
    LAS float* sc = (LAS float*)(C.lds + C.wave * 4096);
    const int gw = C.vcu * NWAVES + C.wave, lane = C.lane;
    for (int ip = 0; ip < 256; ++ip) {
        const int p = gw * 256 + ip, tok = p >> 4, h = p & 15, b = tok >> 12, t = tok & 4095;
        const bf16* qp = Q + (size_t)tok * D + h * HD;
        v4u qv[8];
#pragma unroll
        for (int i = 0; i < 8; ++i) qv[i] = ((const GAS v4u*)qp)[i];
        float L = 0.f, o = 0.f;
        for (int c = (t - 1) >> 6; c >= 0; --c) {
            const int j = 64 * c + lane; const bool valid = j < t;
            const float z = dot64(qv, (const GAS v4u*)(Kb + (size_t)(b * SEQ + j) * D + h * HD));
            const float sp = valid ? (fmaxf(z, 0.f) + lg2(1.0f + ex2(-fabsf(z)))) : 0.f;
            float incl = sp;
#pragma unroll
            for (int off = 1; off < 64; off <<= 1) { const float tmp = __shfl_down(incl, off); if (lane + off < 64) incl += tmp; }
            const float excl = incl - sp;
            const float a = valid ? ex2(z - sp + L - excl) : 0.f;
            L -= __shfl(incl, 0);
            sc[lane] = a;
            LDS_WAIT(); asm volatile("" ::: "memory");
            const bf16* vp = Vb + (size_t)(b * SEQ + 64 * c) * D + h * HD + lane;
#pragma unroll 8
            for (int i = 0; i < 64; ++i) o += sc[i] * __uint_as_float((unsigned)vp[(size_t)i * D] << 16);
            LDS_WAIT(); asm volatile("" ::: "memory");
            if (L < -120.0f) break;
        }
        O[(size_t)tok * D + h * HD + lane] = (bf16)f2bf(o);
    }
}

#ifndef DUP_GEMM
#define DUP_GEMM 0
#endif
#ifndef DUP_ATT
#define DUP_ATT 0
#endif
#ifndef DUP_TOK
#define DUP_TOK 0
#endif
#ifndef DUP_MISC
#define DUP_MISC 0
#endif
#ifndef DUP_PRO
#define DUP_PRO 0
#endif
#ifndef SB_VAR
#define SB_VAR 0
#endif
#ifndef MOBA_VAR
#define MOBA_VAR 0
#endif
#ifndef NAIVE_MOBA
#define NAIVE_MOBA 0
#endif
#ifndef NAIVE_SB
#define NAIVE_SB 0
#endif
#ifndef DUP_BAR
#define DUP_BAR 0
#endif
#define GRID_BAR() do { xcd_barrier(bar); if (DUP_BAR) xcd_barrier(bar); } while (0)
#define LOCAL_BAR() do { if (reg32) xcd_barrier_local(bar); else xcd_barrier(bar); } while (0)
#define WSB(off) ((bf16*)(ws + (off)))
template <int l>
__device__ __forceinline__ void layer_body(const Ctx& C, const XcdBarrier& bar, LAS unsigned char* ring, const LAS int* rt, const int G, const int bx, const bool reg32) {
        if (l == 2) { void* xo = wsp(C) + WS_XBF; token_phase<true, true, false, false, true>(C, xo, xo, inp(C, IN_NMIX) + l * D, l * MODW + 0 * D, l * MODW + 1 * D, (bf16*)(wsp(C) + WS_XN), (l - 1) * MODW + 5 * D, nullptr); }
        else if (l == 0) token_phase<false, false, false, false, true, true>(C, inp(C, IN_X), nullptr, inp(C, IN_NMIX) + l * D, l * MODW + 0 * D, l * MODW + 1 * D, (bf16*)(wsp(C) + WS_XN), 0, nullptr);
        else token_phase<false, false, false, false, true>(C, wsp(C) + WS_XBF, nullptr, inp(C, IN_NMIX) + l * D, l * MODW + 0 * D, l * MODW + 1 * D, (bf16*)(wsp(C) + WS_XN), 0, nullptr);
        if (l == 2) GRID_BAR(); else LOCAL_BAR();
        if (l < 2) {
            { unsigned char* ws = wsp(C); pg8::Gemm g{WSB(WS_XN), (const bf16*)(ws + WS_WQKV + (size_t)l * 3 * D * D), NTOK, 3 * D, D / 2}; pg8::ScaleStage<pg8::StaticOrder> S; S.init(NTOK, 3 * D, G, bx); S.sA = (const float*)(ws + WS_SA); S.sB = (const float*)(ws + WS_SBQKV) + (size_t)l * 3 * D; S.buf = ring + SCALEBUF_OFF; S.cnt = 0;
              pg8::EpiBf16I8 E{WSB(WS_Q), D, D, (size_t)(WS_K - WS_Q) / 2, QSCALE, ring + SCALEBUF_OFF, 0};
              pg8::gemm_phase<pg8::EpiBf16I8, pg8::ScaleStage<pg8::StaticOrder>, true, true, 2>(ring, g, S, E); }
            LOCAL_BAR();
            { unsigned char* ws = wsp(C); if (NAIVE_MOBA) moba_naive(C, WSB(WS_Q), WSB(WS_K), WSB(WS_V), WSB(WS_Q)); else { if (DUP_ATT & 1) moba_phase<MOBA_VAR>(C, WSB(WS_Q), WSB(WS_K), WSB(WS_V), WSB(WS_HID)); moba_phase<0>(C, WSB(WS_Q), WSB(WS_K), WSB(WS_V), WSB(WS_HID)); } }
        } else {
            if (l == 2) { unsigned char* ws = wsp(C); pg8::Gemm g{WSB(WS_XN2), (const bf16*)(ws + WS_WKV), NTOK, 2 * D, D / 2}; pg8::ScaleStage<pg8::StaticOrder> S; S.init(NTOK, 2 * D, G, bx); S.sA = (const float*)(ws + WS_SA2); S.sB = (const float*)(ws + WS_SBKV); S.buf = ring + SCALEBUF_OFF; S.cnt = 0;
              pg8::EpiBf16I8 E{WSB(WS_KSH), D, D, (size_t)(WS_VSH - WS_KSH) / 2, 1.0f, ring + SCALEBUF_OFF, 0};
              pg8::gemm_phase<pg8::EpiBf16I8, pg8::ScaleStage<pg8::StaticOrder>, true, true, 2>(ring, g, S, E); }
            { unsigned char* ws = wsp(C); pg8::Gemm g{WSB(WS_XN), (const bf16*)(ws + WS_WQ + (size_t)(l - 2) * D * D), NTOK, D, D / 2}; pg8::ScaleStage<pg8::StaticOrder> S; S.init(NTOK, D, G, bx); S.sA = (const float*)(ws + WS_SA); S.sB = (const float*)(ws + WS_SBQ) + (size_t)(l - 2) * D; S.buf = ring + SCALEBUF_OFF; S.cnt = 0;
              pg8::EpiBf16I8 E{WSB(WS_Q), D, D, 0, QSCALE, ring + SCALEBUF_OFF, 0};
              pg8::gemm_phase<pg8::EpiBf16I8, pg8::ScaleStage<pg8::StaticOrder>, true, true, 2>(ring, g, S, E); }
            LOCAL_BAR();
            { unsigned char* ws = wsp(C); if (NAIVE_SB) sb_naive(C, WSB(WS_Q), WSB(WS_KSH), WSB(WS_VSH), WSB(WS_Q)); else { if (DUP_ATT & 2) sb_phase<SB_VAR>(C, WSB(WS_Q), WSB(WS_KSH), WSB(WS_VSH), WSB(WS_HID)); sb_phase<0>(C, WSB(WS_Q), WSB(WS_KSH), WSB(WS_VSH), WSB(WS_HID)); } }
        }
        LOCAL_BAR();
        { unsigned char* ws = wsp(C);
          const bf16* wo = (const bf16*)((l < 2) ? ws + WS_WO + (size_t)l * D * D : ws + WS_WBO + (size_t)(l - 2) * D * D);
          pg8::Gemm g{WSB(WS_HID), wo, NTOK, D, D / 2}; pg8::StaticOrder S; S.init(NTOK, D, G, bx);
          if (l == 0) { pg8::EpiResidB<true> E{inp(C, IN_X), WSB(WS_XBF), (const float*)(ws + WS_MOD) + l * MODW + 2 * D, MODLD, 1.0f / (OSCALE8 * WSCALE8)};
              pg8::gemm_phase<pg8::EpiResidB<true>, pg8::StaticOrder, true, true, 1>(ring, g, S, E); }
          else { pg8::EpiResidB<false> E{WSB(WS_XBF), WSB(WS_XBF), (const float*)(ws + WS_MOD) + l * MODW + 2 * D, MODLD, 1.0f / (OSCALE8 * WSCALE8)};
              pg8::gemm_phase<pg8::EpiResidB<false>, pg8::StaticOrder, true, true, 1>(ring, g, S, E); } }
        LOCAL_BAR();
        if (l & 1) token_phase<false, false, true, false, true>(C, wsp(C) + WS_XBF, nullptr, inp(C, IN_NFFN) + l * D, l * MODW + 3 * D, l * MODW + 4 * D, (bf16*)(wsp(C) + WS_XN), 0, inp(C, IN_RW) + (size_t)(l >> 1) * D * NE);
        else token_phase<false, false, false, false, true>(C, wsp(C) + WS_XBF, nullptr, inp(C, IN_NFFN) + l * D, l * MODW + 3 * D, l * MODW + 4 * D, (bf16*)(wsp(C) + WS_XN), 0, nullptr);
        if (l & 1) GRID_BAR(); else LOCAL_BAR();
        if (!(l & 1)) {
            { unsigned char* ws = wsp(C); pg8::Gemm g{WSB(WS_XN), (const bf16*)(ws + WS_W13 + (size_t)(l >> 1) * 2 * FF * D), NTOK, 2 * FF, D / 2}; pg8::ScaleStage<pg8::StaticOrder> S; S.init(NTOK, 2 * FF, G, bx); S.sA = (const float*)(ws + WS_SA); S.sB = (const float*)(ws + WS_SB13) + (size_t)(l >> 1) * 2 * FF; S.buf = ring + SCALEBUF_OFF; S.cnt = 0;
              pg8::EpiSwiGluI8 E{ws + WS_HID, FF, 2 * FF / 256, ring + SCALEBUF_OFF, HSCALE8, 0};
              pg8::gemm_phase<pg8::EpiSwiGluI8, pg8::ScaleStage<pg8::StaticOrder>, true, true, 2>(ring, g, S, E); }
            LOCAL_BAR();
            { unsigned char* ws = wsp(C); pg8::Gemm g{WSB(WS_HID), (const bf16*)(ws + WS_W2 + (size_t)(l >> 1) * D * FF), NTOK, D, FF / 2}; pg8::StaticOrder S; S.init(NTOK, D, G, bx);
              pg8::EpiResidB<false> E{WSB(WS_XBF), WSB(WS_XBF), (const float*)(ws + WS_MOD) + l * MODW + 5 * D, MODLD, 1.0f / (HSCALE8 * WSCALE8)};
              pg8::gemm_phase<pg8::EpiResidB<false>, pg8::StaticOrder, true, true, 1>(ring, g, S, E); }
            LOCAL_BAR();
        } else {
            for (int dup = 0; dup <= DUP_MISC; ++dup) { if (dup) __syncthreads(); route_phase(C, (const bf16*)(wsp(C) + WS_XN)); }
            GRID_BAR();
            const int ntiles = __builtin_amdgcn_readfirstlane(rt[RT_NT]);
            { unsigned char* ws = wsp(C); pg8::Gemm g{WSB(WS_XG), (const bf16*)(ws + WS_MW13 + (size_t)(l >> 1) * NE * 2 * FFE * D), MAXTILES * 256, 2 * FFE, D / 2}; pg8::ScaleStage<pg8::MoeOrder> S; S.init(ntiles, 2 * FFE / 256, G, bx, rt + RT_TEXP); S.sA = (const float*)(ws + WS_SAG); S.sB = (const float*)(ws + WS_SBM13) + (size_t)(l >> 1) * NE * 2 * FFE; S.buf = ring + SCALEBUF_OFF; S.cnt = 0;
              pg8::EpiSwiGluI8 E{ws + WS_HID, FFE, 2 * FFE / 256, ring + SCALEBUF_OFF, HSCALE8, 0};
              pg8::gemm_phase<pg8::EpiSwiGluI8, pg8::ScaleStage<pg8::MoeOrder>, true, true, 2>(ring, g, S, E); }
            GRID_BAR();
            { unsigned char* ws = wsp(C); pg8::Gemm g{WSB(WS_HID), (const bf16*)(ws + WS_MW2 + (size_t)(l >> 1) * NE * D * FFE), MAXTILES * 256, D, FFE / 2, 0}; pg8::MoeOrder S; S.init(ntiles < 256 ? ntiles : 256, D / 256, G, bx, rt + RT_TEXP);
              pg8::EpiBf16 E{WSB(WS_XG), D, 0, 0, 1.0f, D / 256, 1.0f / (HSCALE8 * WSCALE8)};
              pg8::gemm_phase<pg8::EpiBf16, pg8::MoeOrder, true, true, 1>(ring, g, S, E); }
            if (ntiles > 256) { unsigned char* ws = wsp(C); pg8::Gemm g{WSB(WS_HID), (const bf16*)(ws + WS_MW2 + (size_t)(l >> 1) * NE * D * FFE), MAXTILES * 256, D, FFE / 2 / TAIL_NS, FFE / 2}; pg8::TailOrder S; S.init(ntiles - 256, D / 256, TAIL_NS, G, bx, rt + RT_TEXP);
              pg8::EpiPlaneF32 E{(float*)(ws + WS_YT), D / 256, 1.0f / (HSCALE8 * WSCALE8), (size_t)TAIL_ROWS * D};
              pg8::gemm_phase<pg8::EpiPlaneF32, pg8::TailOrder, true, true, 1>(ring, g, S, E); }
            GRID_BAR();
        }
    }

struct Args { const float* in[21]; float* out; unsigned char* ws; };
__global__ void __launch_bounds__(NWAVES * 64, 2) yoco_fwd(Args args) {
    extern __shared__ __attribute__((aligned(16))) unsigned char lds[];
    Ctx C;
    C.lds = (LAS unsigned char*)lds; C.tid = threadIdx.x; C.lane = C.tid & 63; C.wave = __builtin_amdgcn_readfirstlane(C.tid >> 6);
    C.G = gridDim.x; { const int bx = blockIdx.x; C.vcu = (C.G % 8 == 0) ? (bx % 8) * (C.G / 8) + bx / 8 : bx; }
    for (int u = C.tid; u < (LDS_BYTES - LDSCTL_OFF) / 4; u += NWAVES * 64) ((LAS unsigned*)(C.lds + LDSCTL_OFF))[u] = 0u;
    __syncthreads();
    if (C.tid < IN_COUNT) ((LAS unsigned long long*)(C.lds + PTR_OFF))[C.tid] = ((const unsigned long long*)__builtin_amdgcn_kernarg_segment_ptr())[C.tid];
    __syncthreads();
    XcdBarrier bar = xcd_barrier_post((unsigned*)((gu32*)(wsp(C) + WS_CTL) + CW_BAR), (volatile LAS unsigned*)(C.lds + MISC_OFF) + 8);
    LAS unsigned char* ring = C.lds + RING_OFF;
    const LAS int* rt = (const LAS int*)(C.lds + ROUTE_OFF);
    const int G = C.G, bx = (int)blockIdx.x;

    for (int dup = 0; dup <= DUP_PRO; ++dup) { if (dup) __syncthreads(); p0_prologue(C); } GRID_BAR();

    const bool reg32 = __builtin_amdgcn_readfirstlane((int)bar.st[2]) == 2;
    int bxv = bx;
    if (reg32) { const int rank = __builtin_amdgcn_readfirstlane((int)bar.st[3]) - 1, xcc = (int)bar.x; C.vcu = xcc * 32 + rank; bxv = rank * 8 + xcc; }

    layer_body<0>(C, bar, ring, rt, G, bxv, reg32);
    layer_body<1>(C, bar, ring, rt, G, bxv, reg32);
    layer_body<2>(C, bar, ring, rt, G, bxv, reg32);
    layer_body<3>(C, bar, ring, rt, G, bxv, reg32);
    token_phase<true, false, false, true>(C, wsp(C) + WS_XBF, outp(C), inp(C, IN_FNG), 0, 0, nullptr, 3 * MODW + 5 * D, nullptr);
}

extern "C" void kernel_launch(void* const* d_in, const int* in_sizes, int n_in, void* d_out, int out_size, void* d_ws, size_t ws_size, hipStream_t stream) {
    static int grid = 0;
    if (grid == 0) {
        if (n_in != 21 || in_sizes[0] != NTOK * D || out_size != NTOK * D || ws_size < WS_END) { fprintf(stderr, "kernel_launch: unexpected shapes (n_in %d, in0 %d, out %d, ws %zu); nothing launched\n", n_in, n_in > 0 ? in_sizes[0] : -1, out_size, ws_size); grid = -1; return; }
        int dev = 0, cus = 0, per_cu = 0;
        if (hipGetDevice(&dev) != hipSuccess || hipDeviceGetAttribute(&cus, hipDeviceAttributeMultiprocessorCount, dev) != hipSuccess) { fprintf(stderr, "kernel_launch: device query failed\n"); grid = -1; return; }
        if (hipFuncSetAttribute((const void*)yoco_fwd, hipFuncAttributeMaxDynamicSharedMemorySize, LDS_BYTES) != hipSuccess) { fprintf(stderr, "kernel_launch: hipFuncSetAttribute failed\n"); grid = -1; return; }
        if (hipOccupancyMaxActiveBlocksPerMultiprocessor(&per_cu, (const void*)yoco_fwd, NWAVES * 64, LDS_BYTES) != hipSuccess || per_cu < 1)
            fprintf(stderr, "kernel_launch: note: occupancy query reports %d workgroups per CU\n", per_cu);
        (void)hipGetLastError();
        if (cus < 256) { fprintf(stderr, "kernel_launch: this kernel needs 256 CUs (found %d); nothing launched\n", cus); grid = -1; return; }
        grid = 256;
    }
    if (grid < 0) return;
    if (hipMemsetAsync((char*)d_ws + WS_CTL, 0, CTL_ZERO_BYTES, stream) != hipSuccess) { fprintf(stderr, "kernel_launch: hipMemsetAsync failed\n"); return; }
    Args a{};
    for (int i = 0; i < 21; ++i) a.in[i] = (const float*)d_in[i];
    a.out = (float*)d_out; a.ws = (unsigned char*)d_ws;
    hipLaunchKernelGGL(yoco_fwd, dim3(grid), dim3(NWAVES * 64), LDS_BYTES, stream, a);
    const hipError_t le = hipPeekAtLastError();
    if (le != hipSuccess) fprintf(stderr, "kernel_launch: launch failed: %s\n", hipGetErrorName(le));
}
```

```cpp
#include <hip/hip_runtime.h>
#include <cstdio>
#include <cstdint>
namespace pg8 {
#define PG8_LAS __attribute__((address_space(3)))
#define PG8_GAS __attribute__((address_space(1)))
typedef unsigned short bf16_t;
typedef short bf16x8 __attribute__((ext_vector_type(8)));
typedef float f32x4 __attribute__((ext_vector_type(4)));
typedef unsigned u32x4 __attribute__((ext_vector_type(4)));
constexpr int BM = 256, BK = 64, HALF = 128, HTB = HALF * BK * 2  , STAGE_BYTES = 8 * HTB, NXCD = 8, WGM = 8;

__host__ __device__ __forceinline__ int lds_byte(int r, int c) { const int st = (r >> 4) * 2 + (c >> 5), rr = r & 15, cc = c & 31, ob = rr * 64 + cc * 2; return st * 1024 + (ob ^ (((ob >> 9) & 1) << 5)); }
__host__ __device__ __forceinline__ void stage_rc(int b, int& R, int& C) { const int st = b / 1024, sb = b % 1024, swz = sb ^ (((sb >> 9) & 1) << 5); R = (st >> 1) * 16 + swz / 64; C = (st & 1) * 32 + (swz % 64) / 2; }
__host__ __device__ __forceinline__ int perm32(int rho) { const int n = rho >> 4, i = rho & 15; return 8 * (i >> 2) + 4 * n + (i & 3); }

struct Unit { int pm, pn, ks; };
struct Gemm { const bf16_t* A; const bf16_t* Bt; int M, N, K, ld; };

struct StaticOrder {
    static constexpr bool SPLITK = false;
    int nM, nN, nwg, G, c;
    __host__ __device__ void init(int M, int N, int G_, int c_) { nM = M / BM; nN = N / BM; nwg = nM * nN; G = G_; c = c_; }
    __host__ __device__ bool next(int i, Unit& u) const {
        const long L = (long)i * G + c; if (L >= nwg) return false;
        int wgid = (int)L; { const int q = nwg / NXCD, r = nwg % NXCD, xcd = wgid % NXCD, off = wgid / NXCD; wgid = (xcd < r ? xcd * (q + 1) : r * (q + 1) + (xcd - r) * q) + off; }
        const int nig = WGM * nN, gid = wgid / nig, fm = gid * WGM, gsz = (nM - fm) < WGM ? (nM - fm) : WGM;
        u.pm = fm + ((wgid % nig) % gsz); u.pn = (wgid % nig) / gsz; return true;
    }
    __device__ __forceinline__ void a_ready(const Unit&) const {}
    __device__ __forceinline__ void done(const Unit&) const {}
};
struct MoeOrder {
    static constexpr bool SPLITK = false;
    int nM, nN, nwg, G, c; const PG8_LAS int* texp;
    __device__ void init(int ntiles, int nN_, int G_, int c_, const PG8_LAS int* t) { nM = ntiles; nN = nN_; nwg = nM * nN; G = G_; c = c_; texp = t; }
    __device__ bool next(int i, Unit& u) const {
        const long L = (long)i * G + c; if (L >= nwg) return false;
        int wgid = (int)L; { const int q = nwg / NXCD, r = nwg % NXCD, xcd = wgid % NXCD, off = wgid / NXCD; wgid = (xcd < r ? xcd * (q + 1) : r * (q + 1) + (xcd - r) * q) + off; }
        const int nig = WGM * nN, gid = wgid / nig, fm = gid * WGM, gsz = (nM - fm) < WGM ? (nM - fm) : WGM;
        u.pm = fm + ((wgid % nig) % gsz); const int pnl = (wgid % nig) / gsz;
        const int e = __builtin_amdgcn_readfirstlane(texp[u.pm]); u.pn = e * nN + pnl; return true;
    }
    __device__ __forceinline__ void a_ready(const Unit&) const {}
    __device__ __forceinline__ void done(const Unit&) const {}
};

struct TailOrder {
    static constexpr bool SPLITK = true;
    int nN, nS, nwg, G, c; const PG8_LAS int* texp;
    __device__ void init(int ntail, int nN_, int nS_, int G_, int c_, const PG8_LAS int* t) { nN = nN_; nS = nS_; nwg = ntail * nN_ * nS_; G = G_; c = c_; texp = t; }
    __device__ bool next(int i, Unit& u) const {
        const long L = (long)i * G + c; if (L >= nwg) return false;
        const int id = (int)L, rest = id / nS; u.ks = id - rest * nS; const int tl = rest / nN, pnl = rest - tl * nN; u.pm = 256 + tl;
        const int e = __builtin_amdgcn_readfirstlane(texp[u.pm]); u.pn = e * nN + pnl; return true;
    }
    __device__ __forceinline__ void a_ready(const Unit&) const {}
    __device__ __forceinline__ void done(const Unit&) const {}
};
template <class Base> struct ScaleStage : Base {
    const float* sA; const float* sB; PG8_LAS unsigned char* buf; mutable int cnt;
    __device__ __forceinline__ void a_ready(const Unit& u) const {
        if (threadIdx.x < 64) { PG8_LAS unsigned char* d = buf + (cnt & 1) * 2048;
            __builtin_amdgcn_global_load_lds((const unsigned*)(sA + (size_t)u.pm * BM + threadIdx.x * 4), (PG8_LAS unsigned*)d, 16, 0, 0);
            __builtin_amdgcn_global_load_lds((const unsigned*)(sB + (size_t)u.pn * BM + threadIdx.x * 4), (PG8_LAS unsigned*)(d + 1024), 16, 0, 0); }
        ++cnt; }
};
__device__ __forceinline__ unsigned cvt_pk_bf16(float lo, float hi) { unsigned r; asm volatile("v_cvt_pk_bf16_f32 %0, %1, %2" : "=v"(r) : "v"(lo), "v"(hi)); return r; }

typedef int i32x8 __attribute__((ext_vector_type(8)));
typedef int i32x4 __attribute__((ext_vector_type(4)));
typedef unsigned u32x2 __attribute__((ext_vector_type(2)));
__device__ __forceinline__ i32x8 cat8(bf16x8 a, bf16x8 b) { const i32x4 x = __builtin_bit_cast(i32x4, a), y = __builtin_bit_cast(i32x4, b); return __builtin_shufflevector(x, y, 0, 1, 2, 3, 4, 5, 6, 7); }
__device__ __forceinline__ void mfma8(f32x4& acc, const i32x8 a, const i32x8 b, const int sc) { asm volatile("v_mfma_scale_f32_16x16x128_f8f6f4 %0, %1, %2, %0, %3, %3 op_sel_hi:[0,0,0]" : "+v"(acc) : "v"(a), "v"(b), "v"(sc)); }
__device__ __forceinline__ void mfma8z(f32x4& acc, const i32x8 a, const i32x8 b, const int sc) { asm volatile("v_mfma_scale_f32_16x16x128_f8f6f4 %0, %1, %2, 0, %3, %3 op_sel_hi:[0,0,0]" : "=&v"(acc) : "v"(a), "v"(b), "v"(sc)); }
__device__ __forceinline__ unsigned pk4_fp8(float a, float b, float c, float d) {
    a = __builtin_amdgcn_fmed3f(a, -448.f, 448.f); b = __builtin_amdgcn_fmed3f(b, -448.f, 448.f); c = __builtin_amdgcn_fmed3f(c, -448.f, 448.f); d = __builtin_amdgcn_fmed3f(d, -448.f, 448.f);
    int w = 0; w = __builtin_amdgcn_cvt_pk_fp8_f32(a, b, w, false); w = __builtin_amdgcn_cvt_pk_fp8_f32(c, d, w, true); return (unsigned)w; }
struct EpiBf16 {
    static constexpr bool PERM = true, AFTER_DRAIN = false;
    bf16_t* O; int ldc; int split_cols; size_t split_stride; float scale0; int ntn; float scale_all;
    __device__ __forceinline__ void operator()(const f32x4 (&acc)[2][2][4][2], const Unit& u, int wr, int wc, int fr, int fq) const {
        const int row0 = u.pm * BM + wr * 64 + fr; int colt = (ntn ? (u.pn % ntn) : u.pn) * BM; bf16_t* base = O;
        float sc = scale_all; if (split_cols) { const int t = colt / split_cols; base += (size_t)t * split_stride; colt -= t * split_cols; if (t == 0) sc *= scale0; }
        const int col0 = colt + wc * 32 + 8 * fq;
#pragma unroll
        for (int ai = 0; ai < 2; ++ai)
#pragma unroll
            for (int m = 0; m < 4; ++m) { bf16_t* rowp = base + (size_t)(row0 + ai * HALF + m * 16) * ldc + col0;
#pragma unroll
                for (int bj = 0; bj < 2; ++bj) { f32x4 v0 = acc[ai][bj][m][0] * sc, v1 = acc[ai][bj][m][1] * sc;
                    u32x4 w; w.x = cvt_pk_bf16(v0[0], v0[1]); w.y = cvt_pk_bf16(v0[2], v0[3]); w.z = cvt_pk_bf16(v1[0], v1[1]); w.w = cvt_pk_bf16(v1[2], v1[3]);
                    *(PG8_GAS u32x4*)(rowp + bj * HALF) = w; } }
    }
};
struct EpiBf16I8 {
    static constexpr bool PERM = true, AFTER_DRAIN = false;
    bf16_t* O; int ldc; int split_cols; size_t split_stride; float scale0; PG8_LAS unsigned char* sbuf; mutable int cnt;
    __device__ __forceinline__ void operator()(const f32x4 (&acc)[2][2][4][2], const Unit& u, int wr, int wc, int fr, int fq) const {
        const int row0 = u.pm * BM + wr * 64 + fr; int colt = u.pn * BM; bf16_t* base = O;
        float sc = 1.0f; if (split_cols) { const int t = colt / split_cols; base += (size_t)t * split_stride; colt -= t * split_cols; if (t == 0) sc = scale0; }
        const int col0 = colt + wc * 32 + 8 * fq;
        const PG8_LAS float* sa = (const PG8_LAS float*)(sbuf + (cnt & 1) * 2048) + wr * 64 + fr; const PG8_LAS float* sb = (const PG8_LAS float*)(sbuf + (cnt & 1) * 2048 + 1024) + wc * 32 + 8 * fq; ++cnt;
        f32x4 sv[2][2];
#pragma unroll
        for (int bj = 0; bj < 2; ++bj)
#pragma unroll
            for (int n = 0; n < 2; ++n) sv[bj][n] = *(const PG8_LAS f32x4*)(sb + bj * HALF + 4 * n) * sc;
#pragma unroll
        for (int ai = 0; ai < 2; ++ai)
#pragma unroll
            for (int m = 0; m < 4; ++m) { const int r = row0 + ai * HALF + m * 16; bf16_t* rowp = base + (size_t)r * ldc + col0; const float a = sa[ai * HALF + m * 16];
#pragma unroll
                for (int bj = 0; bj < 2; ++bj) { const f32x4 v0 = __builtin_convertvector(__builtin_bit_cast(i32x4, acc[ai][bj][m][0]), f32x4) * (sv[bj][0] * a), v1 = __builtin_convertvector(__builtin_bit_cast(i32x4, acc[ai][bj][m][1]), f32x4) * (sv[bj][1] * a);
                    u32x4 w; w.x = cvt_pk_bf16(v0[0], v0[1]); w.y = cvt_pk_bf16(v0[2], v0[3]); w.z = cvt_pk_bf16(v1[0], v1[1]); w.w = cvt_pk_bf16(v1[2], v1[3]);
                    *(PG8_GAS u32x4*)(rowp + bj * HALF) = w; } }
    }
};
__device__ __forceinline__ float silu_mul2(float t, float u2) { return (t * u2) * __builtin_amdgcn_rcpf(1.0f + __builtin_amdgcn_exp2f(t)); }
__device__ __forceinline__ float silu_mul(float g, float u) { const float e = __builtin_amdgcn_exp2f(g * -1.4426950408889634f); return g * u * __builtin_amdgcn_rcpf(1.0f + e); }
struct EpiSwiGlu {
    static constexpr bool PERM = true, AFTER_DRAIN = false;
    unsigned char* O; int ldc; int ntn; float ascale, hscale;
    __device__ __forceinline__ void operator()(const f32x4 (&acc)[2][2][4][2], const Unit& u, int wr, int wc, int fr, int fq) const {
        const int row0 = u.pm * BM + wr * 64 + fr; const int col0 = (u.pn % ntn) * HALF + wc * 32 + 8 * fq;
#pragma unroll
        for (int ai = 0; ai < 2; ++ai)
#pragma unroll
            for (int m = 0; m < 4; ++m) { unsigned char* rowp = O + (size_t)(row0 + ai * HALF + m * 16) * ldc + col0;
                const f32x4 g0 = acc[ai][0][m][0] * ascale, g1 = acc[ai][0][m][1] * ascale, u0 = acc[ai][1][m][0] * (ascale * hscale), u1 = acc[ai][1][m][1] * (ascale * hscale);
                u32x2 w; w.x = pk4_fp8(silu_mul(g0[0], u0[0]), silu_mul(g0[1], u0[1]), silu_mul(g0[2], u0[2]), silu_mul(g0[3], u0[3]));
                w.y = pk4_fp8(silu_mul(g1[0], u1[0]), silu_mul(g1[1], u1[1]), silu_mul(g1[2], u1[2]), silu_mul(g1[3], u1[3]));
                *(PG8_GAS u32x2*)rowp = w; }
    }
};
struct EpiSwiGluI8 {
    static constexpr bool PERM = true, AFTER_DRAIN = false;
    unsigned char* O; int ldc; int ntn; PG8_LAS unsigned char* sbuf; float hscale; mutable int cnt;
    __device__ __forceinline__ void operator()(const f32x4 (&acc)[2][2][4][2], const Unit& u, int wr, int wc, int fr, int fq) const {
        const int row0 = u.pm * BM + wr * 64 + fr; const int col0 = (u.pn % ntn) * HALF + wc * 32 + 8 * fq;
        const PG8_LAS float* sa = (const PG8_LAS float*)(sbuf + (cnt & 1) * 2048) + wr * 64 + fr; const PG8_LAS float* sb = (const PG8_LAS float*)(sbuf + (cnt & 1) * 2048 + 1024) + wc * 32 + 8 * fq; ++cnt;
        const f32x4 sg0 = *(const PG8_LAS f32x4*)(sb) * -1.4426950408889634f, sg1 = *(const PG8_LAS f32x4*)(sb + 4) * -1.4426950408889634f;
        const f32x4 su0 = *(const PG8_LAS f32x4*)(sb + HALF) * (hscale * -0.6931471805599453f), su1 = *(const PG8_LAS f32x4*)(sb + HALF + 4) * (hscale * -0.6931471805599453f);
#pragma unroll
        for (int ai = 0; ai < 2; ++ai)
#pragma unroll
            for (int m = 0; m < 4; ++m) { const int r = row0 + ai * HALF + m * 16; unsigned char* rowp = O + (size_t)r * ldc + col0; const float a = sa[ai * HALF + m * 16];
                const f32x4 g0 = __builtin_convertvector(__builtin_bit_cast(i32x4, acc[ai][0][m][0]), f32x4) * (sg0 * a), g1 = __builtin_convertvector(__builtin_bit_cast(i32x4, acc[ai][0][m][1]), f32x4) * (sg1 * a);
                const f32x4 u0 = __builtin_convertvector(__builtin_bit_cast(i32x4, acc[ai][1][m][0]), f32x4) * (su0 * a), u1 = __builtin_convertvector(__builtin_bit_cast(i32x4, acc[ai][1][m][1]), f32x4) * (su1 * a);
                u32x2 w; w.x = pk4_fp8(silu_mul2(g0[0], u0[0]), silu_mul2(g0[1], u0[1]), silu_mul2(g0[2], u0[2]), silu_mul2(g0[3], u0[3]));
                w.y = pk4_fp8(silu_mul2(g1[0], u1[0]), silu_mul2(g1[1], u1[1]), silu_mul2(g1[2], u1[2]), silu_mul2(g1[3], u1[3]));
                *(PG8_GAS u32x2*)rowp = w; }
    }
};
struct EpiPlaneF32 {
    static constexpr bool PERM = true, AFTER_DRAIN = false;
    float* O; int ntn; float scale; size_t plane;
    __device__ __forceinline__ void operator()(const f32x4 (&acc)[2][2][4][2], const Unit& u, int wr, int wc, int fr, int fq) const {
        const int row0 = (u.pm - 256) * BM + wr * 64 + fr, col0 = (u.pn % ntn) * BM + wc * 32 + 8 * fq; float* base = O + (size_t)u.ks * plane;
#pragma unroll
        for (int ai = 0; ai < 2; ++ai)
#pragma unroll
            for (int m = 0; m < 4; ++m) { float* rowp = base + (size_t)(row0 + ai * HALF + m * 16) * 1024 + col0;
#pragma unroll
                for (int bj = 0; bj < 2; ++bj) { *(PG8_GAS f32x4*)(rowp + bj * HALF) = acc[ai][bj][m][0] * scale; *(PG8_GAS f32x4*)(rowp + bj * HALF + 4) = acc[ai][bj][m][1] * scale; } }
    }
};
template <bool XIN_F32> struct EpiResidB {
    static constexpr bool PERM = true, AFTER_DRAIN = false;
    const void* xin; bf16_t* out; const float* gate; int gstride; float ascale;
    __device__ __forceinline__ void operator()(const f32x4 (&acc)[2][2][4][2], const Unit& u, int wr, int wc, int fr, int fq) const {
        const int row0 = u.pm * BM + wr * 64 + fr, col0 = u.pn * BM + wc * 32 + 8 * fq; const float* gp = gate + (size_t)(u.pm >> 4) * gstride + col0;
        f32x4 gv[2][2];
#pragma unroll
        for (int bj = 0; bj < 2; ++bj)
#pragma unroll
            for (int n = 0; n < 2; ++n) gv[bj][n] = *(const PG8_GAS f32x4*)(gp + bj * HALF + 4 * n) * ascale;
#pragma unroll
        for (int ai = 0; ai < 2; ++ai)
#pragma unroll
            for (int m = 0; m < 4; ++m) { const size_t off = (size_t)(row0 + ai * HALF + m * 16) * 1024 + col0;
#pragma unroll
                for (int bj = 0; bj < 2; ++bj) { f32x4 xa, xb;
                    if (XIN_F32) { xa = *(const PG8_GAS f32x4*)((const float*)xin + off + bj * HALF); xb = *(const PG8_GAS f32x4*)((const float*)xin + off + bj * HALF + 4); }
                    else { const u32x4 w = *(const PG8_GAS u32x4*)((const bf16_t*)xin + off + bj * HALF);
                        xa = (f32x4){__uint_as_float(w.x << 16), __uint_as_float(w.x & 0xffff0000u), __uint_as_float(w.y << 16), __uint_as_float(w.y & 0xffff0000u)};
                        xb = (f32x4){__uint_as_float(w.z << 16), __uint_as_float(w.z & 0xffff0000u), __uint_as_float(w.w << 16), __uint_as_float(w.w & 0xffff0000u)}; }
                    const f32x4 r0 = xa + gv[bj][0] * acc[ai][bj][m][0], r1 = xb + gv[bj][1] * acc[ai][bj][m][1];
                    u32x4 o; o.x = cvt_pk_bf16(r0[0], r0[1]); o.y = cvt_pk_bf16(r0[2], r0[3]); o.z = cvt_pk_bf16(r1[0], r1[1]); o.w = cvt_pk_bf16(r1[2], r1[3]);
                    *(PG8_GAS u32x4*)(out + off + bj * HALF) = o; }
                if (m & 1) asm volatile("" ::: "memory"); }
    }
};

template <class Epi, class Sched, bool ALIGN_EPI = false, bool SP2 = false, int MODE = 0>
__device__ __forceinline__ void gemm_phase(PG8_LAS unsigned char* lds, const Gemm g, const Sched& S, const Epi& E) {
    int tid_ = threadIdx.x; asm volatile("" : "+v"(tid_));
    const int tid = tid_, wid = __builtin_amdgcn_readfirstlane(tid >> 6), lane = tid & 63, wr = wid >> 2, wc = wid & 3, fr = lane & 15, fq = lane >> 4;
    const int K = g.K, nt = K / BK, LD = g.ld ? g.ld : K;
    unsigned voffA[2], voffB[2];
#pragma unroll
    for (int i = 0; i < 2; ++i) { int R, C; stage_rc(tid * 16 + i * 8192, R, C); const int Rb = Epi::PERM ? ((R & ~31) + perm32(R & 31)) : R;
        voffA[i] = (unsigned)(R * LD + C) * 2u; voffB[i] = (unsigned)(Rb * LD + C) * 2u; }
    const size_t kstep = (size_t)(BK * 2);
    const size_t hstep = (size_t)HALF * LD * 2;
    const size_t tstep = 2 * hstep;
    const unsigned ldsw = (unsigned)wid * 1024u;
    const int aoff = lds_byte(wr * 64 + fr, fq * 8), boff = lds_byte(wc * 32 + fr, fq * 8);
#define PG8_SA(b, h) (((b) * 2 + (h)) * HTB)
#define PG8_SB(b, h) ((4 + (b) * 2 + (h)) * HTB)
#define PG8_STAGE(bufoff, gbase, voff) do { _Pragma("unroll") for (int _i = 0; _i < 2; ++_i) { unsigned vo_ = (voff)[_i]; asm volatile("" : "+v"(vo_));   \
        __builtin_amdgcn_global_load_lds((const unsigned*)((const char*)(gbase) + vo_), (PG8_LAS unsigned*)(lds + (bufoff) + ldsw + _i * 8192), 16, 0, 0); } } while (0)
#define PG8_LDA(dst, b, h) do { _Pragma("unroll") for (int m = 0; m < 4; ++m) _Pragma("unroll") for (int k = 0; k < 2; ++k) dst[m][k] = *(const PG8_LAS bf16x8*)(lds + PG8_SA(b, h) + aoff + m * 2048 + k * 1024); } while (0)
#define PG8_LDB(dst, b, h) do { _Pragma("unroll") for (int n = 0; n < 2; ++n) _Pragma("unroll") for (int k = 0; k < 2; ++k) dst[n][k] = *(const PG8_LAS bf16x8*)(lds + PG8_SB(b, h) + boff + n * 2048 + k * 1024); } while (0)
#define PG8_MMA(Z, ai, bj, At, Bt) do { __builtin_amdgcn_s_setprio(1); \
        if constexpr (MODE == 1) { _Pragma("unroll") for (int m = 0; m < 4; ++m) _Pragma("unroll") for (int n = 0; n < 2; ++n) { \
            if constexpr (Z) mfma8z(acc[ai][bj][m][n], cat8(Bt[n][0], Bt[n][1]), cat8(At[m][0], At[m][1]), sc8); else mfma8(acc[ai][bj][m][n], cat8(Bt[n][0], Bt[n][1]), cat8(At[m][0], At[m][1]), sc8); } } \
        else if constexpr (MODE == 2) { _Pragma("unroll") for (int m = 0; m < 4; ++m) _Pragma("unroll") for (int n = 0; n < 2; ++n) _Pragma("unroll") for (int k = 0; k < 2; ++k) \
            acc[ai][bj][m][n] = __builtin_bit_cast(f32x4, __builtin_amdgcn_mfma_i32_16x16x64_i8(__builtin_bit_cast(i32x4, Bt[n][k]), __builtin_bit_cast(i32x4, At[m][k]), (Z && k == 0) ? (i32x4){0, 0, 0, 0} : __builtin_bit_cast(i32x4, acc[ai][bj][m][n]), 0, 0, 0)); } \
        else { _Pragma("unroll") for (int m = 0; m < 4; ++m) _Pragma("unroll") for (int n = 0; n < 2; ++n) _Pragma("unroll") for (int k = 0; k < 2; ++k) \
            acc[ai][bj][m][n] = __builtin_amdgcn_mfma_f32_16x16x32_bf16(Bt[n][k], At[m][k], (Z && k == 0) ? (f32x4){0.f, 0.f, 0.f, 0.f} : acc[ai][bj][m][n], 0, 0, 0); } __builtin_amdgcn_s_setprio(0); } while (0)
#define PG8_WAIT_V(n) asm volatile("s_waitcnt vmcnt(" #n ")" ::: "memory")
#define PG8_WAIT_L(n) asm volatile("s_waitcnt lgkmcnt(" #n ")" ::: "memory")
#define PG8_BAR __builtin_amdgcn_s_barrier()
#define PG8_SCHED __builtin_amdgcn_sched_barrier(0)
#define PG8_KITER(ZF) do { \
            const bool last = (t == nt - 2); \
            const char* a1 = cA + (size_t)(t + 1) * kstep; \
            const char* a2 = last ? nA : cA + (size_t)(t + 2) * kstep; const char* b2 = last ? nB : cB + (size_t)(t + 2) * kstep; \
            const char* a3 = a2 + kstep; const char* b3 = b2 + kstep; \
            if (last && has_next) S.a_ready(nxt); \
            if constexpr (SP2) { \
            PG8_LDB(B0, 0, 0); PG8_LDB(B1, 0, 1); PG8_SCHED; PG8_LDA(At, 0, 0); PG8_STAGE(PG8_SA(1, 1), a1 + hstep, voffA); \
            PG8_WAIT_V(8); PG8_WAIT_L(0); PG8_BAR; PG8_MMA(ZF, 0, 0, At, B0); PG8_MMA(ZF, 0, 1, At, B1); PG8_BAR; PG8_SCHED; \
            PG8_LDA(At, 0, 1); PG8_STAGE(PG8_SB(0, 0), b2, voffB); PG8_STAGE(PG8_SB(0, 1), b2 + hstep, voffB); PG8_STAGE(PG8_SA(0, 0), a2, voffA); \
            PG8_WAIT_V(8); PG8_WAIT_L(0); PG8_BAR; PG8_MMA(ZF, 1, 0, At, B0); PG8_MMA(ZF, 1, 1, At, B1); PG8_BAR; PG8_SCHED; \
            PG8_LDB(B0, 1, 0); PG8_LDB(B1, 1, 1); PG8_SCHED; PG8_LDA(At, 1, 0); PG8_STAGE(PG8_SA(0, 1), a2 + hstep, voffA); \
            PG8_WAIT_V(8); PG8_WAIT_L(0); PG8_BAR; PG8_MMA(false, 0, 0, At, B0); PG8_MMA(false, 0, 1, At, B1); PG8_BAR; PG8_SCHED; \
            PG8_LDA(At, 1, 1); PG8_STAGE(PG8_SB(1, 0), b3, voffB); PG8_STAGE(PG8_SB(1, 1), b3 + hstep, voffB); PG8_STAGE(PG8_SA(1, 0), a3, voffA); \
            PG8_WAIT_V(8); PG8_WAIT_L(0); PG8_BAR; PG8_MMA(false, 1, 0, At, B0); PG8_MMA(false, 1, 1, At, B1); PG8_BAR; PG8_SCHED; \
            } else { \
            PG8_LDB(B0, 0, 0); PG8_SCHED; PG8_LDA(At, 0, 0); PG8_STAGE(PG8_SA(1, 1), a1 + hstep, voffA); \
            PG8_WAIT_L(8); PG8_BAR; PG8_WAIT_L(0); PG8_MMA(ZF, 0, 0, At, B0); PG8_BAR; PG8_SCHED; \
            PG8_LDB(B1, 0, 1); PG8_STAGE(PG8_SB(0, 0), b2, voffB); \
            PG8_BAR; PG8_WAIT_L(0); PG8_MMA(ZF, 0, 1, At, B1); PG8_BAR; \
            PG8_LDA(At, 0, 1); PG8_STAGE(PG8_SA(0, 0), a2, voffA); \
            PG8_BAR; PG8_WAIT_L(0); PG8_MMA(ZF, 1, 0, At, B0); PG8_BAR; PG8_SCHED; \
            PG8_STAGE(PG8_SB(0, 1), b2 + hstep, voffB); \
            PG8_WAIT_V(6); PG8_BAR; PG8_MMA(ZF, 1, 1, At, B1); PG8_BAR; \
            PG8_LDB(B0, 1, 0); PG8_SCHED; PG8_LDA(At, 1, 0); PG8_STAGE(PG8_SA(0, 1), a2 + hstep, voffA); \
            PG8_WAIT_L(8); PG8_BAR; PG8_WAIT_L(0); PG8_MMA(false, 0, 0, At, B0); PG8_BAR; PG8_SCHED; \
            PG8_LDB(B1, 1, 1); PG8_STAGE(PG8_SB(1, 0), b3, voffB); \
            PG8_BAR; PG8_WAIT_L(0); PG8_MMA(false, 0, 1, At, B1); PG8_BAR; \
            PG8_LDA(At, 1, 1); PG8_STAGE(PG8_SA(1, 0), a3, voffA); \
            PG8_BAR; PG8_WAIT_L(0); PG8_MMA(false, 1, 0, At, B0); PG8_BAR; PG8_SCHED; \
            PG8_STAGE(PG8_SB(1, 1), b3 + hstep, voffB); \
            PG8_WAIT_V(6); PG8_BAR; PG8_MMA(false, 1, 1, At, B1); PG8_BAR; \
            } \
        } while (0)
    int sc8 = 0x7f7f7f7f; asm volatile("" : "+v"(sc8));
    Unit cur, nxt; int ui = 0;
    if (!S.next(0, cur)) return;
    f32x4 acc[2][2][4][2];
    bf16x8 At[4][2], B0[2][2], B1[2][2];
    const char* cA = (const char*)g.A + (size_t)cur.pm * tstep; const char* cB = (const char*)g.Bt + (size_t)cur.pn * tstep;
    if constexpr (Sched::SPLITK) { cA += (size_t)cur.ks * K * 2; cB += (size_t)cur.ks * K * 2; }
    S.a_ready(cur);
    if constexpr (SP2) {
        PG8_STAGE(PG8_SB(0, 0), cB, voffB); PG8_STAGE(PG8_SB(0, 1), cB + hstep, voffB); PG8_STAGE(PG8_SA(0, 0), cA, voffA); PG8_STAGE(PG8_SA(0, 1), cA + hstep, voffA);
        if (wr == 1) PG8_BAR;
        PG8_WAIT_V(2); PG8_BAR;
        PG8_STAGE(PG8_SB(1, 0), cB + kstep, voffB); PG8_STAGE(PG8_SA(1, 0), cA + kstep, voffA); PG8_STAGE(PG8_SB(1, 1), cB + hstep + kstep, voffB);
        PG8_WAIT_V(6); PG8_BAR;
    } else {
        PG8_STAGE(PG8_SB(0, 0), cB, voffB); PG8_STAGE(PG8_SA(0, 0), cA, voffA); PG8_STAGE(PG8_SB(0, 1), cB + hstep, voffB); PG8_STAGE(PG8_SA(0, 1), cA + hstep, voffA);
        if (wr == 1) PG8_BAR;
        PG8_WAIT_V(4); PG8_BAR;
        PG8_STAGE(PG8_SB(1, 0), cB + kstep, voffB); PG8_STAGE(PG8_SA(1, 0), cA + kstep, voffA); PG8_STAGE(PG8_SB(1, 1), cB + hstep + kstep, voffB);
        PG8_WAIT_V(6); PG8_BAR;
    }
    for (;;) {
        const bool has_next = S.next(ui + 1, nxt);
        const char* nA = has_next ? (const char*)g.A + (size_t)nxt.pm * tstep : cA; const char* nB = has_next ? (const char*)g.Bt + (size_t)nxt.pn * tstep : cB;
        if constexpr (Sched::SPLITK) { if (has_next) { nA += (size_t)nxt.ks * K * 2; nB += (size_t)nxt.ks * K * 2; } }
        { const int t = 0; PG8_KITER(true); }
#pragma nounroll
        for (int t = 2; t < nt; t += 2) { PG8_KITER(false); }
        if constexpr (MODE == 1) asm volatile("s_nop 15\n\ts_nop 7" ::: "memory");
        if constexpr (ALIGN_EPI) { if (wr == 0) PG8_BAR; }
        if constexpr (!Epi::AFTER_DRAIN) { E(acc, cur, wr, wc, fr, fq); S.done(cur); }
        if (!has_next) break;
        cur = nxt; cA = nA; cB = nB; ++ui;
        if constexpr (ALIGN_EPI) { if (wr == 1) PG8_BAR; }
    }
    PG8_WAIT_V(0);
    if constexpr (!ALIGN_EPI) { if (wr == 0) PG8_BAR; }
    PG8_BAR;
    if constexpr (Epi::AFTER_DRAIN) { E.fused(acc, cur, wr, wc, fr, fq, lds, wid, lane); S.done(cur); }
#undef PG8_SA
#undef PG8_SB
#undef PG8_STAGE
#undef PG8_LDA
#undef PG8_LDB
#undef PG8_MMA
#undef PG8_KITER
#undef PG8_WAIT_V
#undef PG8_WAIT_L
#undef PG8_BAR
#undef PG8_SCHED
}
}

constexpr int NWAVES = 8;
constexpr int NB = 8, SEQ = 4096, D = 1024, NH = 16, HD = 64, NTOK = NB * SEQ;
constexpr int FF = 2816, FFE = 3584, NE = 8;
constexpr int MODW = 6 * D, MODLD = 4 * MODW + 2 * D;
constexpr int KVMOD = 4 * MODW;
constexpr float RMS_EPS = 1e-6f;
constexpr float LOG2E = 1.4426950408889634f;
constexpr float QSCALE = 0.125f * LOG2E;
constexpr float ASCALE8 = 4.0f, WSCALE8 = 128.0f, HSCALE8 = 4.0f, OSCALE8 = 16.0f;
constexpr int BT_PAD = 256;
constexpr int MAXTILES = 264;

constexpr size_t MiB = 1u << 20;
constexpr size_t WS_CTL = 0, CTL_ZERO_BYTES = 64 * 1024;
constexpr size_t WS_MOD = 1 * MiB;
constexpr size_t WS_BIAS = 2 * MiB;
constexpr size_t WS_KMEAN = 2 * MiB + 256 * 1024;
constexpr size_t WS_TOKE = 3 * MiB;
constexpr size_t WS_TOKW = WS_TOKE + 128 * 1024;
constexpr size_t WS_TOKS = WS_TOKW + 256 * 1024;
constexpr size_t WS_HIST = WS_TOKS + 256 * 1024;
constexpr size_t WS_SA = 4 * MiB, WS_SAG = 4 * MiB + 256 * 1024;
constexpr size_t WS_SA2 = 4 * MiB + 640 * 1024;
constexpr size_t WS_SBQKV = 5 * MiB + 576 * 1024, WS_SBKV = WS_SBQKV + 32 * 1024, WS_SBQ = WS_SBKV + 16 * 1024;
constexpr size_t WS_SB13 = 5 * MiB, WS_SBM13 = 5 * MiB + 64 * 1024;
constexpr size_t WS_WQKV = 8 * MiB, WS_WO = 20 * MiB, WS_WKV = 24 * MiB, WS_WQ = 28 * MiB, WS_WBO = 32 * MiB, WS_W13 = 36 * MiB, WS_W2 = 58 * MiB, WS_MW13 = 70 * MiB, WS_MW2 = 294 * MiB;
constexpr size_t WS_XN = 408 * MiB, WS_XN2 = 440 * MiB, WS_XBF = 472 * MiB;
constexpr size_t WS_Q = 536 * MiB, WS_K = 600 * MiB, WS_V = 664 * MiB, WS_KSH = 728 * MiB, WS_VSH = 792 * MiB, WS_HID = 856 * MiB, WS_END = 1320 * MiB;
constexpr int TAIL_NS = 2, TAIL_ROWS = (MAXTILES - 256) * 256;
constexpr size_t WS_YT = WS_KSH;
constexpr size_t WS_XG = WS_Q;
static_assert((size_t)MAXTILES * 256 * D * 2 <= WS_KSH - WS_Q && (size_t)MAXTILES * 256 * FFE * 2 <= WS_END - WS_HID && WS_MW2 + (size_t)16 * D * FFE * 2 <= WS_XN, "d_ws map");
constexpr int CW_TMO = 0, CW_CODE = 1, CW_BAR = 4096;

constexpr int RING_OFF = 0, RING_BYTES = 131072;
constexpr int LDSCTL_OFF = RING_BYTES, MISC_OFF = LDSCTL_OFF + 320;
constexpr int ROUTE_OFF = RING_BYTES + 1024;
constexpr int RT_CNT = 0, RT_BASE = 8, RT_SEG = 16, RT_NT = 25, RT_TEXP = 32, RT_WC = 320, RT_LS = 336, RT_HIST = 600;
constexpr int PTR_OFF = RING_BYTES + 512;
constexpr int SCALEBUF_OFF = RING_BYTES + 4096;
constexpr int LDS_BYTES = 147456;
static_assert(ROUTE_OFF + (RT_HIST + 8) * 4 <= LDS_BYTES, "LDS map");

#define GAS __attribute__((address_space(1)))
#define LAS __attribute__((address_space(3)))
typedef unsigned short bf16;
typedef unsigned v4u __attribute__((ext_vector_type(4)));
typedef unsigned v2u __attribute__((ext_vector_type(2)));
typedef float f32x4 __attribute__((ext_vector_type(4)));
typedef float f32x2 __attribute__((ext_vector_type(2)));
typedef GAS unsigned gu32;
#define RLX_AGENT __ATOMIC_RELAXED, __HIP_MEMORY_SCOPE_AGENT
#define LDS_WAIT() asm volatile("s_waitcnt lgkmcnt(0)" ::: "memory")
#define VM_WAIT() asm volatile("s_waitcnt vmcnt(0)" ::: "memory")
__device__ __forceinline__ unsigned f2bf(float f) { unsigned u = __builtin_bit_cast(unsigned, f); return (u + 0x7fffu + ((u >> 16) & 1u)) >> 16; }
__device__ __forceinline__ unsigned pk2(float lo, float hi) { return f2bf(lo) | (f2bf(hi) << 16); }
__device__ __forceinline__ float bflo(unsigned w) { return __uint_as_float(w << 16); }
__device__ __forceinline__ float bfhi(unsigned w) { return __uint_as_float(w & 0xffff0000u); }
template <int CTRL> __device__ __forceinline__ float dppf(float v) { return __uint_as_float((unsigned)__builtin_amdgcn_update_dpp(0, (int)__float_as_uint(v), CTRL, 0xf, 0xf, true)); }
template <int CTRL> __device__ __forceinline__ int dppi(int v) { return __builtin_amdgcn_update_dpp(0, v, CTRL, 0xf, 0xf, true); }
#define DPP_X1 0xB1
#define DPP_X2 0x4E
#define DPP_HM 0x141
#define DPP_RM 0x140
#define DPP_X8 0x128
__device__ __forceinline__ float sum16x(float v) { const auto r = __builtin_amdgcn_permlane16_swap(__float_as_uint(v), __float_as_uint(v), false, false); return __uint_as_float(r[0]) + __uint_as_float(r[1]); }
__device__ __forceinline__ float sum32x(float v) { const auto r = __builtin_amdgcn_permlane32_swap(__float_as_uint(v), __float_as_uint(v), false, false); return __uint_as_float(r[0]) + __uint_as_float(r[1]); }
__device__ __forceinline__ float max16x(float v) { const auto r = __builtin_amdgcn_permlane16_swap(__float_as_uint(v), __float_as_uint(v), false, false); return fmaxf(__uint_as_float(r[0]), __uint_as_float(r[1])); }
__device__ __forceinline__ float max32x(float v) { const auto r = __builtin_amdgcn_permlane32_swap(__float_as_uint(v), __float_as_uint(v), false, false); return fmaxf(__uint_as_float(r[0]), __uint_as_float(r[1])); }
__device__ __forceinline__ int isum16x(int v) { const auto r = __builtin_amdgcn_permlane16_swap((unsigned)v, (unsigned)v, false, false); return (int)(r[0] + r[1]); }
__device__ __forceinline__ int isum32x(int v) { const auto r = __builtin_amdgcn_permlane32_swap((unsigned)v, (unsigned)v, false, false); return (int)(r[0] + r[1]); }
__device__ __forceinline__ float wave_sum(float v) { v += dppf<DPP_X1>(v); v += dppf<DPP_X2>(v); v += dppf<DPP_HM>(v); v += dppf<DPP_RM>(v); return sum32x(sum16x(v)); }
__device__ __forceinline__ float wave_max(float v) { v = fmaxf(v, dppf<DPP_X1>(v)); v = fmaxf(v, dppf<DPP_X2>(v)); v = fmaxf(v, dppf<DPP_HM>(v)); v = fmaxf(v, dppf<DPP_RM>(v)); return max32x(max16x(v)); }
__device__ __forceinline__ int wave_isum(int v) { v += dppi<DPP_X1>(v); v += dppi<DPP_X2>(v); v += dppi<DPP_HM>(v); v += dppi<DPP_RM>(v); return isum32x(isum16x(v)); }
__device__ __forceinline__ float max_x8_16_32(float v) { v = fmaxf(v, dppf<DPP_X8>(v)); return max32x(max16x(v)); }
__device__ __forceinline__ float ex2(float x) { return __builtin_amdgcn_exp2f(x); }
__device__ __forceinline__ float lg2(float x) { return __builtin_amdgcn_logf(x); }

#define XB_TMO      128
#define XB_XCNT(j)  (256  + 64 * (j))
#define XB_XSUB(j)  (1280 + 64 * (j))
#define XB_XGEN(j)  (2304 + 64 * (j))
#define XB_TOP      3328
#define XB_TOPGEN   3392
#define XB_LSUB(j)  (3456 + 64 * (j))
#define XB_LGEN(j)  (4480 + 64 * (j))
#define XCD_BAR_WORDS 5504
#define XB_SPIN_CAP (1u << 18)

__device__ __forceinline__ unsigned xb_ld(unsigned* p)              { return __hip_atomic_load(p, __ATOMIC_RELAXED, __HIP_MEMORY_SCOPE_AGENT); }
__device__ __forceinline__ unsigned xb_add(unsigned* p, unsigned v) { return __hip_atomic_fetch_add(p, v, __ATOMIC_RELAXED, __HIP_MEMORY_SCOPE_AGENT); }
__device__ __forceinline__ unsigned xb_xcc_id() { return (unsigned)__builtin_amdgcn_s_getreg((3 << 11) | 20) & 0xFu; }
#define XB_SPIN(cond, bar) do { unsigned _sp = 0; while (cond) { __builtin_amdgcn_s_sleep(1); \
    if ((++_sp & 255u) == 0u) { if (xb_ld(&(bar)[XB_TMO])) break; if (_sp > XB_SPIN_CAP) { atomicAdd(&(bar)[XB_TMO], 1u); break; } } } } while (0)

struct XcdBarrier {
    unsigned* bar; unsigned x;
    volatile LAS unsigned* st;
};

__device__ __forceinline__ XcdBarrier xcd_barrier_post(unsigned* bar, volatile LAS unsigned* st) {
    XcdBarrier b; b.bar = bar; b.x = xb_xcc_id(); b.st = st;
    if (threadIdx.x == 0) st[3] = 1u + xb_add(&bar[XB_XCNT(b.x)], 1u);
    return b;
}
__device__ __forceinline__ void xcd_barrier_complete(unsigned* bar, unsigned x, unsigned& nloc, unsigned& nx, unsigned& reg32) {
    const unsigned G = gridDim.x * gridDim.y * gridDim.z;
    unsigned sum, cnt, mine, n32, sp = 0u;
    for (;;) {
        sum = 0u; cnt = 0u; mine = 0u; n32 = 0u;
#pragma unroll
        for (unsigned j = 0; j < 16; ++j) { const unsigned c = xb_ld(&bar[XB_XCNT(j)]); sum += c; cnt += (c > 0u) ? 1u : 0u; n32 += (c == 32u && j < 8u) ? 1u : 0u; mine = (j == x) ? c : mine; }
        if (sum == G) break;
        __builtin_amdgcn_s_sleep(1);
        if ((++sp & 255u) == 0u) { if (xb_ld(&bar[XB_TMO])) break; if (sp > XB_SPIN_CAP) { atomicAdd(&bar[XB_TMO], 1u); break; } }
    }
    nloc = mine > 0u ? mine : 1u; nx = cnt > 0u ? cnt : 1u;
    reg32 = (sum == G && G == 256u && n32 == 8u) ? 1u : 0u;
}

__device__ __forceinline__ void xcd_barrier(const XcdBarrier& b) {
    asm volatile("s_waitcnt vmcnt(0)" ::: "memory");
    __syncthreads();
    if (threadIdx.x == 0) {
        unsigned* bar = b.bar;
        __builtin_amdgcn_s_waitcnt(0);
        unsigned nloc = b.st[0], nx = b.st[1];
        if (nloc == 0u) { unsigned r32; xcd_barrier_complete(bar, b.x, nloc, nx, r32); b.st[0] = nloc; b.st[1] = nx; b.st[2] = 1u + r32; }
        const unsigned old = xb_add(&bar[XB_XSUB(b.x)], 1u);
        const unsigned gen = old / nloc;
        if (old + 1u == (gen + 1u) * nloc) {
            __builtin_amdgcn_fence(__ATOMIC_RELEASE, "agent");
            asm volatile("s_waitcnt vmcnt(0)" ::: "memory");
            const unsigned og = xb_add(&bar[XB_TOP], 1u);
            const unsigned tg = og / nx;
            if (og + 1u == (tg + 1u) * nx) xb_add(&bar[XB_TOPGEN], 1u);
            else XB_SPIN(xb_ld(&bar[XB_TOPGEN]) == tg, bar);
            __builtin_amdgcn_fence(__ATOMIC_ACQUIRE, "agent");
            xb_add(&bar[XB_XGEN(b.x)], 1u);
            asm volatile("s_waitcnt vmcnt(0)" ::: "memory");
        } else {
            XB_SPIN(xb_ld(&bar[XB_XGEN(b.x)]) == gen, bar);
            __builtin_amdgcn_fence(__ATOMIC_ACQUIRE, "agent");
            asm volatile("s_waitcnt vmcnt(0)" ::: "memory");
        }
    }
    __syncthreads();
}

__device__ __forceinline__ void xcd_barrier_local(const XcdBarrier& b) {
    asm volatile("s_waitcnt vmcnt(0)" ::: "memory");
    __syncthreads();
    if (threadIdx.x == 0) {
        unsigned* bar = b.bar;
        __builtin_amdgcn_s_waitcnt(0);
        const unsigned old = xb_add(&bar[XB_LSUB(b.x)], 1u);
        const unsigned gen = old >> 5;
        if (((old + 1u) & 31u) == 0u) xb_add(&bar[XB_LGEN(b.x)], 1u);
        else XB_SPIN(xb_ld(&bar[XB_LGEN(b.x)]) == gen, bar);
        __builtin_amdgcn_fence(__ATOMIC_ACQUIRE, "agent");
        asm volatile("s_waitcnt vmcnt(0)" ::: "memory");
    }
    __syncthreads();
}

struct Ctx { LAS unsigned char* lds; int tid, lane, wave, vcu, G; };
__device__ __forceinline__ Ctx phase_ctx(const Ctx& C0) { Ctx C = C0; int t = C0.tid; asm volatile("" : "+v"(t)); C.tid = t; C.lane = t & 63; return C; }
enum { IN_X = 0, IN_C, IN_RELB, IN_MODW, IN_MODB, IN_NMIX, IN_NFFN, IN_AWQKV, IN_AWO, IN_KVNG, IN_KVMW, IN_KVMB, IN_BWKV, IN_BWQ, IN_BWO, IN_W13, IN_W2, IN_RW, IN_MW13, IN_MW2, IN_FNG, IN_OUT, IN_WS, IN_COUNT };
__device__ __forceinline__ unsigned long long ptr_bits(const Ctx& C, int k) {
    volatile LAS unsigned long long* t = (volatile LAS unsigned long long*)(C.lds + PTR_OFF);
    const unsigned long long v = t[k];
    const unsigned lo = __builtin_amdgcn_readfirstlane((unsigned)v), hi = __builtin_amdgcn_readfirstlane((unsigned)(v >> 32));
    return ((unsigned long long)hi << 32) | lo; }
__device__ __forceinline__ const float* inp(const Ctx& C, int k) { return (const float*)ptr_bits(C, k); }
__device__ __forceinline__ float* outp(const Ctx& C) { return (float*)ptr_bits(C, IN_OUT); }
__device__ __forceinline__ unsigned char* wsp(const Ctx& C) { return (unsigned char*)ptr_bits(C, IN_WS); }

__device__ __forceinline__ void tr_load(f32x4 (&v)[8], const float* W, int N, int cs, int k0, int lane) {
#pragma unroll
    for (int i = 0; i < 8; ++i) v[i] = *(const GAS f32x4*)(W + (size_t)(k0 + 8 * i + (lane >> 3)) * N + cs + 4 * (lane & 7));
}
template <bool F8>
__device__ __forceinline__ void tr_item(const f32x4 (&v)[8], int K, bf16* WT, int rd, int k0, LAS float* scr, int lane) {
#pragma unroll
    for (int i = 0; i < 8; ++i) { LAS float* d = scr + (8 * i + (lane >> 3)) * 33 + 4 * (lane & 7); d[0] = v[i].x; d[1] = v[i].y; d[2] = v[i].z; d[3] = v[i].w; }
    LDS_WAIT(); asm volatile("" ::: "memory");
    const int c = lane & 7;
    if (F8) {
#pragma unroll
        for (int j = 0; j < 4; ++j) { const int n = (lane >> 3) + 8 * j; const LAS float* s = scr + (8 * c) * 33 + n;
            v2u o; o.x = pg8::pk4_fp8(s[0 * 33] * WSCALE8, s[1 * 33] * WSCALE8, s[2 * 33] * WSCALE8, s[3 * 33] * WSCALE8); o.y = pg8::pk4_fp8(s[4 * 33] * WSCALE8, s[5 * 33] * WSCALE8, s[6 * 33] * WSCALE8, s[7 * 33] * WSCALE8);
            *(GAS v2u*)((unsigned char*)WT + (size_t)(rd + n) * K + k0 + 8 * c) = o; }
    } else {
#pragma unroll
        for (int j = 0; j < 4; ++j) { const int n = (lane >> 3) + 8 * j; const LAS float* s = scr + (8 * c) * 33 + n;
            v4u o; o.x = pk2(s[0 * 33], s[1 * 33]); o.y = pk2(s[2 * 33], s[3 * 33]); o.z = pk2(s[4 * 33], s[5 * 33]); o.w = pk2(s[6 * 33], s[7 * 33]);
            *(GAS v4u*)(WT + (size_t)(rd + n) * K + k0 + 8 * c) = o; }
    }
    LDS_WAIT(); asm volatile("" ::: "memory");
}
template <bool F8>
__device__ __forceinline__ void tr_group(const float* src, bf16* dst, int K, int N, int F, int cnt, int& it, int NTW, LAS float* scr, int lane) {
    const int nblk = N / 32, ipm = (K / 64) * nblk, total = cnt * ipm;
#define TRG_LOAD(vv, it_) do { const int mi_ = (it_) / ipm, r_ = (it_) - mi_ * ipm, kb_ = r_ / nblk, rd_ = 32 * (r_ - kb_ * nblk); int cs_ = rd_; \
        if (F) { const int j_ = rd_ >> 8, w_ = rd_ & 255; cs_ = (w_ < 128) ? 128 * j_ + w_ : F + 128 * j_ + (w_ - 128); } tr_load(vv, src + (size_t)mi_ * K * N, N, cs_, 64 * kb_, lane); } while (0)
    f32x4 v[8], vn[8];
    if (it < total) TRG_LOAD(v, it);
    for (; it < total; it += NTW) {
        const int mi = it / ipm, r = it - mi * ipm, kb = r / nblk, nb = r - kb * nblk, rd = 32 * nb;
        if (it + NTW < total) TRG_LOAD(vn, it + NTW);
        tr_item<F8>(v, K, F8 ? (bf16*)((unsigned char*)dst + (size_t)mi * K * N) : dst + (size_t)mi * K * N, rd, 64 * kb, scr, lane);
#pragma unroll
        for (int i = 0; i < 8; ++i) v[i] = vn[i];
    }
#undef TRG_LOAD
    it -= total;
}
__device__ __forceinline__ unsigned q8b(float x) { return __float_as_uint(x + 12582912.0f) & 0xffu; }
__device__ __forceinline__ void tr_group_i8(const float* src, unsigned char* dst, float* sBout, int K, int N, int F, int cnt, int& it, int NTW, LAS float* scr, int lane) {
    const int nblk = N / 32, total = cnt * nblk;
    for (; it < total; it += NTW) {
        const int mi = it / nblk, nb = it - mi * nblk, rd = 32 * nb;
        int cs = rd; if (F) { const int j = rd >> 8, w = rd & 255; cs = (w < 128) ? 128 * j + w : F + 128 * j + (w - 128); }
        const float* W = src + (size_t)mi * K * N + cs + 4 * (lane & 7);
        f32x4 mx = (f32x4){0.f, 0.f, 0.f, 0.f};
#pragma unroll 2
        for (int kb = 0; kb < K / 64; ++kb) {
#pragma unroll
            for (int i = 0; i < 8; ++i) { const f32x4 v = *(const GAS f32x4*)(W + (size_t)(64 * kb + 8 * i + (lane >> 3)) * N);
                mx.x = fmaxf(mx.x, fabsf(v.x)); mx.y = fmaxf(mx.y, fabsf(v.y)); mx.z = fmaxf(mx.z, fabsf(v.z)); mx.w = fmaxf(mx.w, fabsf(v.w)); } }
        mx.x = max_x8_16_32(mx.x); mx.y = max_x8_16_32(mx.y); mx.z = max_x8_16_32(mx.z); mx.w = max_x8_16_32(mx.w);
        f32x4 inv, sc;
        inv.x = mx.x > 0.f ? 127.0f / mx.x : 0.f; inv.y = mx.y > 0.f ? 127.0f / mx.y : 0.f; inv.z = mx.z > 0.f ? 127.0f / mx.z : 0.f; inv.w = mx.w > 0.f ? 127.0f / mx.w : 0.f;
        sc = mx * (1.0f / 127.0f);
        if ((lane >> 3) == 0) *(GAS f32x4*)(sBout + (size_t)mi * N + rd + 4 * (lane & 7)) = sc;
        unsigned char* WT = dst + ((size_t)mi * N + rd) * K;
        for (int kb = 0; kb < K / 64; ++kb) {
            f32x4 v[8];
#pragma unroll
            for (int i = 0; i < 8; ++i) v[i] = *(const GAS f32x4*)(W + (size_t)(64 * kb + 8 * i + (lane >> 3)) * N);
#pragma unroll
            for (int i = 0; i < 8; ++i) { LAS float* d = scr + (8 * i + (lane >> 3)) * 33 + 4 * (lane & 7); d[0] = v[i].x * inv.x; d[1] = v[i].y * inv.y; d[2] = v[i].z * inv.z; d[3] = v[i].w * inv.w; }
            LDS_WAIT(); asm volatile("" ::: "memory");
            const int c = lane & 7;
#pragma unroll
            for (int j = 0; j < 4; ++j) { const int n = (lane >> 3) + 8 * j; const LAS float* s = scr + (8 * c) * 33 + n;
                v2u o; o.x = q8b(s[0 * 33]) | (q8b(s[1 * 33]) << 8) | (q8b(s[2 * 33]) << 16) | (q8b(s[3 * 33]) << 24); o.y = q8b(s[4 * 33]) | (q8b(s[5 * 33]) << 8) | (q8b(s[6 * 33]) << 16) | (q8b(s[7 * 33]) << 24);
                *(GAS v2u*)(WT + (size_t)n * K + 64 * kb + 8 * c) = o; }
            LDS_WAIT(); asm volatile("" ::: "memory");
        }
    }
    it -= total;
}
__device__ __forceinline__ void i8_wg_group(const Ctx& C, const float* src, unsigned char* dst, float* sBout, int N, int F, int cnt, int& it, LAS float* scr) {
    constexpr int K = D;
    const int lane = C.lane, nblk = N / 32, total = cnt * nblk;
    LAS float* pmax = (LAS float*)(C.lds + 69632);
#define I8WG_SRC(it_) ([&](int i_) { const int mi_ = i_ / nblk, rd_ = 32 * (i_ - mi_ * nblk); int cs_ = rd_; if (F) { const int j_ = rd_ >> 8, w_ = rd_ & 255; cs_ = (w_ < 128) ? 128 * j_ + w_ : F + 128 * j_ + (w_ - 128); } \
        return src + (size_t)mi_ * K * N + (size_t)(128 * C.wave + (lane >> 3)) * N + cs_ + 4 * (lane & 7); })(it_)
    f32x4 v[16], vn[16];
    if (it < total) { const float* W0 = I8WG_SRC(it);
#pragma unroll
        for (int i = 0; i < 16; ++i) v[i] = *(const GAS f32x4*)(W0 + (size_t)(8 * i) * N); }
    for (; it < total; it += C.G) {
        const int mi = it / nblk, nb = it - mi * nblk, rd = 32 * nb, par = (it / C.G) & 1;
        f32x4 mx = (f32x4){0.f, 0.f, 0.f, 0.f};
#pragma unroll
        for (int i = 0; i < 16; ++i) { mx.x = fmaxf(mx.x, fabsf(v[i].x)); mx.y = fmaxf(mx.y, fabsf(v[i].y)); mx.z = fmaxf(mx.z, fabsf(v[i].z)); mx.w = fmaxf(mx.w, fabsf(v[i].w)); }
        mx.x = max_x8_16_32(mx.x); mx.y = max_x8_16_32(mx.y); mx.z = max_x8_16_32(mx.z); mx.w = max_x8_16_32(mx.w);
        if (lane < 8) *(LAS f32x4*)(pmax + (par * 8 + C.wave) * 32 + 4 * lane) = mx;
        __syncthreads();
        if (it + C.G < total) { const float* Wn = I8WG_SRC(it + C.G);
#pragma unroll
            for (int i = 0; i < 16; ++i) vn[i] = *(const GAS f32x4*)(Wn + (size_t)(8 * i) * N); }
#pragma unroll
        for (int w = 0; w < 8; ++w) { const f32x4 p = *(const LAS f32x4*)(pmax + (par * 8 + w) * 32 + 4 * (lane & 7)); mx.x = fmaxf(mx.x, p.x); mx.y = fmaxf(mx.y, p.y); mx.z = fmaxf(mx.z, p.z); mx.w = fmaxf(mx.w, p.w); }
        f32x4 inv;
        inv.x = mx.x > 0.f ? 127.0f / mx.x : 0.f; inv.y = mx.y > 0.f ? 127.0f / mx.y : 0.f; inv.z = mx.z > 0.f ? 127.0f / mx.z : 0.f; inv.w = mx.w > 0.f ? 127.0f / mx.w : 0.f;
        if (C.wave == 0 && lane < 8) *(GAS f32x4*)(sBout + (size_t)mi * N + rd + 4 * lane) = mx * (1.0f / 127.0f);
        unsigned char* WT = dst + ((size_t)mi * N + rd) * K + 128 * C.wave;
#pragma unroll
        for (int hf = 0; hf < 2; ++hf) {
#pragma unroll
            for (int i = 0; i < 8; ++i) { LAS float* d = scr + (8 * i + (lane >> 3)) * 33 + 4 * (lane & 7); const f32x4 x = v[8 * hf + i]; d[0] = x.x * inv.x; d[1] = x.y * inv.y; d[2] = x.z * inv.z; d[3] = x.w * inv.w; }
            LDS_WAIT(); asm volatile("" ::: "memory");
            const int c = lane & 7;
#pragma unroll
            for (int j = 0; j < 4; ++j) { const int n = (lane >> 3) + 8 * j; const LAS float* sp = scr + (8 * c) * 33 + n;
                v2u o; o.x = q8b(sp[0 * 33]) | (q8b(sp[1 * 33]) << 8) | (q8b(sp[2 * 33]) << 16) | (q8b(sp[3 * 33]) << 24); o.y = q8b(sp[4 * 33]) | (q8b(sp[5 * 33]) << 8) | (q8b(sp[6 * 33]) << 16) | (q8b(sp[7 * 33]) << 24);
                *(GAS v2u*)(WT + (size_t)n * K + 64 * hf + 8 * c) = o; }
            LDS_WAIT(); asm volatile("" ::: "memory");
        }
#pragma unroll
        for (int i = 0; i < 16; ++i) v[i] = vn[i];
    }
#undef I8WG_SRC
    it -= total;
}
__device__ __forceinline__ void gemv_mod(const Ctx& C, int w) {
    const float* Wm; const float* bias; int N, j0, ooff;
    if (w < 192) { const int l = w / 48, cb = w % 48; Wm = inp(C, IN_MODW) + (size_t)l * D * MODW; bias = inp(C, IN_MODB) + l * MODW; N = MODW; j0 = 128 * cb; ooff = l * MODW + j0; }
    else { const int cb = w - 192; Wm = inp(C, IN_KVMW); bias = inp(C, IN_KVMB); N = 2 * D; j0 = 128 * cb; ooff = KVMOD + j0; }
    const LAS f32x4* tab = (const LAS f32x4*)(C.lds + 65536) + 2 * 128 * C.wave;
    const GAS f32x2* wp = (const GAS f32x2*)(Wm + (size_t)(128 * C.wave) * N + j0) + C.lane;
    const size_t rs = (size_t)(N / 2);
    float a0[8], a1[8];
#pragma unroll
    for (int b = 0; b < 8; ++b) { a0[b] = 0.f; a1[b] = 0.f; }
#pragma unroll 16
    for (int k = 0; k < 128; ++k) {
        const f32x2 wv = wp[(size_t)k * rs]; const f32x4 s0 = tab[2 * k], s1 = tab[2 * k + 1];
        a0[0] += s0.x * wv.x; a1[0] += s0.x * wv.y; a0[1] += s0.y * wv.x; a1[1] += s0.y * wv.y; a0[2] += s0.z * wv.x; a1[2] += s0.z * wv.y; a0[3] += s0.w * wv.x; a1[3] += s0.w * wv.y;
        a0[4] += s1.x * wv.x; a1[4] += s1.x * wv.y; a0[5] += s1.y * wv.x; a1[5] += s1.y * wv.y; a0[6] += s1.z * wv.x; a1[6] += s1.z * wv.y; a0[7] += s1.w * wv.x; a1[7] += s1.w * wv.y;
    }
    LAS float* part = (LAS float*)(C.lds + 98304);
#pragma unroll
    for (int b = 0; b < 8; ++b) *(LAS f32x2*)(part + (C.wave * 8 + b) * 128 + 2 * C.lane) = (f32x2){a0[b], a1[b]};
    __syncthreads();
    float* mod = (float*)(wsp(C) + WS_MOD);
#pragma unroll
    for (int j = 0; j < 2; ++j) { const int idx = C.tid + 512 * j, b = idx >> 7, col = idx & 127; float s = bias[j0 + col];
#pragma unroll
        for (int ww = 0; ww < 8; ++ww) s += part[(ww * 8 + b) * 128 + col];
        mod[(size_t)b * MODLD + ooff + col] = s; }
    __syncthreads();
}
__device__ __forceinline__ void p0_prologue(const Ctx& C0) {
    const Ctx C = phase_ctx(C0);
    const int wg = (int)blockIdx.x;
    if (wg < 208) {
        LAS float* tab = (LAS float*)(C.lds + 65536);
        for (int idx = C.tid; idx < NB * D; idx += NWAVES * 64) { const int b = idx >> 10, k = idx & 1023; const float v = inp(C, IN_C)[idx]; tab[k * 8 + b] = v / (1.0f + __expf(-v)); }
        __syncthreads();
        gemv_mod(C, wg);
    } else if (wg < 224 && C.wave == 7) {
        const int h = wg - 208; float* bt = (float*)(wsp(C) + WS_BIAS) + h * 1024;
        for (int i = 0; i < 16; ++i) { const int d = C.lane + 64 * i; int bk;
            if (d < 16) bk = d; else { bk = 16 + (int)(logf((float)d / 16.0f) / 4.1588830833596715f * 16.0f); bk = bk > 31 ? 31 : bk; }
            bt[d] = inp(C, IN_RELB)[bk * NH + h] * LOG2E; }
    }
    {
        LAS float* scr = (LAS float*)(C.lds + C.wave * 8704);
        unsigned char* ws = wsp(C);
        int itg = wg;
        i8_wg_group(C, inp(C, IN_MW13), ws + WS_MW13, (float*)(ws + WS_SBM13), 2 * FFE, FFE, 16, itg, scr);
        i8_wg_group(C, inp(C, IN_W13), ws + WS_W13, (float*)(ws + WS_SB13), 2 * FF, FF, 2, itg, scr);
        i8_wg_group(C, inp(C, IN_AWQKV), ws + WS_WQKV, (float*)(ws + WS_SBQKV), 3 * D, 0, 2, itg, scr);
        i8_wg_group(C, inp(C, IN_BWKV), ws + WS_WKV, (float*)(ws + WS_SBKV), 2 * D, 0, 1, itg, scr);
        i8_wg_group(C, inp(C, IN_BWQ), ws + WS_WQ, (float*)(ws + WS_SBQ), D, 0, 2, itg, scr);
        int it = wg * NWAVES + C.wave; const int NTW = C.G * NWAVES;
        tr_group<true>(inp(C, IN_MW2), (bf16*)(ws + WS_MW2), FFE, D, 0, 16, it, NTW, scr, C.lane);
        tr_group<true>(inp(C, IN_W2), (bf16*)(ws + WS_W2), FF, D, 0, 2, it, NTW, scr, C.lane);
        tr_group<true>(inp(C, IN_AWO), (bf16*)(ws + WS_WO), D, D, 0, 2, it, NTW, scr, C.lane);
        tr_group<true>(inp(C, IN_BWO), (bf16*)(ws + WS_WBO), D, D, 0, 2, it, NTW, scr, C.lane);
    }
}

__device__ __forceinline__ void tail_row(v2u (&y)[4], const unsigned char* ws, int ts, int lane) {
    f32x4 p[TAIL_NS][4];
#pragma unroll
    for (int k = 0; k < TAIL_NS; ++k)
#pragma unroll
        for (int j = 0; j < 4; ++j) p[k][j] = ((const GAS f32x4*)((const float*)(ws + WS_YT) + ((size_t)k * TAIL_ROWS + ts) * D) + lane)[64 * j];
#pragma unroll
    for (int j = 0; j < 4; ++j) { f32x4 a = p[0][j];
#pragma unroll
        for (int k = 1; k < TAIL_NS; ++k) a += p[k][j];
        y[j] = (v2u){pk2(a.x, a.y), pk2(a.z, a.w)}; }
}
template <bool COMBINE, bool KV2, bool ROUTER, bool FINAL, bool F8OUT = false, bool XIN_F32 = false>
__device__ __forceinline__ void token_phase(const Ctx& C0, const void* xin, void* xout, const float* gnorm, int off_sh, int off_sc, bf16* XNo, int off_gf, const float* router) {
    const Ctx C = phase_ctx(C0);
    const int gw = C.vcu * NWAVES + C.wave, r0 = gw * 16, b = r0 >> 12, lane = C.lane;
    unsigned char* const ws = wsp(C);
    const float* modb = (const float*)(ws + WS_MOD) + (size_t)b * MODLD;
    const float* kvng = KV2 ? inp(C, IN_KVNG) : nullptr;
    f32x4 A[4], Bv[4], A2[4], B2[4], GF[4];
#pragma unroll
    for (int j = 0; j < 4; ++j) { const int col = 256 * j + 4 * lane;
        const f32x4 g = *(const f32x4*)(gnorm + col);
        if (FINAL) { A[j] = g; Bv[j] = (f32x4){0.f, 0.f, 0.f, 0.f}; }
        else { const f32x4 sc = *(const f32x4*)(modb + off_sc + col); A[j] = g * (sc + 1.0f); Bv[j] = *(const f32x4*)(modb + off_sh + col); }
        if (KV2) { const f32x4 g2 = *(const f32x4*)(kvng + col), sc2 = *(const f32x4*)(modb + KVMOD + D + col); A2[j] = g2 * (sc2 + 1.0f); B2[j] = *(const f32x4*)(modb + KVMOD + col); }
        if (COMBINE) GF[j] = *(const f32x4*)(modb + off_gf + col);
    }
    LAS int* rt = (LAS int*)(C.lds + ROUTE_OFF);
    if (ROUTER) {
        LAS float* rw = (LAS float*)C.lds;
        for (int i = C.tid; i < D * NE; i += NWAVES * 64) rw[i] = router[i];
        if (C.tid < 8) rt[RT_HIST + C.tid] = 0;
        __syncthreads();
    }
    int cnt[8];
#pragma unroll
    for (int e = 0; e < 8; ++e) cnt[e] = 0;
    const bf16* Y2 = (const bf16*)(ws + WS_XG);
    const int* tslot = (const int*)(ws + WS_TOKS); const float* tw = (const float*)(ws + WS_TOKW);
    constexpr int RG = 4;
    for (int i0 = 0; i0 < 16; i0 += RG) {
      f32x4 vin[RG][4]; v2u ya_[RG][4], yc_[RG][4]; float w0_[RG], w1_[RG]; int sl0_[RG], sl1_[RG];
#pragma unroll
      for (int rr = 0; rr < RG; ++rr) { const int row = r0 + i0 + rr;
        if (XIN_F32) { const GAS f32x4* xr = (const GAS f32x4*)((const float*)xin + (size_t)row * D) + lane;
#pragma unroll
            for (int j = 0; j < 4; ++j) vin[rr][j] = xr[64 * j];
        } else { const GAS v2u* xr = (const GAS v2u*)((const bf16*)xin + (size_t)row * D) + lane;
#pragma unroll
            for (int j = 0; j < 4; ++j) { const v2u w = xr[64 * j]; vin[rr][j] = (f32x4){bflo(w.x), bfhi(w.x), bflo(w.y), bfhi(w.y)}; } }
        if (COMBINE) {
            const int s0 = tslot[2 * row], s1 = tslot[2 * row + 1]; w0_[rr] = tw[2 * row]; w1_[rr] = tw[2 * row + 1]; sl0_[rr] = __builtin_amdgcn_readfirstlane(s0); sl1_[rr] = __builtin_amdgcn_readfirstlane(s1);
            const GAS v2u* y0 = (const GAS v2u*)(Y2 + (size_t)(s0 < 65536 ? s0 : 0) * D) + lane; const GAS v2u* y1 = (const GAS v2u*)(Y2 + (size_t)(s1 < 65536 ? s1 : 0) * D) + lane;
#pragma unroll
            for (int j = 0; j < 4; ++j) { ya_[rr][j] = y0[64 * j]; yc_[rr][j] = y1[64 * j]; } } }
      if (COMBINE) {
        int anyt = 0;
#pragma unroll
        for (int rr = 0; rr < RG; ++rr) anyt |= (sl0_[rr] | sl1_[rr]) >> 16;
        if (anyt) {
#pragma unroll
            for (int rr = 0; rr < RG; ++rr) {
                if (sl0_[rr] >= 65536) { tail_row(ya_[rr], ws, sl0_[rr] - 65536, lane); asm volatile("" ::: "memory"); }
                if (sl1_[rr] >= 65536) { tail_row(yc_[rr], ws, sl1_[rr] - 65536, lane); asm volatile("" ::: "memory"); } } } }
#pragma unroll
      for (int rr = 0; rr < RG; ++rr) {
        const int row = r0 + i0 + rr;
        f32x4 v[4];
#pragma unroll
        for (int j = 0; j < 4; ++j) v[j] = vin[rr][j];
        if (COMBINE) {
#pragma unroll
            for (int j = 0; j < 4; ++j) { const v2u a = ya_[rr][j], c = yc_[rr][j];
                f32x4 ya = (f32x4){bflo(a.x), bfhi(a.x), bflo(a.y), bfhi(a.y)}, yc = (f32x4){bflo(c.x), bfhi(c.x), bflo(c.y), bfhi(c.y)};
                v[j] = v[j] + GF[j] * (ya * w0_[rr] + yc * w1_[rr]); }
            if (!FINAL) { GAS v2u* xo = (GAS v2u*)((bf16*)xout + (size_t)row * D) + lane;
#pragma unroll
                for (int j = 0; j < 4; ++j) xo[64 * j] = (v2u){pk2(v[j].x, v[j].y), pk2(v[j].z, v[j].w)}; }
        }
        float ss = 0.f;
#pragma unroll
        for (int j = 0; j < 4; ++j) ss += (v[j].x * v[j].x + v[j].y * v[j].y) + (v[j].z * v[j].z + v[j].w * v[j].w);
        const float rstd = 1.0f / sqrtf(wave_sum(ss) * (1.0f / D) + RMS_EPS);
        f32x4 hv[4];
#pragma unroll
        for (int j = 0; j < 4; ++j) hv[j] = (v[j] * rstd) * A[j] + Bv[j];
        if (FINAL) { GAS f32x4* xo = (GAS f32x4*)((float*)xout + (size_t)row * D) + lane;
#pragma unroll
            for (int j = 0; j < 4; ++j) __builtin_nontemporal_store(hv[j], xo + 64 * j);
        } else if (F8OUT) { GAS unsigned* o4 = (GAS unsigned*)((unsigned char*)XNo + (size_t)row * D) + lane;
            float am = 0.f;
#pragma unroll
            for (int j = 0; j < 4; ++j) am = fmaxf(am, fmaxf(fmaxf(fabsf(hv[j].x), fabsf(hv[j].y)), fmaxf(fabsf(hv[j].z), fabsf(hv[j].w))));
            am = wave_max(am); const float inv = am > 0.f ? 127.0f / am : 0.f;
            if (lane == 0) ((float*)(ws + WS_SA))[row] = am * (1.0f / 127.0f);
#pragma unroll
            for (int j = 0; j < 4; ++j) o4[64 * j] = q8b(hv[j].x * inv) | (q8b(hv[j].y * inv) << 8) | (q8b(hv[j].z * inv) << 16) | (q8b(hv[j].w * inv) << 24);
        } else { GAS v2u* o8 = (GAS v2u*)(XNo + (size_t)row * D) + lane;
#pragma unroll
            for (int j = 0; j < 4; ++j) o8[64 * j] = (v2u){pk2(hv[j].x, hv[j].y), pk2(hv[j].z, hv[j].w)}; }
        if (KV2) { GAS unsigned* o4 = (GAS unsigned*)(ws + WS_XN2 + (size_t)row * D) + lane; f32x4 h2[4]; float am = 0.f;
#pragma unroll
            for (int j = 0; j < 4; ++j) { h2[j] = (v[j] * rstd) * A2[j] + B2[j]; am = fmaxf(am, fmaxf(fmaxf(fabsf(h2[j].x), fabsf(h2[j].y)), fmaxf(fabsf(h2[j].z), fabsf(h2[j].w)))); }
            am = wave_max(am); const float inv = am > 0.f ? 127.0f / am : 0.f;
            if (lane == 0) ((float*)(ws + WS_SA2))[row] = am * (1.0f / 127.0f);
#pragma unroll
            for (int j = 0; j < 4; ++j) o4[64 * j] = q8b(h2[j].x * inv) | (q8b(h2[j].y * inv) << 8) | (q8b(h2[j].z * inv) << 16) | (q8b(h2[j].w * inv) << 24); }
        if (ROUTER) {
            const LAS f32x4* rw = (const LAS f32x4*)C.lds;
            f32x4 p0 = (f32x4){0.f, 0.f, 0.f, 0.f}, p1 = p0;
#pragma unroll
            for (int j = 0; j < 4; ++j) { const int col = 256 * j + 4 * lane;
                p0 += rw[2 * col + 0] * hv[j].x; p1 += rw[2 * col + 1] * hv[j].x; p0 += rw[2 * col + 2] * hv[j].y; p1 += rw[2 * col + 3] * hv[j].y;
                p0 += rw[2 * col + 4] * hv[j].z; p1 += rw[2 * col + 5] * hv[j].z; p0 += rw[2 * col + 6] * hv[j].w; p1 += rw[2 * col + 7] * hv[j].w; }
            float p[8] = {wave_sum(p0.x), wave_sum(p0.y), wave_sum(p0.z), wave_sum(p0.w), wave_sum(p1.x), wave_sum(p1.y), wave_sum(p1.z), wave_sum(p1.w)};
            int e0 = 0; float v0 = p[0];
#pragma unroll
            for (int e = 1; e < 8; ++e) if (p[e] > v0) { v0 = p[e]; e0 = e; }
            int e1 = 0; float v1 = -INFINITY;
#pragma unroll
            for (int e = 0; e < 8; ++e) if (e != e0 && p[e] > v1) { v1 = p[e]; e1 = e; }
            const float w0 = 1.0f / (1.0f + __expf(v1 - v0)), w1 = 1.0f - w0;
            if (lane == 0) { ((int*)(ws + WS_TOKE))[row] = e0 | (e1 << 8); *(f32x2*)((float*)(ws + WS_TOKW) + 2 * row) = (f32x2){w0, w1}; }
#pragma unroll
            for (int e = 0; e < 8; ++e) cnt[e] += (e == e0 || e == e1) ? 1 : 0;
        }
      }
    }
    if (ROUTER) {
        if (lane == 0) {
#pragma unroll
            for (int e = 0; e < 8; ++e) __hip_atomic_fetch_add(rt + RT_HIST + e, cnt[e], __ATOMIC_RELAXED, __HIP_MEMORY_SCOPE_WORKGROUP);
        }
        __syncthreads();
        if (C.tid < 8) ((int*)(ws + WS_HIST))[C.vcu * 8 + C.tid] = rt[RT_HIST + C.tid];
    }
}

__device__ __forceinline__ void route_phase(const Ctx& C0, const bf16* XN) {
    const Ctx C = phase_ctx(C0);
    LAS int* rt = (LAS int*)(C.lds + ROUTE_OFF);
    unsigned char* const ws = wsp(C);
    const int* hist = (const int*)(ws + WS_HIST);
    { const int e = C.wave; int tot = 0, pre = 0;
#pragma unroll
      for (int i = 0; i < 4; ++i) { const int wg = C.lane + 64 * i; const int v = hist[wg * 8 + e]; tot += v; pre += (wg < C.vcu) ? v : 0; }
      tot = wave_isum(tot); pre = wave_isum(pre);
      if (C.lane == 0) { rt[RT_CNT + e] = tot; rt[RT_BASE + e] = pre; } }
    __syncthreads();
    { int tp[9]; tp[0] = 0;
#pragma unroll
        for (int e = 0; e < 8; ++e) tp[e + 1] = tp[e] + ((rt[RT_CNT + e] + 255) >> 8);
        if (C.tid < 9) { int v = 0;
#pragma unroll
            for (int e = 0; e < 9; ++e) v = (C.tid == e) ? tp[e] : v;
            rt[RT_SEG + C.tid] = v * 256; }
        if (C.tid == 9) rt[RT_NT] = tp[8] < MAXTILES ? tp[8] : MAXTILES;
        if (C.tid < MAXTILES && C.tid < tp[8]) { int e = 0;
#pragma unroll
            for (int k = 1; k < 8; ++k) e += (C.tid >= tp[k]) ? 1 : 0;
            rt[RT_TEXP + C.tid] = e; } }
    __syncthreads();
    const int tok = 128 * C.vcu + (C.tid & 127);
    int e0 = -1, e1 = -1; if (C.tid < 128) { const int ee = ((const int*)(ws + WS_TOKE))[tok]; e0 = ee & 255; e1 = ee >> 8; }
    unsigned long long bal[8];
#pragma unroll
    for (int e = 0; e < 8; ++e) bal[e] = __ballot((e0 == e) || (e1 == e));
    if (C.tid == 0) {
#pragma unroll
        for (int e = 0; e < 8; ++e) rt[RT_WC + e] = __popcll(bal[e]);
    }
    __syncthreads();
    if (C.tid < 128) { int s0 = 0, s1 = 0; const unsigned long long lt = (1ull << C.lane) - 1ull;
#pragma unroll
        for (int e = 0; e < 8; ++e) { const int slot = rt[RT_SEG + e] + rt[RT_BASE + e] + __popcll(bal[e] & lt) + (C.wave == 1 ? rt[RT_WC + e] : 0); if (e0 == e) s0 = slot; if (e1 == e) s1 = slot; }
        ((int*)(ws + WS_TOKS))[2 * tok] = s0; ((int*)(ws + WS_TOKS))[2 * tok + 1] = s1; rt[RT_LS + 2 * C.tid] = s0; rt[RT_LS + 2 * C.tid + 1] = s1; }
    __syncthreads();
    bf16* XG = (bf16*)(ws + WS_XG);
    v4u rowv[16]; float sav = 0.f;
#pragma unroll
    for (int i = 0; i < 16; ++i) { const int t2 = 128 * C.vcu + 16 * C.wave + i; rowv[i] = ((const GAS v4u*)((const unsigned char*)XN + (size_t)t2 * D))[C.lane]; }
    if (C.lane < 16) sav = ((const GAS float*)(ws + WS_SA))[128 * C.vcu + 16 * C.wave + C.lane];
#pragma unroll
    for (int i = 0; i < 16; ++i) { const int tl = 16 * C.wave + i; const int s0 = rt[RT_LS + 2 * tl], s1 = rt[RT_LS + 2 * tl + 1];
        ((GAS v4u*)((unsigned char*)XG + (size_t)s0 * D))[C.lane] = rowv[i]; ((GAS v4u*)((unsigned char*)XG + (size_t)s1 * D))[C.lane] = rowv[i]; }
    if (C.lane < 16) { const int tl = 16 * C.wave + C.lane; ((GAS float*)(ws + WS_SAG))[rt[RT_LS + 2 * tl]] = sav; ((GAS float*)(ws + WS_SAG))[rt[RT_LS + 2 * tl + 1]] = sav; }
}

__device__ __forceinline__ void kmean_phase(const Ctx& C0, const bf16* Kb) {
    const Ctx C = phase_ctx(C0);
    const int gw = C.vcu * NWAVES + C.wave;
    if (gw < 1024) { const int cb = gw & 7, n = (gw >> 3) & 15, b = gw >> 7;
        const GAS unsigned* kp = (const GAS unsigned*)(Kb + ((size_t)(b * SEQ + 256 * n)) * D + 128 * cb) + C.lane; float s0 = 0.f, s1 = 0.f;
#pragma unroll 16
        for (int i = 0; i < 256; ++i) { const unsigned w = kp[(size_t)i * (D / 2)]; s0 += bflo(w); s1 += bfhi(w); }
        const int col = 128 * cb + 2 * C.lane, h = col >> 6, d = col & 63;
        float* km = (float*)(wsp(C) + WS_KMEAN) + ((size_t)((b * NH + h) * 16 + n)) * 64 + d; km[0] = s0 * (1.f / 256.f); km[1] = s1 * (1.f / 256.f); }
}


namespace att {
typedef short bf16x8 __attribute__((ext_vector_type(8)));
typedef float f32x16 __attribute__((ext_vector_type(16)));
typedef short v4i16_t __attribute__((ext_vector_type(4)));
__device__ __forceinline__ unsigned cvtpk(float lo, float hi) { typedef float f2 __attribute__((ext_vector_type(2))); typedef __bf16 b2 __attribute__((ext_vector_type(2))); const f2 v = {lo, hi}; const b2 b = __builtin_convertvector(v, b2); return __builtin_bit_cast(unsigned, b); }
__device__ __forceinline__ float swap32(float x, int hi) { auto rr = __builtin_amdgcn_permlane32_swap(__float_as_uint(x), __float_as_uint(x), false, false); return __uint_as_float(hi ? rr[0] : rr[1]); }
__device__ __forceinline__ void dma_k_piece(const bf16* Kh, int kv0, int piece, LAS unsigned char* kslot, int lane) {
    const int row = 8 * piece + (lane >> 3);
    const bf16* src = Kh + (size_t)(kv0 + row) * D + ((lane & 7) ^ ((row >> 1) & 7)) * 8;
    __builtin_amdgcn_global_load_lds((const unsigned*)src, (LAS unsigned*)(kslot + piece * 1024), 16, 0, 0); }
__device__ __forceinline__ void dma_v_piece(const bf16* Vh, int kv0, int piece, LAS unsigned char* vslot, int lane) {
    const int row = 8 * piece + (lane >> 3);
    const bf16* src = Vh + (size_t)(kv0 + row) * D + ((lane & 7) ^ (((row >> 1) & 1) << 2)) * 8;
    __builtin_amdgcn_global_load_lds((const unsigned*)src, (LAS unsigned*)(vslot + piece * 1024), 16, 0, 0); }
__device__ __forceinline__ int kfrag_off(int d0, int r32, int hi) { return 128 * r32 + 16 * ((2 * d0 + hi) ^ ((r32 >> 1) & 7)); }
__device__ __forceinline__ void qkt(f32x16& p0, f32x16& p1, const LAS unsigned char* kslot, const bf16x8 (&qr)[4], int r32, int hi) {
    p0 = (f32x16){0.f, 0.f, 0.f, 0.f, 0.f, 0.f, 0.f, 0.f, 0.f, 0.f, 0.f, 0.f, 0.f, 0.f, 0.f, 0.f}; p1 = p0;
    bf16x8 kf[8];
#pragma unroll
    for (int d0 = 0; d0 < 4; ++d0) { const LAS unsigned char* kb = kslot + kfrag_off(d0, r32, hi); kf[2 * d0] = *(const LAS bf16x8*)(kb); kf[2 * d0 + 1] = *(const LAS bf16x8*)(kb + 4096); }
#pragma unroll
    for (int d0 = 0; d0 < 4; ++d0) { p0 = __builtin_amdgcn_mfma_f32_32x32x16_bf16(kf[2 * d0], qr[d0], p0, 0, 0, 0); p1 = __builtin_amdgcn_mfma_f32_32x32x16_bf16(kf[2 * d0 + 1], qr[d0], p1, 0, 0, 0); }
}
__device__ __forceinline__ v4i16_t vtr(const LAS unsigned char* p) { return __builtin_amdgcn_ds_read_tr16_b64_v4i16((LAS v4i16_t*)p); }
__device__ __forceinline__ void pvt(f32x16 (&o)[2], const LAS unsigned char* vslot, int lane, const v4u (&pw)[4]) {
    const int r = (lane & 15) >> 2, f = (r >> 1) & 1;
    const LAS unsigned char* vb0 = vslot + (4 * (lane >> 5) + r) * 128 + f * 64 + ((lane >> 4) & 1) * 32 + (lane & 3) * 8;
    const LAS unsigned char* vb1 = vslot + (4 * (lane >> 5) + r) * 128 + (f ^ 1) * 64 + ((lane >> 4) & 1) * 32 + (lane & 3) * 8;
    v4i16_t lo[8], hh[8];
#pragma unroll
    for (int i = 0; i < 4; ++i) { lo[i] = vtr(vb0 + i * 2048); hh[i] = vtr(vb0 + i * 2048 + 1024); lo[4 + i] = vtr(vb1 + i * 2048); hh[4 + i] = vtr(vb1 + i * 2048 + 1024); }
#pragma unroll
    for (int i = 0; i < 8; ++i) { const bf16x8 vf = (bf16x8){lo[i][0], lo[i][1], lo[i][2], lo[i][3], hh[i][0], hh[i][1], hh[i][2], hh[i][3]};
        o[i >> 2] = __builtin_amdgcn_mfma_f32_32x32x16_bf16(vf, __builtin_bit_cast(bf16x8, pw[i & 3]), o[i >> 2], 0, 0, 0); }
}
__device__ __forceinline__ void pack_p(v4u (&pw)[4], const f32x16& p0, const f32x16& p1) {
#pragma unroll
    for (int i = 0; i < 4; ++i) { pw[0][i] = cvtpk(p0[2 * i], p0[2 * i + 1]); pw[1][i] = cvtpk(p0[8 + 2 * i], p0[9 + 2 * i]); pw[2][i] = cvtpk(p1[2 * i], p1[2 * i + 1]); pw[3][i] = cvtpk(p1[8 + 2 * i], p1[9 + 2 * i]); }
}
__device__ __forceinline__ void store_o(bf16* Orow  , const f32x16 (&o)[2], float scale, int hi) {
#pragma unroll
    for (int dh = 0; dh < 2; ++dh)
#pragma unroll
        for (int gp = 0; gp < 2; ++gp) { float na[4], nb[4];
#pragma unroll
            for (int e = 0; e < 4; ++e) { auto rr = __builtin_amdgcn_permlane32_swap(__float_as_uint(o[dh][8 * gp + e] * scale), __float_as_uint(o[dh][8 * gp + 4 + e] * scale), false, false); na[e] = __uint_as_float(rr[0]); nb[e] = __uint_as_float(rr[1]); }
            const v4u w = (v4u){cvtpk(na[0], na[1]), cvtpk(na[2], na[3]), cvtpk(nb[0], nb[1]), cvtpk(nb[2], nb[3])};
            *(GAS v4u*)(Orow + 32 * dh + 8 * (2 * gp + hi)) = w; }
}
constexpr int BT_DMAX = 1119, BT_LEN = BT_DMAX + 1 + BT_PAD, BT_CS = 1424;
static_assert(BT_CS >= BT_LEN + 4 && BT_CS % 64 == 16, "bias table copies");
__device__ __forceinline__ const LAS float* bias_ptr(const LAS float* bt, int qrow, int hi, int tile) {
    const int jb = BT_DMAX - qrow + 64 * tile + 4 * hi, m = jb & 3, jc = jb > m ? jb : m;
    return bt + m * BT_CS - m + jc; }
__device__ __forceinline__ void store_o8(unsigned char* Orow  , const f32x16 (&o)[2], float scale, int hi) {
#pragma unroll
    for (int dh = 0; dh < 2; ++dh)
#pragma unroll
        for (int gp = 0; gp < 2; ++gp) { float na[4], nb[4];
#pragma unroll
            for (int e = 0; e < 4; ++e) { auto rr = __builtin_amdgcn_permlane32_swap(__float_as_uint(o[dh][8 * gp + e] * scale), __float_as_uint(o[dh][8 * gp + 4 + e] * scale), false, false); na[e] = __uint_as_float(rr[0]); nb[e] = __uint_as_float(rr[1]); }
            const v2u w = (v2u){pg8::pk4_fp8(na[0], na[1], na[2], na[3]), pg8::pk4_fp8(nb[0], nb[1], nb[2], nb[3])};
            *(GAS v2u*)(Orow + 32 * dh + 8 * (2 * gp + hi)) = w; }
}
}

#define MOBA_WAITBAR(N) do { if (!(VAR & 1)) asm volatile("s_waitcnt vmcnt(" #N ") lgkmcnt(0)\n\ts_barrier" ::: "memory"); } while (0)
__device__ __forceinline__ float vmax3(float a, float b, float c) { float r; asm("v_max3_f32 %0, %1, %2, %3" : "=v"(r) : "v"(a), "v"(b), "v"(c)); return r; }
__device__ __forceinline__ float vadd(float a, float b) { float r; asm("v_add_f32_e32 %0, %1, %2" : "=v"(r) : "v"(a), "v"(b)); return r; }
__device__ __forceinline__ float vmax(float a, float b) { float r; asm("v_max_f32_e32 %0, %1, %2" : "=v"(r) : "v"(a), "v"(b)); return r; }
__device__ __forceinline__ float vmul(float a, float b) { float r; asm("v_mul_f32_e32 %0, %1, %2" : "=v"(r) : "v"(a), "v"(b)); return r; }
#define MSB() __builtin_amdgcn_sched_barrier(0)
#define ME4(X, i) do { if (VAR & 8) break; X[i] = ex2(X[i]); X[(i) + 1] = ex2(X[(i) + 1]); X[(i) + 2] = ex2(X[(i) + 2]); X[(i) + 3] = ex2(X[(i) + 3]); } while (0)
#define MC2(W, j, X, i) do { if (VAR & 8) break; W[j] = att::cvtpk(X[i], X[(i) + 1]); W[(j) + 1] = att::cvtpk(X[(i) + 2], X[(i) + 3]); } while (0)
#define MMF(a, b, c) ((VAR & 4) ? (c) : __builtin_amdgcn_mfma_f32_32x32x16_bf16(a, b, c, 0, 0, 0))
template <int VAR>
__device__ __forceinline__ void moba_step(att::f32x16& A0, att::f32x16& A1, att::f32x16& B0, att::f32x16& B1, int s, int NT, int u, int wid, int lane, int qrow, unsigned selmask,
                                          float& mref, float& l, att::f32x16 (&o)[2], const LAS unsigned char* lds, const LAS float* bt, const att::bf16x8 (&qr)[4], att::bf16x8 (&kf)[8]) {
    const int r32 = lane & 31, hi = lane >> 5;
    const int s1 = (s + 1 < NT) ? s + 1 : s;
    const int t1 = (s1 < 4) ? 4 * u + s1 : s1 - 4;
    const bool mine = (s1 < 4) ? (2 * s1 <= wid) : (((selmask >> (t1 >> 2)) & 1u) != 0u);
    const unsigned q0w = hi ? 0u : (mine ? (__float_as_uint(-mref) >> 16) : 0xFF80u), k0w = hi ? 0u : 0x3F80u;
    const att::bf16x8 qaug = __builtin_bit_cast(att::bf16x8, (v4u){q0w, 0u, 0u, 0u}), kone = __builtin_bit_cast(att::bf16x8, (v4u){k0w, 0u, 0u, 0u});
    const LAS unsigned char* vsl = lds + (s % 5) * 16384 + 8192;
    const int s2 = (s + 2 < NT) ? s + 2 : NT - 1, t2 = (s2 < 4) ? 4 * u + s2 : s2 - 4;
    const LAS unsigned char* ksl2 = lds + (s2 % 5) * 16384;
    const LAS float* bp2 = att::bias_ptr(bt, qrow, hi, t2); asm volatile("" : "+v"(bp2));
#define MBL(g) do { const f32x4 x0_ = *(const LAS f32x4*)(bp2 + 8 * (g)), x1_ = *(const LAS f32x4*)(bp2 + 32 + 8 * (g)); \
        A0[4 * (g)] = x0_.x; A0[4 * (g) + 1] = x0_.y; A0[4 * (g) + 2] = x0_.z; A0[4 * (g) + 3] = x0_.w; A1[4 * (g)] = x1_.x; A1[4 * (g) + 1] = x1_.y; A1[4 * (g) + 2] = x1_.z; A1[4 * (g) + 3] = x1_.w; } while (0)
#define MKL(d0) do { const LAS unsigned char* kb_ = ksl2 + att::kfrag_off(d0, r32, hi); kf[2 * (d0)] = *(const LAS att::bf16x8*)(kb_); kf[2 * (d0) + 1] = *(const LAS att::bf16x8*)(kb_ + 4096); } while (0)
    const int vr = (lane & 15) >> 2, vf_ = (vr >> 1) & 1;
    const LAS unsigned char* vb0 = vsl + (4 * hi + vr) * 128 + vf_ * 64 + ((lane >> 4) & 1) * 32 + (lane & 3) * 8;
    const LAS unsigned char* vb1 = vsl + (4 * hi + vr) * 128 + (vf_ ^ 1) * 64 + ((lane >> 4) & 1) * 32 + (lane & 3) * 8;
    asm volatile("" : "+v"(vb0), "+v"(vb1));
    att::v4i16_t lo[8], hh[8]; v4u pw[4];
    MSB();
    B0 = MMF(kf[0], qr[0], B0); ME4(A0, 0);  MC2(pw[0], 0, A0, 0);  MSB();
    B1 = MMF(kf[1], qr[0], B1); ME4(A0, 4);  MC2(pw[0], 2, A0, 4);  MSB();
    B0 = MMF(kf[2], qr[1], B0); ME4(A0, 8);  MC2(pw[1], 0, A0, 8);  MSB();
    B1 = MMF(kf[3], qr[1], B1); ME4(A0, 12); MC2(pw[1], 2, A0, 12); MSB();
    B0 = MMF(kf[4], qr[2], B0); ME4(A1, 0);  MC2(pw[2], 0, A1, 0);  lo[0] = att::vtr(vb0); hh[0] = att::vtr(vb0 + 1024); lo[1] = att::vtr(vb0 + 2048); hh[1] = att::vtr(vb0 + 3072); MSB();
    B1 = MMF(kf[5], qr[2], B1); ME4(A1, 4);  MC2(pw[2], 2, A1, 4);  lo[2] = att::vtr(vb0 + 4096); hh[2] = att::vtr(vb0 + 5120); lo[3] = att::vtr(vb0 + 6144); hh[3] = att::vtr(vb0 + 7168); MSB();
    B0 = MMF(kf[6], qr[3], B0); ME4(A1, 8);  MC2(pw[3], 0, A1, 8);  lo[4] = att::vtr(vb1); hh[4] = att::vtr(vb1 + 1024); lo[5] = att::vtr(vb1 + 2048); hh[5] = att::vtr(vb1 + 3072); MSB();
    B1 = MMF(kf[7], qr[3], B1); ME4(A1, 12); MC2(pw[3], 2, A1, 12); lo[6] = att::vtr(vb1 + 4096); hh[6] = att::vtr(vb1 + 5120); lo[7] = att::vtr(vb1 + 6144); hh[7] = att::vtr(vb1 + 7168); MSB();
    B0 = MMF(kone, qaug, B0); MSB();
    B1 = MMF(kone, qaug, B1); MSB();
#define MVF(i) (att::bf16x8){lo[i][0], lo[i][1], lo[i][2], lo[i][3], hh[i][0], hh[i][1], hh[i][2], hh[i][3]}
#define MPW(k) __builtin_bit_cast(att::bf16x8, pw[k])
    float la, lb, lc, ld, ma, mb, mc, md;
    o[0] = MMF(MVF(0), MPW(0), o[0]); la = vadd(A0[0], A0[1]); lb = vadd(A1[0], A1[1]); lc = vadd(A0[2], A0[3]); ld = vadd(A1[2], A1[3]); la = vadd(la, A0[4]); lb = vadd(lb, A1[4]); MSB();
    o[0] = MMF(MVF(1), MPW(1), o[0]); lc = vadd(lc, A0[5]); ld = vadd(ld, A1[5]); la = vadd(la, A0[6]); lb = vadd(lb, A1[6]); lc = vadd(lc, A0[7]); ld = vadd(ld, A1[7]); la = vadd(la, A0[8]); lb = vadd(lb, A1[8]); MSB();
    o[0] = MMF(MVF(2), MPW(2), o[0]); lc = vadd(lc, A0[9]); ld = vadd(ld, A1[9]); la = vadd(la, A0[10]); lb = vadd(lb, A1[10]); lc = vadd(lc, A0[11]); ld = vadd(ld, A1[11]); la = vadd(la, A0[12]); lb = vadd(lb, A1[12]); MSB();
    o[0] = MMF(MVF(3), MPW(3), o[0]); lc = vadd(lc, A0[13]); ld = vadd(ld, A1[13]); la = vadd(la, A0[14]); lb = vadd(lb, A1[14]); lc = vadd(lc, A0[15]); ld = vadd(ld, A1[15]); la = vadd(la, lc); lb = vadd(lb, ld); MSB();
    o[1] = MMF(MVF(4), MPW(0), o[1]); MKL(0); MBL(0); ma = vmax3(B0[0], B0[1], B0[2]); mb = vmax3(B1[0], B1[1], B1[2]); mc = vmax3(B0[3], B0[4], B0[5]); md = vmax3(B1[3], B1[4], B1[5]); MSB();
    o[1] = MMF(MVF(5), MPW(1), o[1]); MKL(1); MBL(1); ma = vmax3(ma, B0[6], B0[7]); mb = vmax3(mb, B1[6], B1[7]); mc = vmax3(mc, B0[8], B0[9]); md = vmax3(md, B1[8], B1[9]); MSB();
    o[1] = MMF(MVF(6), MPW(2), o[1]); MKL(2); MBL(2); ma = vmax3(ma, B0[10], B0[11]); mb = vmax3(mb, B1[10], B1[11]); mc = vmax3(mc, B0[12], B0[13]); md = vmax3(md, B1[12], B1[13]); MSB();
    o[1] = MMF(MVF(7), MPW(3), o[1]); MKL(3); MBL(3); ma = vmax3(ma, B0[14], B0[15]); mb = vmax3(mb, B1[14], B1[15]); ma = vmax3(ma, mc, md); MSB();
#undef MVF
#undef MPW
#undef MBL
#undef MKL
    l += vadd(la, lb);
    float mx = vmax(ma, mb); mx = vmax(mx, att::swap32(mx, hi));
    const bool mv = mx > 8.0f;
    if (__any(mv)) {
        const float nref = mv ? __uint_as_float((__float_as_uint(mref + mx) + 0x8000u) & 0xffff0000u) : mref, d = nref - mref, f = ex2(-d); mref = nref; l *= f;
#pragma unroll
        for (int r = 0; r < 16; ++r) { o[0][r] *= f; o[1][r] *= f; B0[r] -= d; B1[r] -= d; } }
}
template <int VAR>
__device__ __forceinline__ void moba_phase(const Ctx& C0, const bf16* Q, const bf16* Kb, const bf16* Vb, bf16* O) {
    const Ctx C = phase_ctx(C0);
    const int lane = C.lane, r32 = lane & 31, hi = lane >> 5, wid = C.wave;
    unsigned char* const ws = wsp(C);
    const float* kmean = (const float*)(ws + WS_KMEAN); const float* btab = (const float*)(ws + WS_BIAS);
    LAS unsigned char* lds = C.lds;
    LAS float* bt = (LAS float*)(lds + 81920);
    const int bh = C.vcu >> 1, b = bh >> 4, h = bh & 15;
    for (int i = C.tid; i < 4 * att::BT_CS; i += NWAVES * 64) { const int m = i / att::BT_CS, j = i - m * att::BT_CS + m, d = att::BT_DMAX - j;
        bt[i] = (j >= att::BT_LEN || d < 0) ? -INFINITY : btab[h * 1024 + (d > 1023 ? 1023 : d)]; }
    const bf16* Kh = Kb + (size_t)b * SEQ * D + h * HD; const bf16* Vh = Vb + (size_t)b * SEQ * D + h * HD;
    LAS float* kml = (LAS float*)(lds + 81920 + 4 * att::BT_CS * 4);
#pragma unroll 1
    for (int nn = 0; nn < 2; ++nn) { const int n = 2 * wid + nn; const GAS v4u* kp = (const GAS v4u*)(Kh + (size_t)(256 * n + (lane >> 3)) * D) + (lane & 7); float sk[8];
#pragma unroll
        for (int j = 0; j < 8; ++j) sk[j] = 0.f;
#pragma unroll 16
        for (int i = 0; i < 32; ++i) { const v4u w = kp[(size_t)i * (8 * D / 8)];
            sk[0] += bflo(w.x); sk[1] += bfhi(w.x); sk[2] += bflo(w.y); sk[3] += bfhi(w.y); sk[4] += bflo(w.z); sk[5] += bfhi(w.z); sk[6] += bflo(w.w); sk[7] += bfhi(w.w); }
#pragma unroll
        for (int j = 0; j < 8; ++j) { float t = sk[j]; t += dppf<DPP_X8>(t); sk[j] = sum32x(sum16x(t)); }
        if (lane < 8) {
#pragma unroll
            for (int j = 0; j < 8; ++j) kml[n * 64 + 8 * lane + j] = sk[j] * (1.f / 256.f); } }
    __syncthreads();
    for (int iu = 0; iu < 8; ++iu) {
        const int sidx0 = 4 * (C.vcu & 1) + (iu >> 1), u = (iu & 1) ? 15 - sidx0 : sidx0;
        const int qrow = 256 * u + 32 * wid + r32, tok = b * SEQ + qrow;
#define MOBA_TILE(s) (((s) < 4) ? 4 * u + (s) : (s) - 4)
#define MOBA_DMA(s) do { if (VAR & 2) break; const int t_ = MOBA_TILE(s); att::dma_k_piece(Kh, 64 * t_, wid, lds + ((s) % 5) * 16384, lane); att::dma_v_piece(Vh, 64 * t_, wid, lds + ((s) % 5) * 16384 + 8192, lane); } while (0)
        MOBA_DMA(0); MOBA_DMA(1); MOBA_DMA(2); MOBA_DMA(3);
        att::bf16x8 qr[4];
#pragma unroll
        for (int d0 = 0; d0 < 4; ++d0) qr[d0] = *(const GAS att::bf16x8*)(Q + (size_t)tok * D + h * HD + d0 * 16 + hi * 8);
        unsigned selmask = 0;
        if (u <= 3) selmask = (1u << u) - 1u;
        else {
            const LAS float* km = kml + 8 * hi;
            float g[15];
#pragma unroll
            for (int n = 0; n < 15; ++n) {
                if (n < u) { float s = 0.f;
#pragma unroll
                    for (int d0 = 0; d0 < 4; ++d0) { const f32x4 a = *(const LAS f32x4*)(km + n * 64 + 16 * d0), c = *(const LAS f32x4*)(km + n * 64 + 16 * d0 + 4);
                        s += __uint_as_float((unsigned)(unsigned short)qr[d0][0] << 16) * a.x; s += __uint_as_float((unsigned)(unsigned short)qr[d0][1] << 16) * a.y;
                        s += __uint_as_float((unsigned)(unsigned short)qr[d0][2] << 16) * a.z; s += __uint_as_float((unsigned)(unsigned short)qr[d0][3] << 16) * a.w;
                        s += __uint_as_float((unsigned)(unsigned short)qr[d0][4] << 16) * c.x; s += __uint_as_float((unsigned)(unsigned short)qr[d0][5] << 16) * c.y;
                        s += __uint_as_float((unsigned)(unsigned short)qr[d0][6] << 16) * c.z; s += __uint_as_float((unsigned)(unsigned short)qr[d0][7] << 16) * c.w; }
                    g[n] = s + att::swap32(s, hi);
                } else g[n] = -INFINITY;
            }
#pragma unroll
            for (int r = 0; r < 3; ++r) { float best = -INFINITY; int bi = 0;
#pragma unroll
                for (int n = 0; n < 15; ++n) if (!((selmask >> n) & 1u) && g[n] > best) { best = g[n]; bi = n; }
                selmask |= 1u << bi; }
        }
        const int NT = 4 * u + 4;
        float mref = 0.f, l = 0.f; att::f32x16 o[2];
#pragma unroll
        for (int r = 0; r < 16; ++r) { o[0][r] = 0.f; o[1][r] = 0.f; }
        att::f32x16 a0, a1, b0, b1;
        att::bf16x8 kfn[8];
        MOBA_WAITBAR(4);
        {
            const LAS float* bp = att::bias_ptr(bt, qrow, hi, 4 * u); asm volatile("" : "+v"(bp));
#pragma unroll
            for (int g = 0; g < 4; ++g) { const f32x4 x0 = *(const LAS f32x4*)(bp + 8 * g), x1 = *(const LAS f32x4*)(bp + 32 + 8 * g);
                a0[4 * g] = x0.x; a0[4 * g + 1] = x0.y; a0[4 * g + 2] = x0.z; a0[4 * g + 3] = x0.w; a1[4 * g] = x1.x; a1[4 * g + 1] = x1.y; a1[4 * g + 2] = x1.z; a1[4 * g + 3] = x1.w; }
            att::bf16x8 kf[8];
#pragma unroll
            for (int d0 = 0; d0 < 4; ++d0) { const LAS unsigned char* kb = lds + att::kfrag_off(d0, r32, hi); kf[2 * d0] = *(const LAS att::bf16x8*)(kb); kf[2 * d0 + 1] = *(const LAS att::bf16x8*)(kb + 4096); }
#pragma unroll
            for (int d0 = 0; d0 < 4; ++d0) { a0 = MMF(kf[2 * d0], qr[d0], a0); a1 = MMF(kf[2 * d0 + 1], qr[d0], a1); }
            float mx = fmaxf(a0[0], a1[0]);
#pragma unroll
            for (int r = 1; r < 16; ++r) mx = fmaxf(mx, fmaxf(a0[r], a1[r]));
            mx = fmaxf(mx, att::swap32(mx, hi));
            mref = __uint_as_float((__float_as_uint(mx) + 0x8000u) & 0xffff0000u);
#pragma unroll
            for (int r = 0; r < 16; ++r) { a0[r] -= mref; a1[r] -= mref; }
            MSB();
            const LAS float* bq = att::bias_ptr(bt, qrow, hi, 4 * u + 1); asm volatile("" : "+v"(bq));
#pragma unroll
            for (int g = 0; g < 4; ++g) { const f32x4 x0 = *(const LAS f32x4*)(bq + 8 * g), x1 = *(const LAS f32x4*)(bq + 32 + 8 * g);
                b0[4 * g] = x0.x; b0[4 * g + 1] = x0.y; b0[4 * g + 2] = x0.z; b0[4 * g + 3] = x0.w; b1[4 * g] = x1.x; b1[4 * g + 1] = x1.y; b1[4 * g + 2] = x1.z; b1[4 * g + 3] = x1.w; }
#pragma unroll
            for (int d0 = 0; d0 < 4; ++d0) { const LAS unsigned char* kb = lds + 16384 + att::kfrag_off(d0, r32, hi); kfn[2 * d0] = *(const LAS att::bf16x8*)(kb); kfn[2 * d0 + 1] = *(const LAS att::bf16x8*)(kb + 4096); }
        }
        for (int s = 0; s < NT; s += 2) {
            if (s + 3 < NT) MOBA_WAITBAR(2); else MOBA_WAITBAR(0);
            if (s + 4 < NT) MOBA_DMA(s + 4);
            moba_step<VAR>(a0, a1, b0, b1, s, NT, u, wid, lane, qrow, selmask, mref, l, o, lds, bt, qr, kfn);
            if (s + 4 < NT) MOBA_WAITBAR(2); else MOBA_WAITBAR(0);
            if (s + 5 < NT) MOBA_DMA(s + 5);
            moba_step<VAR>(b0, b1, a0, a1, s + 1, NT, u, wid, lane, qrow, selmask, mref, l, o, lds, bt, qr, kfn);
        }
        l += att::swap32(l, hi);
        att::store_o8((unsigned char*)O + (size_t)tok * D + h * HD, o, OSCALE8 / l, hi);
        MOBA_WAITBAR(0);
    }
#undef MOBA_TILE
#undef MOBA_DMA
}

template <int SVAR>
__device__ __forceinline__ void sb_phase(const Ctx& C0, const bf16* Q, const bf16* Kb, const bf16* Vb, bf16* O) {
    const Ctx C = phase_ctx(C0);
    const int lane = C.lane, r32 = lane & 31, hi = lane >> 5, wid = C.wave;
    LAS unsigned char* wbuf = C.lds + wid * 16384;
    const int gw = C.vcu * NWAVES + wid;
    const int vr = (lane & 15) >> 2, vf_ = (vr >> 1) & 1;
    const int voff0 = (4 * hi + vr) * 128 + vf_ * 64 + ((lane >> 4) & 1) * 32 + (lane & 3) * 8, voff1 = (4 * hi + vr) * 128 + (vf_ ^ 1) * 64 + ((lane >> 4) & 1) * 32 + (lane & 3) * 8;
    for (int iu = 0; iu < 8; ++iu) {
        const int U = (C.vcu * 8 + iu) * NWAVES + wid, bh = U >> 7, qt = U & 127, b = bh >> 4, h = bh & 15;
        const int t = 32 * qt + r32, tok = b * SEQ + t;
        const bf16* Kh = Kb + (size_t)b * SEQ * D + h * HD; const bf16* Vh = Vb + (size_t)b * SEQ * D + h * HD;
#define SB_DMA(tk_, p_) do { _Pragma("unroll") for (int pc = 0; pc < 4; ++pc) att::dma_k_piece(Kh, 32 * (tk_), pc, wbuf + (p_) * 8192, lane); \
                             _Pragma("unroll") for (int pc = 0; pc < 4; ++pc) att::dma_v_piece(Vh, 32 * (tk_), pc, wbuf + (p_) * 8192 + 4096, lane); } while (0)
        asm volatile("s_waitcnt lgkmcnt(0)" ::: "memory");
        SB_DMA(qt, 0);
        att::bf16x8 qr[4];
#pragma unroll
        for (int d0 = 0; d0 < 4; ++d0) qr[d0] = *(const GAS att::bf16x8*)(Q + (size_t)tok * D + h * HD + d0 * 16 + hi * 8);
        float L = 1.f; att::f32x16 o[2];
#pragma unroll
        for (int r = 0; r < 16; ++r) { o[0][r] = 0.f; o[1][r] = 0.f; }
        int p = 0;
        for (int tk = qt; tk >= 0; --tk) {
            if (tk > 0) { asm volatile("s_waitcnt lgkmcnt(0)" ::: "memory"); SB_DMA(tk - 1, p ^ 1); asm volatile("s_waitcnt vmcnt(8)" ::: "memory"); }
            else asm volatile("s_waitcnt vmcnt(0)" ::: "memory");
            const LAS unsigned char* kslot = wbuf + p * 8192; const LAS unsigned char* vslot = kslot + 4096;
            att::bf16x8 kf[4];
#pragma unroll
            for (int d0 = 0; d0 < 4; ++d0) kf[d0] = *(const LAS att::bf16x8*)(kslot + att::kfrag_off(d0, r32, hi));
            att::f32x16 z;
#pragma unroll
            for (int r = 0; r < 16; ++r) z[r] = 0.f;
#pragma unroll
            for (int d0 = 0; d0 < 4; ++d0) z = __builtin_amdgcn_mfma_f32_32x32x16_bf16(kf[d0], qr[d0], z, 0, 0, 0);
            att::f32x16 s;
#pragma unroll
            for (int r = 0; r < 16; ++r) { const float e = ex2(z[r]); s[r] = __builtin_amdgcn_rcpf(1.0f + e); z[r] = 1.0f - s[r]; }
            if (tk == qt) { const int lim = r32 - 4 * hi;
#pragma unroll
                for (int r = 0; r < 16; ++r) { const int ko = (r & 3) + 8 * (r >> 2); if (!(ko < lim)) { s[r] = 1.f; z[r] = 0.f; } } }
            __builtin_amdgcn_sched_barrier(0);
            float Gs[4], E[4], T[4], EG[4];
#pragma unroll
            for (int gq = 0; gq < 4; ++gq) Gs[gq] = vmul(vmul(s[4 * gq], s[4 * gq + 1]), vmul(s[4 * gq + 2], s[4 * gq + 3]));
            E[3] = 1.f; E[2] = Gs[3]; E[1] = vmul(E[2], Gs[2]); E[0] = vmul(E[1], Gs[1]);
            EG[3] = Gs[3]; EG[2] = E[1]; EG[1] = E[0]; EG[0] = vmul(E[0], Gs[0]);
#pragma unroll
            for (int gq = 0; gq < 3; ++gq) T[gq] = vmul(E[gq], att::swap32(hi ? EG[gq] : E[gq], hi));
            T[3] = att::swap32(hi ? EG[3] : 1.f, hi);
            const float own = EG[0], tot = vmul(own, att::swap32(own, hi));
#pragma unroll
            for (int gq = 0; gq < 4; ++gq) { const float b3 = vmul(L, T[gq]), b2 = vmul(b3, s[4 * gq + 3]), b1 = vmul(b2, s[4 * gq + 2]), b0 = vmul(b1, s[4 * gq + 1]);
                z[4 * gq + 3] = vmul(z[4 * gq + 3], b3); z[4 * gq + 2] = vmul(z[4 * gq + 2], b2); z[4 * gq + 1] = vmul(z[4 * gq + 1], b1); z[4 * gq] = vmul(z[4 * gq], b0); }
            L = vmul(L, tot);
            v4u pw0, pw1;
#pragma unroll
            for (int i = 0; i < 4; ++i) { pw0[i] = att::cvtpk(z[2 * i], z[2 * i + 1]); pw1[i] = att::cvtpk(z[8 + 2 * i], z[9 + 2 * i]); }
            { const att::v4i16_t l00 = att::vtr(vslot + voff0), h00 = att::vtr(vslot + voff0 + 1024), l01 = att::vtr(vslot + voff0 + 2048), h01 = att::vtr(vslot + voff0 + 3072);
              const att::v4i16_t l10 = att::vtr(vslot + voff1), h10 = att::vtr(vslot + voff1 + 1024), l11 = att::vtr(vslot + voff1 + 2048), h11 = att::vtr(vslot + voff1 + 3072);
#define SB_VF(lo_, hh_) (att::bf16x8){lo_[0], lo_[1], lo_[2], lo_[3], hh_[0], hh_[1], hh_[2], hh_[3]}
              o[0] = __builtin_amdgcn_mfma_f32_32x32x16_bf16(SB_VF(l00, h00), __builtin_bit_cast(att::bf16x8, pw0), o[0], 0, 0, 0);
              o[0] = __builtin_amdgcn_mfma_f32_32x32x16_bf16(SB_VF(l01, h01), __builtin_bit_cast(att::bf16x8, pw1), o[0], 0, 0, 0);
              o[1] = __builtin_amdgcn_mfma_f32_32x32x16_bf16(SB_VF(l10, h10), __builtin_bit_cast(att::bf16x8, pw0), o[1], 0, 0, 0);
              o[1] = __builtin_amdgcn_mfma_f32_32x32x16_bf16(SB_VF(l11, h11), __builtin_bit_cast(att::bf16x8, pw1), o[1], 0, 0, 0);
#undef SB_VF
            }
            if (!__any(L >= 7.5e-37f)) break;
            p ^= 1;
        }
        att::store_o8((unsigned char*)O + (size_t)tok * D + h * HD, o, OSCALE8, hi);
#undef SB_DMA
    }
}

__device__ __forceinline__ float dot64(const v4u (&q)[8], const GAS v4u* kr) { float s = 0.f;
#pragma unroll
    for (int i = 0; i < 8; ++i) { const v4u k = kr[i];
        s += bflo(q[i].x) * bflo(k.x); s += bfhi(q[i].x) * bfhi(k.x); s += bflo(q[i].y) * bflo(k.y); s += bfhi(q[i].y) * bfhi(k.y);
        s += bflo(q[i].z) * bflo(k.z); s += bfhi(q[i].z) * bfhi(k.z); s += bflo(q[i].w) * bflo(k.w); s += bfhi(q[i].w) * bfhi(k.w); }
    return s; }
__device__ __forceinline__ void moba_naive(const Ctx& C0, const bf16* Q, const bf16* Kb, const bf16* Vb, bf16* O) {
    const Ctx C = phase_ctx(C0);
    LAS float* sc = (LAS float*)(C.lds + C.wave * 4096);
    const float* kmean = (const float*)(wsp(C) + WS_KMEAN); const float* btab = (const float*)(wsp(C) + WS_BIAS);
    const int gw = C.vcu * NWAVES + C.wave, lane = C.lane;
    for (int ip = 0; ip < 256; ++ip) {
        const int p = gw * 256 + ip, tok = p >> 4, h = p & 15, b = tok >> 12, qpos = tok & 4095, u = qpos >> 8;
        const bf16* qp = Q + (size_t)tok * D + h * HD;
        v4u qv[8];
#pragma unroll
        for (int i = 0; i < 8; ++i) qv[i] = ((const GAS v4u*)qp)[i];
        const float qd = __uint_as_float((unsigned)qp[lane] << 16);
        const float* km = kmean + (size_t)((b * NH + h) * 16) * 64 + lane;
        float g[15];
#pragma unroll
        for (int n = 0; n < 15; ++n) g[n] = (n < u) ? wave_sum(qd * km[n * 64]) : -INFINITY;
        unsigned mask = 0;
        if (u <= 3) mask = (1u << u) - 1u;
        else {
#pragma unroll
            for (int r = 0; r < 3; ++r) { float best = -INFINITY; int bi = 0;
#pragma unroll
                for (int n = 0; n < 15; ++n) if (!((mask >> n) & 1u) && g[n] > best) { best = g[n]; bi = n; }
                mask |= 1u << bi; }
        }
        mask |= 1u << u;
        const float* bt = btab + h * 1024;
        float mx = -INFINITY; int ns = 0;
        for (int n = 0; n <= u; ++n) { if (!((mask >> n) & 1u)) continue;
            for (int c4 = 0; c4 < 4; ++c4) { const int kpos = 256 * n + 64 * c4 + lane; const int dist = qpos - kpos;
                float s = dot64(qv, (const GAS v4u*)(Kb + (size_t)(b * SEQ + kpos) * D + h * HD));
                s += bt[dist < 0 ? 0 : (dist > 1023 ? 1023 : dist)];
                if (dist < 0) s = -INFINITY;
                sc[ns * 256 + 64 * c4 + lane] = s; mx = fmaxf(mx, s); }
            ++ns; }
        mx = wave_max(mx);
        LDS_WAIT(); asm volatile("" ::: "memory");
        float l = 0.f;
        for (int i = 0; i < ns * 4; ++i) { const float pz = ex2(sc[64 * i + lane] - mx); sc[64 * i + lane] = pz; l += pz; }
        l = wave_sum(l);
        LDS_WAIT(); asm volatile("" ::: "memory");
        float o = 0.f; int n2 = 0;
        for (int n = 0; n <= u; ++n) { if (!((mask >> n) & 1u)) continue;
            const bf16* vp = Vb + (size_t)(b * SEQ + 256 * n) * D + h * HD + lane;
#pragma unroll 8
            for (int i = 0; i < 256; ++i) o += sc[n2 * 256 + i] * __uint_as_float((unsigned)vp[(size_t)i * D] << 16);
            ++n2; }
        LDS_WAIT(); asm volatile("" ::: "memory");
        O[(size_t)tok * D + h * HD + lane] = (bf16)f2bf(o / l);
    }
}
__device__ __forceinline__ void sb_naive(const Ctx& C0, const bf16* Q, const bf16* Kb, const bf16* Vb, bf16* O) {
    const Ctx C = phase_ctx(C0);
    LAS float* sc = (LAS float*)(C.lds + C.wave * 4096);
    const int gw = C.vcu * NWAVES + C.wave, lane = C.lane;
    for (int ip = 0; ip < 256; ++ip) {
        const int p = gw * 256 + ip, tok = p >> 4, h = p & 15, b = tok >> 12, t = tok & 4095;
        const bf16* qp = Q + (size_t)tok * D + h * HD;
        v4u qv[8];
#pragma unroll
        for (int i = 0; i < 8; ++i) qv[i] = ((const GAS v4u*)qp)[i];
        float L = 0.f, o = 0.f;
        for (int c = (t - 1) >> 6; c >= 0; --c) {
            const int j = 64 * c + lane; const bool valid = j < t;
            const float z = dot64(qv, (const GAS v4u*)(Kb + (size_t)(b * SEQ + j) * D + h * HD));
            const float sp = valid ? (fmaxf(z, 0.f) + lg2(1.0f + ex2(-fabsf(z)))) : 0.f;
            float incl = sp;
#pragma unroll
            for (int off = 1; off < 64; off <<= 1) { const float tmp = __shfl_down(incl, off); if (lane + off < 64) incl += tmp; }
            const float excl = incl - sp;
            const float a = valid ? ex2(z - sp + L - excl) : 0.f;
            L -= __shfl(incl, 0);
            sc[lane] = a;
            LDS_WAIT(); asm volatile("" ::: "memory");
            const bf16* vp = Vb + (size_t)(b * SEQ + 64 * c) * D + h * HD + lane;
#pragma unroll 8
            for (int i = 0; i < 64; ++i) o += sc[i] * __uint_as_float((unsigned)vp[(size_t)i * D] << 16);
            LDS_WAIT(); asm volatile("" ::: "memory");
            if (L < -120.0f) break;
        }
        O[(size_t)tok * D + h * HD + lane] = (bf16)f2bf(o);
    }
}

#ifndef DUP_GEMM
#define DUP_GEMM 0
#endif
#ifndef DUP_ATT
#define DUP_ATT 0
#endif
#ifndef DUP_TOK
#define DUP_TOK 0
#endif
#ifndef DUP_MISC
#define DUP_MISC 0
#endif
#ifndef DUP_PRO
#define DUP_PRO 0
#endif
#ifndef SB_VAR
#define SB_VAR 0
#endif
#ifndef MOBA_VAR
#define MOBA_VAR 0
#endif
#ifndef NAIVE_MOBA
#define NAIVE_MOBA 0
#endif
#ifndef NAIVE_SB
#define NAIVE_SB 0
#endif
#ifndef DUP_BAR
#define DUP_BAR 0
#endif
#define GRID_BAR() do { xcd_barrier(bar); if (DUP_BAR) xcd_barrier(bar); } while (0)
#define LOCAL_BAR() do { if (reg32) xcd_barrier_local(bar); else xcd_barrier(bar); } while (0)
#define WSB(off) ((bf16*)(ws + (off)))
template <int l>
__device__ __forceinline__ void layer_body(const Ctx& C, const XcdBarrier& bar, LAS unsigned char* ring, const LAS int* rt, const int G, const int bx, const bool reg32) {
        if (l == 2) { void* xo = wsp(C) + WS_XBF; token_phase<true, true, false, false, true>(C, xo, xo, inp(C, IN_NMIX) + l * D, l * MODW + 0 * D, l * MODW + 1 * D, (bf16*)(wsp(C) + WS_XN), (l - 1) * MODW + 5 * D, nullptr); }
        else if (l == 0) token_phase<false, false, false, false, true, true>(C, inp(C, IN_X), nullptr, inp(C, IN_NMIX) + l * D, l * MODW + 0 * D, l * MODW + 1 * D, (bf16*)(wsp(C) + WS_XN), 0, nullptr);
        else token_phase<false, false, false, false, true>(C, wsp(C) + WS_XBF, nullptr, inp(C, IN_NMIX) + l * D, l * MODW + 0 * D, l * MODW + 1 * D, (bf16*)(wsp(C) + WS_XN), 0, nullptr);
        if (l == 2) GRID_BAR(); else LOCAL_BAR();
        if (l < 2) {
            { unsigned char* ws = wsp(C); pg8::Gemm g{WSB(WS_XN), (const bf16*)(ws + WS_WQKV + (size_t)l * 3 * D * D), NTOK, 3 * D, D / 2}; pg8::ScaleStage<pg8::StaticOrder> S; S.init(NTOK, 3 * D, G, bx); S.sA = (const float*)(ws + WS_SA); S.sB = (const float*)(ws + WS_SBQKV) + (size_t)l * 3 * D; S.buf = ring + SCALEBUF_OFF; S.cnt = 0;
              pg8::EpiBf16I8 E{WSB(WS_Q), D, D, (size_t)(WS_K - WS_Q) / 2, QSCALE, ring + SCALEBUF_OFF, 0};
              pg8::gemm_phase<pg8::EpiBf16I8, pg8::ScaleStage<pg8::StaticOrder>, true, true, 2>(ring, g, S, E); }
            LOCAL_BAR();
            { unsigned char* ws = wsp(C); if (NAIVE_MOBA) moba_naive(C, WSB(WS_Q), WSB(WS_K), WSB(WS_V), WSB(WS_Q)); else { if (DUP_ATT & 1) moba_phase<MOBA_VAR>(C, WSB(WS_Q), WSB(WS_K), WSB(WS_V), WSB(WS_HID)); moba_phase<0>(C, WSB(WS_Q), WSB(WS_K), WSB(WS_V), WSB(WS_HID)); } }
        } else {
            if (l == 2) { unsigned char* ws = wsp(C); pg8::Gemm g{WSB(WS_XN2), (const bf16*)(ws + WS_WKV), NTOK, 2 * D, D / 2}; pg8::ScaleStage<pg8::StaticOrder> S; S.init(NTOK, 2 * D, G, bx); S.sA = (const float*)(ws + WS_SA2); S.sB = (const float*)(ws + WS_SBKV); S.buf = ring + SCALEBUF_OFF; S.cnt = 0;
              pg8::EpiBf16I8 E{WSB(WS_KSH), D, D, (size_t)(WS_VSH - WS_KSH) / 2, 1.0f, ring + SCALEBUF_OFF, 0};
              pg8::gemm_phase<pg8::EpiBf16I8, pg8::ScaleStage<pg8::StaticOrder>, true, true, 2>(ring, g, S, E); }
            { unsigned char* ws = wsp(C); pg8::Gemm g{WSB(WS_XN), (const bf16*)(ws + WS_WQ + (size_t)(l - 2) * D * D), NTOK, D, D / 2}; pg8::ScaleStage<pg8::StaticOrder> S; S.init(NTOK, D, G, bx); S.sA = (const float*)(ws + WS_SA); S.sB = (const float*)(ws + WS_SBQ) + (size_t)(l - 2) * D; S.buf = ring + SCALEBUF_OFF; S.cnt = 0;
              pg8::EpiBf16I8 E{WSB(WS_Q), D, D, 0, QSCALE, ring + SCALEBUF_OFF, 0};
              pg8::gemm_phase<pg8::EpiBf16I8, pg8::ScaleStage<pg8::StaticOrder>, true, true, 2>(ring, g, S, E); }
            LOCAL_BAR();
            { unsigned char* ws = wsp(C); if (NAIVE_SB) sb_naive(C, WSB(WS_Q), WSB(WS_KSH), WSB(WS_VSH), WSB(WS_Q)); else { if (DUP_ATT & 2) sb_phase<SB_VAR>(C, WSB(WS_Q), WSB(WS_KSH), WSB(WS_VSH), WSB(WS_HID)); sb_phase<0>(C, WSB(WS_Q), WSB(WS_KSH), WSB(WS_VSH), WSB(WS_HID)); } }
        }
        LOCAL_BAR();
        { unsigned char* ws = wsp(C);
          const bf16* wo = (const bf16*)((l < 2) ? ws + WS_WO + (size_t)l * D * D : ws + WS_WBO + (size_t)(l - 2) * D * D);
          pg8::Gemm g{WSB(WS_HID), wo, NTOK, D, D / 2}; pg8::StaticOrder S; S.init(NTOK, D, G, bx);
          if (l == 0) { pg8::EpiResidB<true> E{inp(C, IN_X), WSB(WS_XBF), (const float*)(ws + WS_MOD) + l * MODW + 2 * D, MODLD, 1.0f / (OSCALE8 * WSCALE8)};
              pg8::gemm_phase<pg8::EpiResidB<true>, pg8::StaticOrder, true, true, 1>(ring, g, S, E); }
          else { pg8::EpiResidB<false> E{WSB(WS_XBF), WSB(WS_XBF), (const float*)(ws + WS_MOD) + l * MODW + 2 * D, MODLD, 1.0f / (OSCALE8 * WSCALE8)};
              pg8::gemm_phase<pg8::EpiResidB<false>, pg8::StaticOrder, true, true, 1>(ring, g, S, E); } }
        LOCAL_BAR();
        if (l & 1) token_phase<false, false, true, false, true>(C, wsp(C) + WS_XBF, nullptr, inp(C, IN_NFFN) + l * D, l * MODW + 3 * D, l * MODW + 4 * D, (bf16*)(wsp(C) + WS_XN), 0, inp(C, IN_RW) + (size_t)(l >> 1) * D * NE);
        else token_phase<false, false, false, false, true>(C, wsp(C) + WS_XBF, nullptr, inp(C, IN_NFFN) + l * D, l * MODW + 3 * D, l * MODW + 4 * D, (bf16*)(wsp(C) + WS_XN), 0, nullptr);
        if (l & 1) GRID_BAR(); else LOCAL_BAR();
        if (!(l & 1)) {
            { unsigned char* ws = wsp(C); pg8::Gemm g{WSB(WS_XN), (const bf16*)(ws + WS_W13 + (size_t)(l >> 1) * 2 * FF * D), NTOK, 2 * FF, D / 2}; pg8::ScaleStage<pg8::StaticOrder> S; S.init(NTOK, 2 * FF, G, bx); S.sA = (const float*)(ws + WS_SA); S.sB = (const float*)(ws + WS_SB13) + (size_t)(l >> 1) * 2 * FF; S.buf = ring + SCALEBUF_OFF; S.cnt = 0;
              pg8::EpiSwiGluI8 E{ws + WS_HID, FF, 2 * FF / 256, ring + SCALEBUF_OFF, HSCALE8, 0};
              pg8::gemm_phase<pg8::EpiSwiGluI8, pg8::ScaleStage<pg8::StaticOrder>, true, true, 2>(ring, g, S, E); }
            LOCAL_BAR();
            { unsigned char* ws = wsp(C); pg8::Gemm g{WSB(WS_HID), (const bf16*)(ws + WS_W2 + (size_t)(l >> 1) * D * FF), NTOK, D, FF / 2}; pg8::StaticOrder S; S.init(NTOK, D, G, bx);
              pg8::EpiResidB<false> E{WSB(WS_XBF), WSB(WS_XBF), (const float*)(ws + WS_MOD) + l * MODW + 5 * D, MODLD, 1.0f / (HSCALE8 * WSCALE8)};
              pg8::gemm_phase<pg8::EpiResidB<false>, pg8::StaticOrder, true, true, 1>(ring, g, S, E); }
            LOCAL_BAR();
        } else {
            for (int dup = 0; dup <= DUP_MISC; ++dup) { if (dup) __syncthreads(); route_phase(C, (const bf16*)(wsp(C) + WS_XN)); }
            GRID_BAR();
            const int ntiles = __builtin_amdgcn_readfirstlane(rt[RT_NT]);
            { unsigned char* ws = wsp(C); pg8::Gemm g{WSB(WS_XG), (const bf16*)(ws + WS_MW13 + (size_t)(l >> 1) * NE * 2 * FFE * D), MAXTILES * 256, 2 * FFE, D / 2}; pg8::ScaleStage<pg8::MoeOrder> S; S.init(ntiles, 2 * FFE / 256, G, bx, rt + RT_TEXP); S.sA = (const float*)(ws + WS_SAG); S.sB = (const float*)(ws + WS_SBM13) + (size_t)(l >> 1) * NE * 2 * FFE; S.buf = ring + SCALEBUF_OFF; S.cnt = 0;
              pg8::EpiSwiGluI8 E{ws + WS_HID, FFE, 2 * FFE / 256, ring + SCALEBUF_OFF, HSCALE8, 0};
              pg8::gemm_phase<pg8::EpiSwiGluI8, pg8::ScaleStage<pg8::MoeOrder>, true, true, 2>(ring, g, S, E); }
            GRID_BAR();
            { unsigned char* ws = wsp(C); pg8::Gemm g{WSB(WS_HID), (const bf16*)(ws + WS_MW2 + (size_t)(l >> 1) * NE * D * FFE), MAXTILES * 256, D, FFE / 2, 0}; pg8::MoeOrder S; S.init(ntiles < 256 ? ntiles : 256, D / 256, G, bx, rt + RT_TEXP);
              pg8::EpiBf16 E{WSB(WS_XG), D, 0, 0, 1.0f, D / 256, 1.0f / (HSCALE8 * WSCALE8)};
              pg8::gemm_phase<pg8::EpiBf16, pg8::MoeOrder, true, true, 1>(ring, g, S, E); }
            if (ntiles > 256) { unsigned char* ws = wsp(C); pg8::Gemm g{WSB(WS_HID), (const bf16*)(ws + WS_MW2 + (size_t)(l >> 1) * NE * D * FFE), MAXTILES * 256, D, FFE / 2 / TAIL_NS, FFE / 2}; pg8::TailOrder S; S.init(ntiles - 256, D / 256, TAIL_NS, G, bx, rt + RT_TEXP);
              pg8::EpiPlaneF32 E{(float*)(ws + WS_YT), D / 256, 1.0f / (HSCALE8 * WSCALE8), (size_t)TAIL_ROWS * D};
              pg8::gemm_phase<pg8::EpiPlaneF32, pg8::TailOrder, true, true, 1>(ring, g, S, E); }
            GRID_BAR();
        }
    }

struct Args { const float* in[21]; float* out; unsigned char* ws; };
__global__ void __launch_bounds__(NWAVES * 64, 2) yoco_fwd(Args args) {
    extern __shared__ __attribute__((aligned(16))) unsigned char lds[];
    Ctx C;
    C.lds = (LAS unsigned char*)lds; C.tid = threadIdx.x; C.lane = C.tid & 63; C.wave = __builtin_amdgcn_readfirstlane(C.tid >> 6);
    C.G = gridDim.x; { const int bx = blockIdx.x; C.vcu = (C.G % 8 == 0) ? (bx % 8) * (C.G / 8) + bx / 8 : bx; }
    for (int u = C.tid; u < (LDS_BYTES - LDSCTL_OFF) / 4; u += NWAVES * 64) ((LAS unsigned*)(C.lds + LDSCTL_OFF))[u] = 0u;
    __syncthreads();
    if (C.tid < IN_COUNT) ((LAS unsigned long long*)(C.lds + PTR_OFF))[C.tid] = ((const unsigned long long*)__builtin_amdgcn_kernarg_segment_ptr())[C.tid];
    __syncthreads();
    XcdBarrier bar = xcd_barrier_post((unsigned*)((gu32*)(wsp(C) + WS_CTL) + CW_BAR), (volatile LAS unsigned*)(C.lds + MISC_OFF) + 8);
    LAS unsigned char* ring = C.lds + RING_OFF;
    const LAS int* rt = (const LAS int*)(C.lds + ROUTE_OFF);
    const int G = C.G, bx = (int)blockIdx.x;

    for (int dup = 0; dup <= DUP_PRO; ++dup) { if (dup) __syncthreads(); p0_prologue(C); } GRID_BAR();

    const bool reg32 = __builtin_amdgcn_readfirstlane((int)bar.st[2]) == 2;
    int bxv = bx;
    if (reg32) { const int rank = __builtin_amdgcn_readfirstlane((int)bar.st[3]) - 1, xcc = (int)bar.x; C.vcu = xcc * 32 + rank; bxv = rank * 8 + xcc; }

    layer_body<0>(C, bar, ring, rt, G, bxv, reg32);
    layer_body<1>(C, bar, ring, rt, G, bxv, reg32);
    layer_body<2>(C, bar, ring, rt, G, bxv, reg32);
    layer_body<3>(C, bar, ring, rt, G, bxv, reg32);
    token_phase<true, false, false, true>(C, wsp(C) + WS_XBF, outp(C), inp(C, IN_FNG), 0, 0, nullptr, 3 * MODW + 5 * D, nullptr);
}

extern "C" void kernel_launch(void* const* d_in, const int* in_sizes, int n_in, void* d_out, int out_size, void* d_ws, size_t ws_size, hipStream_t stream) {
    static int grid = 0;
    if (grid == 0) {
        if (n_in != 21 || in_sizes[0] != NTOK * D || out_size != NTOK * D || ws_size < WS_END) { fprintf(stderr, "kernel_launch: unexpected shapes (n_in %d, in0 %d, out %d, ws %zu); nothing launched\n", n_in, n_in > 0 ? in_sizes[0] : -1, out_size, ws_size); grid = -1; return; }
        int dev = 0, cus = 0, per_cu = 0;
        if (hipGetDevice(&dev) != hipSuccess || hipDeviceGetAttribute(&cus, hipDeviceAttributeMultiprocessorCount, dev) != hipSuccess) { fprintf(stderr, "kernel_launch: device query failed\n"); grid = -1; return; }
        if (hipFuncSetAttribute((const void*)yoco_fwd, hipFuncAttributeMaxDynamicSharedMemorySize, LDS_BYTES) != hipSuccess) { fprintf(stderr, "kernel_launch: hipFuncSetAttribute failed\n"); grid = -1; return; }
        if (hipOccupancyMaxActiveBlocksPerMultiprocessor(&per_cu, (const void*)yoco_fwd, NWAVES * 64, LDS_BYTES) != hipSuccess || per_cu < 1)
            fprintf(stderr, "kernel_launch: note: occupancy query reports %d workgroups per CU\n", per_cu);
        (void)hipGetLastError();
        if (cus < 256) { fprintf(stderr, "kernel_launch: this kernel needs 256 CUs (found %d); nothing launched\n", cus); grid = -1; return; }
        grid = 256;
    }
    if (grid < 0) return;
    if (hipMemsetAsync((char*)d_ws + WS_CTL, 0, CTL_ZERO_BYTES, stream) != hipSuccess) { fprintf(stderr, "kernel_launch: hipMemsetAsync failed\n"); return; }
    Args a{};
    for (int i = 0; i < 21; ++i) a.in[i] = (const float*)d_in[i];
    a.out = (float*)d_out; a.ws = (unsigned char*)d_ws;
    hipLaunchKernelGGL(yoco_fwd, dim3(grid), dim3(NWAVES * 64), LDS_BYTES, stream, a);
    const hipError_t le = hipPeekAtLastError();
    if (le != hipSuccess) fprintf(stderr, "kernel_launch: launch failed: %s\n", hipGetErrorName(le));
}
```

```cpp
#include <hip/hip_runtime.h>
#include <cstdio>
#include <cstdint>
namespace pg8 {
#define PG8_LAS __attribute__((address_space(3)))
#define PG8_GAS __attribute__((address_space(1)))
typedef unsigned short bf16_t;
typedef short bf16x8 __attribute__((ext_vector_type(8)));
typedef float f32x4 __attribute__((ext_vector_type(4)));
typedef unsigned u32x4 __attribute__((ext_vector_type(4)));
constexpr int BM = 256, BK = 64, HALF = 128, HTB = HALF * BK * 2  , STAGE_BYTES = 8 * HTB, NXCD = 8, WGM = 8;

__host__ __device__ __forceinline__ int lds_byte(int r, int c) { const int st = (r >> 4) * 2 + (c >> 5), rr = r & 15, cc = c & 31, ob = rr * 64 + cc * 2; return st * 1024 + (ob ^ (((ob >> 9) & 1) << 5)); }
__host__ __device__ __forceinline__ void stage_rc(int b, int& R, int& C) { const int st = b / 1024, sb = b % 1024, swz = sb ^ (((sb >> 9) & 1) << 5); R = (st >> 1) * 16 + swz / 64; C = (st & 1) * 32 + (swz % 64) / 2; }
__host__ __device__ __forceinline__ int perm32(int rho) { const int n = rho >> 4, i = rho & 15; return 8 * (i >> 2) + 4 * n + (i & 3); }

struct Unit { int pm, pn, ks; };
struct Gemm { const bf16_t* A; const bf16_t* Bt; int M, N, K, ld; };

struct StaticOrder {
    static constexpr bool SPLITK = false;
    int nM, nN, nwg, G, c;
    __host__ __device__ void init(int M, int N, int G_, int c_) { nM = M / BM; nN = N / BM; nwg = nM * nN; G = G_; c = c_; }
    __host__ __device__ bool next(int i, Unit& u) const {
        const long L = (long)i * G + c; if (L >= nwg) return false;
        int wgid = (int)L; { const int q = nwg / NXCD, r = nwg % NXCD, xcd = wgid % NXCD, off = wgid / NXCD; wgid = (xcd < r ? xcd * (q + 1) : r * (q + 1) + (xcd - r) * q) + off; }
        const int nig = WGM * nN, gid = wgid / nig, fm = gid * WGM, gsz = (nM - fm) < WGM ? (nM - fm) : WGM;
        u.pm = fm + ((wgid % nig) % gsz); u.pn = (wgid % nig) / gsz; return true;
    }
    __device__ __forceinline__ void a_ready(const Unit&) const {}
    __device__ __forceinline__ void done(const Unit&) const {}
};
struct MoeOrder {
    static constexpr bool SPLITK = false;
    int nM, nN, nwg, G, c; const PG8_LAS int* texp;
    __device__ void init(int ntiles, int nN_, int G_, int c_, const PG8_LAS int* t) { nM = ntiles; nN = nN_; nwg = nM * nN; G = G_; c = c_; texp = t; }
    __device__ bool next(int i, Unit& u) const {
        const long L = (long)i * G + c; if (L >= nwg) return false;
        int wgid = (int)L; { const int q = nwg / NXCD, r = nwg % NXCD, xcd = wgid % NXCD, off = wgid / NXCD; wgid = (xcd < r ? xcd * (q + 1) : r * (q + 1) + (xcd - r) * q) + off; }
        const int nig = WGM * nN, gid = wgid / nig, fm = gid * WGM, gsz = (nM - fm) < WGM ? (nM - fm) : WGM;
        u.pm = fm + ((wgid % nig) % gsz); const int pnl = (wgid % nig) / gsz;
        const int e = __builtin_amdgcn_readfirstlane(texp[u.pm]); u.pn = e * nN + pnl; return true;
    }
    __device__ __forceinline__ void a_ready(const Unit&) const {}
    __device__ __forceinline__ void done(const Unit&) const {}
};

struct TailOrder {
    static constexpr bool SPLITK = true;
    int nN, nS, nwg, G, c; const PG8_LAS int* texp;
    __device__ void init(int ntail, int nN_, int nS_, int G_, int c_, const PG8_LAS int* t) { nN = nN_; nS = nS_; nwg = ntail * nN_ * nS_; G = G_; c = c_; texp = t; }
    __device__ bool next(int i, Unit& u) const {
        const long L = (long)i * G + c; if (L >= nwg) return false;
        const int id = (int)L, rest = id / nS; u.ks = id - rest * nS; const int tl = rest / nN, pnl = rest - tl * nN; u.pm = 256 + tl;
        const int e = __builtin_amdgcn_readfirstlane(texp[u.pm]); u.pn = e * nN + pnl; return true;
    }
    __device__ __forceinline__ void a_ready(const Unit&) const {}
    __device__ __forceinline__ void done(const Unit&) const {}
};
template <class Base> struct ScaleStage : Base {
    const float* sA; const float* sB; PG8_LAS unsigned char* buf; mutable int cnt;
    __device__ __forceinline__ void a_ready(const Unit& u) const {
        if (threadIdx.x < 64) { PG8_LAS unsigned char* d = buf + (cnt & 1) * 2048;
            __builtin_amdgcn_global_load_lds((const unsigned*)(sA + (size_t)u.pm * BM + threadIdx.x * 4), (PG8_LAS unsigned*)d, 16, 0, 0);
            __builtin_amdgcn_global_load_lds((const unsigned*)(sB + (size_t)u.pn * BM + threadIdx.x * 4), (PG8_LAS unsigned*)(d + 1024), 16, 0, 0); }
        ++cnt; }
};
__device__ __forceinline__ unsigned cvt_pk_bf16(float lo, float hi) { unsigned r; asm volatile("v_cvt_pk_bf16_f32 %0, %1, %2" : "=v"(r) : "v"(lo), "v"(hi)); return r; }

typedef int i32x8 __attribute__((ext_vector_type(8)));
typedef int i32x4 __attribute__((ext_vector_type(4)));
typedef unsigned u32x2 __attribute__((ext_vector_type(2)));
__device__ __forceinline__ i32x8 cat8(bf16x8 a, bf16x8 b) { const i32x4 x = __builtin_bit_cast(i32x4, a), y = __builtin_bit_cast(i32x4, b); return __builtin_shufflevector(x, y, 0, 1, 2, 3, 4, 5, 6, 7); }
__device__ __forceinline__ void mfma8(f32x4& acc, const i32x8 a, const i32x8 b, const int sc) { asm volatile("v_mfma_scale_f32_16x16x128_f8f6f4 %0, %1, %2, %0, %3, %3 op_sel_hi:[0,0,0]" : "+v"(acc) : "v"(a), "v"(b), "v"(sc)); }
__device__ __forceinline__ void mfma8z(f32x4& acc, const i32x8 a, const i32x8 b, const int sc) { asm volatile("v_mfma_scale_f32_16x16x128_f8f6f4 %0, %1, %2, 0, %3, %3 op_sel_hi:[0,0,0]" : "=&v"(acc) : "v"(a), "v"(b), "v"(sc)); }
__device__ __forceinline__ unsigned pk4_fp8(float a, float b, float c, float d) {
    a = __builtin_amdgcn_fmed3f(a, -448.f, 448.f); b = __builtin_amdgcn_fmed3f(b, -448.f, 448.f); c = __builtin_amdgcn_fmed3f(c, -448.f, 448.f); d = __builtin_amdgcn_fmed3f(d, -448.f, 448.f);
    int w = 0; w = __builtin_amdgcn_cvt_pk_fp8_f32(a, b, w, false); w = __builtin_amdgcn_cvt_pk_fp8_f32(c, d, w, true); return (unsigned)w; }
struct EpiBf16 {
    static constexpr bool PERM = true, AFTER_DRAIN = false;
    bf16_t* O; int ldc; int split_cols; size_t split_stride; float scale0; int ntn; float scale_all;
    __device__ __forceinline__ void operator()(const f32x4 (&acc)[2][2][4][2], const Unit& u, int wr, int wc, int fr, int fq) const {
        const int row0 = u.pm * BM + wr * 64 + fr; int colt = (ntn ? (u.pn % ntn) : u.pn) * BM; bf16_t* base = O;
        float sc = scale_all; if (split_cols) { const int t = colt / split_cols; base += (size_t)t * split_stride; colt -= t * split_cols; if (t == 0) sc *= scale0; }
        const int col0 = colt + wc * 32 + 8 * fq;
#pragma unroll
        for (int ai = 0; ai < 2; ++ai)
#pragma unroll
            for (int m = 0; m < 4; ++m) { bf16_t* rowp = base + (size_t)(row0 + ai * HALF + m * 16) * ldc + col0;
#pragma unroll
                for (int bj = 0; bj < 2; ++bj) { f32x4 v0 = acc[ai][bj][m][0] * sc, v1 = acc[ai][bj][m][1] * sc;
                    u32x4 w; w.x = cvt_pk_bf16(v0[0], v0[1]); w.y = cvt_pk_bf16(v0[2], v0[3]); w.z = cvt_pk_bf16(v1[0], v1[1]); w.w = cvt_pk_bf16(v1[2], v1[3]);
                    *(PG8_GAS u32x4*)(rowp + bj * HALF) = w; } }
    }
};
struct EpiBf16I8 {
    static constexpr bool PERM = true, AFTER_DRAIN = false;
    bf16_t* O; int ldc; int split_cols; size_t split_stride; float scale0; PG8_LAS unsigned char* sbuf; mutable int cnt;
    __device__ __forceinline__ void operator()(const f32x4 (&acc)[2][2][4][2], const Unit& u, int wr, int wc, int fr, int fq) const {
        const int row0 = u.pm * BM + wr * 64 + fr; int colt = u.pn * BM; bf16_t* base = O;
        float sc = 1.0f; if (split_cols) { const int t = colt / split_cols; base += (size_t)t * split_stride; colt -= t * split_cols; if (t == 0) sc = scale0; }
        const int col0 = colt + wc * 32 + 8 * fq;
        const PG8_LAS float* sa = (const PG8_LAS float*)(sbuf + (cnt & 1) * 2048) + wr * 64 + fr; const PG8_LAS float* sb = (const PG8_LAS float*)(sbuf + (cnt & 1) * 2048 + 1024) + wc * 32 + 8 * fq; ++cnt;
        f32x4 sv[2][2];
#pragma unroll
        for (int bj = 0; bj < 2; ++bj)
#pragma unroll
            for (int n = 0; n < 2; ++n) sv[bj][n] = *(const PG8_LAS f32x4*)(sb + bj * HALF + 4 * n) * sc;
#pragma unroll
        for (int ai = 0; ai < 2; ++ai)
#pragma unroll
            for (int m = 0; m < 4; ++m) { const int r = row0 + ai * HALF + m * 16; bf16_t* rowp = base + (size_t)r * ldc + col0; const float a = sa[ai * HALF + m * 16];
#pragma unroll
                for (int bj = 0; bj < 2; ++bj) { const f32x4 v0 = __builtin_convertvector(__builtin_bit_cast(i32x4, acc[ai][bj][m][0]), f32x4) * (sv[bj][0] * a), v1 = __builtin_convertvector(__builtin_bit_cast(i32x4, acc[ai][bj][m][1]), f32x4) * (sv[bj][1] * a);
                    u32x4 w; w.x = cvt_pk_bf16(v0[0], v0[1]); w.y = cvt_pk_bf16(v0[2], v0[3]); w.z = cvt_pk_bf16(v1[0], v1[1]); w.w = cvt_pk_bf16(v1[2], v1[3]);
                    *(PG8_GAS u32x4*)(rowp + bj * HALF) = w; } }
    }
};
__device__ __forceinline__ float silu_mul2(float t, float u2) { return (t * u2) * __builtin_amdgcn_rcpf(1.0f + __builtin_amdgcn_exp2f(t)); }
__device__ __forceinline__ float silu_mul(float g, float u) { const float e = __builtin_amdgcn_exp2f(g * -1.4426950408889634f); return g * u * __builtin_amdgcn_rcpf(1.0f + e); }
struct EpiSwiGlu {
    static constexpr bool PERM = true, AFTER_DRAIN = false;
    unsigned char* O; int ldc; int ntn; float ascale, hscale;
    __device__ __forceinline__ void operator()(const f32x4 (&acc)[2][2][4][2], const Unit& u, int wr, int wc, int fr, int fq) const {
        const int row0 = u.pm * BM + wr * 64 + fr; const int col0 = (u.pn % ntn) * HALF + wc * 32 + 8 * fq;
#pragma unroll
        for (int ai = 0; ai < 2; ++ai)
#pragma unroll
            for (int m = 0; m < 4; ++m) { unsigned char* rowp = O + (size_t)(row0 + ai * HALF + m * 16) * ldc + col0;
                const f32x4 g0 = acc[ai][0][m][0] * ascale, g1 = acc[ai][0][m][1] * ascale, u0 = acc[ai][1][m][0] * (ascale * hscale), u1 = acc[ai][1][m][1] * (ascale * hscale);
                u32x2 w; w.x = pk4_fp8(silu_mul(g0[0], u0[0]), silu_mul(g0[1], u0[1]), silu_mul(g0[2], u0[2]), silu_mul(g0[3], u0[3]));
                w.y = pk4_fp8(silu_mul(g1[0], u1[0]), silu_mul(g1[1], u1[1]), silu_mul(g1[2], u1[2]), silu_mul(g1[3], u1[3]));
                *(PG8_GAS u32x2*)rowp = w; }
    }
};
struct EpiSwiGluI8 {
    static constexpr bool PERM = true, AFTER_DRAIN = false;
    unsigned char* O; int ldc; int ntn; PG8_LAS unsigned char* sbuf; float hscale; mutable int cnt;
    __device__ __forceinline__ void operator()(const f32x4 (&acc)[2][2][4][2], const Unit& u, int wr, int wc, int fr, int fq) const {
        const int row0 = u.pm * BM + wr * 64 + fr; const int col0 = (u.pn % ntn) * HALF + wc * 32 + 8 * fq;
        const PG8_LAS float* sa = (const PG8_LAS float*)(sbuf + (cnt & 1) * 2048) + wr * 64 + fr; const PG8_LAS float* sb = (const PG8_LAS float*)(sbuf + (cnt & 1) * 2048 + 1024) + wc * 32 + 8 * fq; ++cnt;
        const f32x4 sg0 = *(const PG8_LAS f32x4*)(sb) * -1.4426950408889634f, sg1 = *(const PG8_LAS f32x4*)(sb + 4) * -1.4426950408889634f;
        const f32x4 su0 = *(const PG8_LAS f32x4*)(sb + HALF) * (hscale * -0.6931471805599453f), su1 = *(const PG8_LAS f32x4*)(sb + HALF + 4) * (hscale * -0.6931471805599453f);
#pragma unroll
        for (int ai = 0; ai < 2; ++ai)
#pragma unroll
            for (int m = 0; m < 4; ++m) { const int r = row0 + ai * HALF + m * 16; unsigned char* rowp = O + (size_t)r * ldc + col0; const float a = sa[ai * HALF + m * 16];
                const f32x4 g0 = __builtin_convertvector(__builtin_bit_cast(i32x4, acc[ai][0][m][0]), f32x4) * (sg0 * a), g1 = __builtin_convertvector(__builtin_bit_cast(i32x4, acc[ai][0][m][1]), f32x4) * (sg1 * a);
                const f32x4 u0 = __builtin_convertvector(__builtin_bit_cast(i32x4, acc[ai][1][m][0]), f32x4) * (su0 * a), u1 = __builtin_convertvector(__builtin_bit_cast(i32x4, acc[ai][1][m][1]), f32x4) * (su1 * a);
                u32x2 w; w.x = pk4_fp8(silu_mul2(g0[0], u0[0]), silu_mul2(g0[1], u0[1]), silu_mul2(g0[2], u0[2]), silu_mul2(g0[3], u0[3]));
                w.y = pk4_fp8(silu_mul2(g1[0], u1[0]), silu_mul2(g1[1], u1[1]), silu_mul2(g1[2], u1[2]), silu_mul2(g1[3], u1[3]));
                *(PG8_GAS u32x2*)rowp = w; }
    }
};
struct EpiPlaneF32 {
    static constexpr bool PERM = true, AFTER_DRAIN = false;
    float* O; int ntn; float scale; size_t plane;
    __device__ __forceinline__ void operator()(const f32x4 (&acc)[2][2][4][2], const Unit& u, int wr, int wc, int fr, int fq) const {
        const int row0 = (u.pm - 256) * BM + wr * 64 + fr, col0 = (u.pn % ntn) * BM + wc * 32 + 8 * fq; float* base = O + (size_t)u.ks * plane;
#pragma unroll
        for (int ai = 0; ai < 2; ++ai)
#pragma unroll
            for (int m = 0; m < 4; ++m) { float* rowp = base + (size_t)(row0 + ai * HALF + m * 16) * 1024 + col0;
#pragma unroll
                for (int bj = 0; bj < 2; ++bj) { *(PG8_GAS f32x4*)(rowp + bj * HALF) = acc[ai][bj][m][0] * scale; *(PG8_GAS f32x4*)(rowp + bj * HALF + 4) = acc[ai][bj][m][1] * scale; } }
    }
};
template <bool XIN_F32> struct EpiResidB {
    static constexpr bool PERM = true, AFTER_DRAIN = false;
    const void* xin; bf16_t* out; const float* gate; int gstride; float ascale;
    __device__ __forceinline__ void operator()(const f32x4 (&acc)[2][2][4][2], const Unit& u, int wr, int wc, int fr, int fq) const {
        const int row0 = u.pm * BM + wr * 64 + fr, col0 = u.pn * BM + wc * 32 + 8 * fq; const float* gp = gate + (size_t)(u.pm >> 4) * gstride + col0;
        f32x4 gv[2][2];
#pragma unroll
        for (int bj = 0; bj < 2; ++bj)
#pragma unroll
            for (int n = 0; n < 2; ++n) gv[bj][n] = *(const PG8_GAS f32x4*)(gp + bj * HALF + 4 * n) * ascale;
#pragma unroll
        for (int ai = 0; ai < 2; ++ai)
#pragma unroll
            for (int m = 0; m < 4; ++m) { const size_t off = (size_t)(row0 + ai * HALF + m * 16) * 1024 + col0;
#pragma unroll
                for (int bj = 0; bj < 2; ++bj) { f32x4 xa, xb;
                    if (XIN_F32) { xa = *(const PG8_GAS f32x4*)((const float*)xin + off + bj * HALF); xb = *(const PG8_GAS f32x4*)((const float*)xin + off + bj * HALF + 4); }
                    else { const u32x4 w = *(const PG8_GAS u32x4*)((const bf16_t*)xin + off + bj * HALF);
                        xa = (f32x4){__uint_as_float(w.x << 16), __uint_as_float(w.x & 0xffff0000u), __uint_as_float(w.y << 16), __uint_as_float(w.y & 0xffff0000u)};
                        xb = (f32x4){__uint_as_float(w.z << 16), __uint_as_float(w.z & 0xffff0000u), __uint_as_float(w.w << 16), __uint_as_float(w.w & 0xffff0000u)}; }
                    const f32x4 r0 = xa + gv[bj][0] * acc[ai][bj][m][0], r1 = xb + gv[bj][1] * acc[ai][bj][m][1];
                    u32x4 o; o.x = cvt_pk_bf16(r0[0], r0[1]); o.y = cvt_pk_bf16(r0[2], r0[3]); o.z = cvt_pk_bf16(r1[0], r1[1]); o.w = cvt_pk_bf16(r1[2], r1[3]);
                    *(PG8_GAS u32x4*)(out + off + bj * HALF) = o; }
                if (m & 1) asm volatile("" ::: "memory"); }
    }
};

template <class Epi, class Sched, bool ALIGN_EPI = false, bool SP2 = false, int MODE = 0>
__device__ __forceinline__ void gemm_phase(PG8_LAS unsigned char* lds, const Gemm g, const Sched& S, const Epi& E) {
    int tid_ = threadIdx.x; asm volatile("" : "+v"(tid_));
    const int tid = tid_, wid = __builtin_amdgcn_readfirstlane(tid >> 6), lane = tid & 63, wr = wid >> 2, wc = wid & 3, fr = lane & 15, fq = lane >> 4;
    const int K = g.K, nt = K / BK, LD = g.ld ? g.ld : K;
    unsigned voffA[2], voffB[2];
#pragma unroll
    for (int i = 0; i < 2; ++i) { int R, C; stage_rc(tid * 16 + i * 8192, R, C); const int Rb = Epi::PERM ? ((R & ~31) + perm32(R & 31)) : R;
        voffA[i] = (unsigned)(R * LD + C) * 2u; voffB[i] = (unsigned)(Rb * LD + C) * 2u; }
    const size_t kstep = (size_t)(BK * 2);
    const size_t hstep = (size_t)HALF * LD * 2;
    const size_t tstep = 2 * hstep;
    const unsigned ldsw = (unsigned)wid * 1024u;
    const int aoff = lds_byte(wr * 64 + fr, fq * 8), boff = lds_byte(wc * 32 + fr, fq * 8);
#define PG8_SA(b, h) (((b) * 2 + (h)) * HTB)
#define PG8_SB(b, h) ((4 + (b) * 2 + (h)) * HTB)
#define PG8_STAGE(bufoff, gbase, voff) do { _Pragma("unroll") for (int _i = 0; _i < 2; ++_i) { unsigned vo_ = (voff)[_i]; asm volatile("" : "+v"(vo_));   \
        __builtin_amdgcn_global_load_lds((const unsigned*)((const char*)(gbase) + vo_), (PG8_LAS unsigned*)(lds + (bufoff) + ldsw + _i * 8192), 16, 0, 0); } } while (0)
#define PG8_LDA(dst, b, h) do { _Pragma("unroll") for (int m = 0; m < 4; ++m) _Pragma("unroll") for (int k = 0; k < 2; ++k) dst[m][k] = *(const PG8_LAS bf16x8*)(lds + PG8_SA(b, h) + aoff + m * 2048 + k * 1024); } while (0)
#define PG8_LDB(dst, b, h) do { _Pragma("unroll") for (int n = 0; n < 2; ++n) _Pragma("unroll") for (int k = 0; k < 2; ++k) dst[n][k] = *(const PG8_LAS bf16x8*)(lds + PG8_SB(b, h) + boff + n * 2048 + k * 1024); } while (0)
#define PG8_MMA(Z, ai, bj, At, Bt) do { __builtin_amdgcn_s_setprio(1); \
        if constexpr (MODE == 1) { _Pragma("unroll") for (int m = 0; m < 4; ++m) _Pragma("unroll") for (int n = 0; n < 2; ++n) { \
            if constexpr (Z) mfma8z(acc[ai][bj][m][n], cat8(Bt[n][0], Bt[n][1]), cat8(At[m][0], At[m][1]), sc8); else mfma8(acc[ai][bj][m][n], cat8(Bt[n][0], Bt[n][1]), cat8(At[m][0], At[m][1]), sc8); } } \
        else if constexpr (MODE == 2) { _Pragma("unroll") for (int m = 0; m < 4; ++m) _Pragma("unroll") for (int n = 0; n < 2; ++n) _Pragma("unroll") for (int k = 0; k < 2; ++k) \
            acc[ai][bj][m][n] = __builtin_bit_cast(f32x4, __builtin_amdgcn_mfma_i32_16x16x64_i8(__builtin_bit_cast(i32x4, Bt[n][k]), __builtin_bit_cast(i32x4, At[m][k]), (Z && k == 0) ? (i32x4){0, 0, 0, 0} : __builtin_bit_cast(i32x4, acc[ai][bj][m][n]), 0, 0, 0)); } \
        else { _Pragma("unroll") for (int m = 0; m < 4; ++m) _Pragma("unroll") for (int n = 0; n < 2; ++n) _Pragma("unroll") for (int k = 0; k < 2; ++k) \
            acc[ai][bj][m][n] = __builtin_amdgcn_mfma_f32_16x16x32_bf16(Bt[n][k], At[m][k], (Z && k == 0) ? (f32x4){0.f, 0.f, 0.f, 0.f} : acc[ai][bj][m][n], 0, 0, 0); } __builtin_amdgcn_s_setprio(0); } while (0)
#define PG8_WAIT_V(n) asm volatile("s_waitcnt vmcnt(" #n ")" ::: "memory")
#define PG8_WAIT_L(n) asm volatile("s_waitcnt lgkmcnt(" #n ")" ::: "memory")
#define PG8_BAR __builtin_amdgcn_s_barrier()
#define PG8_SCHED __builtin_amdgcn_sched_barrier(0)
#define PG8_KITER(ZF) do { \
            const bool last = (t == nt - 2); \
            const char* a1 = cA + (size_t)(t + 1) * kstep; \
            const char* a2 = last ? nA : cA + (size_t)(t + 2) * kstep; const char* b2 = last ? nB : cB + (size_t)(t + 2) * kstep; \
            const char* a3 = a2 + kstep; const char* b3 = b2 + kstep; \
            if (last && has_next) S.a_ready(nxt); \
            if constexpr (SP2) { \
            PG8_LDB(B0, 0, 0); PG8_LDB(B1, 0, 1); PG8_SCHED; PG8_LDA(At, 0, 0); PG8_STAGE(PG8_SA(1, 1), a1 + hstep, voffA); \
            PG8_WAIT_V(8); PG8_WAIT_L(0); PG8_BAR; PG8_MMA(ZF, 0, 0, At, B0); PG8_MMA(ZF, 0, 1, At, B1); PG8_BAR; PG8_SCHED; \
            PG8_LDA(At, 0, 1); PG8_STAGE(PG8_SB(0, 0), b2, voffB); PG8_STAGE(PG8_SB(0, 1), b2 + hstep, voffB); PG8_STAGE(PG8_SA(0, 0), a2, voffA); \
            PG8_WAIT_V(8); PG8_WAIT_L(0); PG8_BAR; PG8_MMA(ZF, 1, 0, At, B0); PG8_MMA(ZF, 1, 1, At, B1); PG8_BAR; PG8_SCHED; \
            PG8_LDB(B0, 1, 0); PG8_LDB(B1, 1, 1); PG8_SCHED; PG8_LDA(At, 1, 0); PG8_STAGE(PG8_SA(0, 1), a2 + hstep, voffA); \
            PG8_WAIT_V(8); PG8_WAIT_L(0); PG8_BAR; PG8_MMA(false, 0, 0, At, B0); PG8_MMA(false, 0, 1, At, B1); PG8_BAR; PG8_SCHED; \
            PG8_LDA(At, 1, 1); PG8_STAGE(PG8_SB(1, 0), b3, voffB); PG8_STAGE(PG8_SB(1, 1), b3 + hstep, voffB); PG8_STAGE(PG8_SA(1, 0), a3, voffA); \
            PG8_WAIT_V(8); PG8_WAIT_L(0); PG8_BAR; PG8_MMA(false, 1, 0, At, B0); PG8_MMA(false, 1, 1, At, B1); PG8_BAR; PG8_SCHED; \
            } else { \
            PG8_LDB(B0, 0, 0); PG8_SCHED; PG8_LDA(At, 0, 0); PG8_STAGE(PG8_SA(1, 1), a1 + hstep, voffA); \
            PG8_WAIT_L(8); PG8_BAR; PG8_WAIT_L(0); PG8_MMA(ZF, 0, 0, At, B0); PG8_BAR; PG8_SCHED; \
            PG8_LDB(B1, 0, 1); PG8_STAGE(PG8_SB(0, 0), b2, voffB); \
            PG8_BAR; PG8_WAIT_L(0); PG8_MMA(ZF, 0, 1, At, B1); PG8_BAR; \
            PG8_LDA(At, 0, 1); PG8_STAGE(PG8_SA(0, 0), a2, voffA); \
            PG8_BAR; PG8_WAIT_L(0); PG8_MMA(ZF, 1, 0, At, B0); PG8_BAR; PG8_SCHED; \
            PG8_STAGE(PG8_SB(0, 1), b2 + hstep, voffB); \
            PG8_WAIT_V(6); PG8_BAR; PG8_MMA(ZF, 1, 1, At, B1); PG8_BAR; \
            PG8_LDB(B0, 1, 0); PG8_SCHED; PG8_LDA(At, 1, 0); PG8_STAGE(PG8_SA(0, 1), a2 + hstep, voffA); \
            PG8_WAIT_L(8); PG8_BAR; PG8_WAIT_L(0); PG8_MMA(false, 0, 0, At, B0); PG8_BAR; PG8_SCHED; \
            PG8_LDB(B1, 1, 1); PG8_STAGE(PG8_SB(1, 0), b3, voffB); \
            PG8_BAR; PG8_WAIT_L(0); PG8_MMA(false, 0, 1, At, B1); PG8_BAR; \
            PG8_LDA(At, 1, 1); PG8_STAGE(PG8_SA(1, 0), a3, voffA); \
            PG8_BAR; PG8_WAIT_L(0); PG8_MMA(false, 1, 0, At, B0); PG8_BAR; PG8_SCHED; \
            PG8_STAGE(PG8_SB(1, 1), b3 + hstep, voffB); \
            PG8_WAIT_V(6); PG8_BAR; PG8_MMA(false, 1, 1, At, B1); PG8_BAR; \
            } \
        } while (0)
    int sc8 = 0x7f7f7f7f; asm volatile("" : "+v"(sc8));
    Unit cur, nxt; int ui = 0;
    if (!S.next(0, cur)) return;
    f32x4 acc[2][2][4][2];
    bf16x8 At[4][2], B0[2][2], B1[2][2];
    const char* cA = (const char*)g.A + (size_t)cur.pm * tstep; const char* cB = (const char*)g.Bt + (size_t)cur.pn * tstep;
    if constexpr (Sched::SPLITK) { cA += (size_t)cur.ks * K * 2; cB += (size_t)cur.ks * K * 2; }
    S.a_ready(cur);
    if constexpr (SP2) {
        PG8_STAGE(PG8_SB(0, 0), cB, voffB); PG8_STAGE(PG8_SB(0, 1), cB + hstep, voffB); PG8_STAGE(PG8_SA(0, 0), cA, voffA); PG8_STAGE(PG8_SA(0, 1), cA + hstep, voffA);
        if (wr == 1) PG8_BAR;
        PG8_WAIT_V(2); PG8_BAR;
        PG8_STAGE(PG8_SB(1, 0), cB + kstep, voffB); PG8_STAGE(PG8_SA(1, 0), cA + kstep, voffA); PG8_STAGE(PG8_SB(1, 1), cB + hstep + kstep, voffB);
        PG8_WAIT_V(6); PG8_BAR;
    } else {
        PG8_STAGE(PG8_SB(0, 0), cB, voffB); PG8_STAGE(PG8_SA(0, 0), cA, voffA); PG8_STAGE(PG8_SB(0, 1), cB + hstep, voffB); PG8_STAGE(PG8_SA(0, 1), cA + hstep, voffA);
        if (wr == 1) PG8_BAR;
        PG8_WAIT_V(4); PG8_BAR;
        PG8_STAGE(PG8_SB(1, 0), cB + kstep, voffB); PG8_STAGE(PG8_SA(1, 0), cA + kstep, voffA); PG8_STAGE(PG8_SB(1, 1), cB + hstep + kstep, voffB);
        PG8_WAIT_V(6); PG8_BAR;
    }
    for (;;) {
        const bool has_next = S.next(ui + 1, nxt);
        const char* nA = has_next ? (const char*)g.A + (size_t)nxt.pm * tstep : cA; const char* nB = has_next ? (const char*)g.Bt + (size_t)nxt.pn * tstep : cB;
        if constexpr (Sched::SPLITK) { if (has_next) { nA += (size_t)nxt.ks * K * 2; nB += (size_t)nxt.ks * K * 2; } }
        { const int t = 0; PG8_KITER(true); }
#pragma nounroll
        for (int t = 2; t < nt; t += 2) { PG8_KITER(false); }
        if constexpr (MODE == 1) asm volatile("s_nop 15\n\ts_nop 7" ::: "memory");
        if constexpr (ALIGN_EPI) { if (wr == 0) PG8_BAR; }
        if constexpr (!Epi::AFTER_DRAIN) { E(acc, cur, wr, wc, fr, fq); S.done(cur); }
        if (!has_next) break;
        cur = nxt; cA = nA; cB = nB; ++ui;
        if constexpr (ALIGN_EPI) { if (wr == 1) PG8_BAR; }
    }
    PG8_WAIT_V(0);
    if constexpr (!ALIGN_EPI) { if (wr == 0) PG8_BAR; }
    PG8_BAR;
    if constexpr (Epi::AFTER_DRAIN) { E.fused(acc, cur, wr, wc, fr, fq, lds, wid, lane); S.done(cur); }
#undef PG8_SA
#undef PG8_SB
#undef PG8_STAGE
#undef PG8_LDA
#undef PG8_LDB
#undef PG8_MMA
#undef PG8_KITER
#undef PG8_WAIT_V
#undef PG8_WAIT_L
#undef PG8_BAR
#undef PG8_SCHED
}
}

constexpr int NWAVES = 8;
constexpr int NB = 8, SEQ = 4096, D = 1024, NH = 16, HD = 64, NTOK = NB * SEQ;
constexpr int FF = 2816, FFE = 3584, NE = 8;
constexpr int MODW = 6 * D, MODLD = 4 * MODW + 2 * D;
constexpr int KVMOD = 4 * MODW;
constexpr float RMS_EPS = 1e-6f;
constexpr float LOG2E = 1.4426950408889634f;
constexpr float QSCALE = 0.125f * LOG2E;
constexpr float ASCALE8 = 4.0f, WSCALE8 = 128.0f, HSCALE8 = 4.0f, OSCALE8 = 16.0f;
constexpr int BT_PAD = 256;
constexpr int MAXTILES = 264;

constexpr size_t MiB = 1u << 20;
constexpr size_t WS_CTL = 0, CTL_ZERO_BYTES = 64 * 1024;
constexpr size_t WS_MOD = 1 * MiB;
constexpr size_t WS_BIAS = 2 * MiB;
constexpr size_t WS_KMEAN = 2 * MiB + 256 * 1024;
constexpr size_t WS_TOKE = 3 * MiB;
constexpr size_t WS_TOKW = WS_TOKE + 128 * 1024;
constexpr size_t WS_TOKS = WS_TOKW + 256 * 1024;
constexpr size_t WS_HIST = WS_TOKS + 256 * 1024;
constexpr size_t WS_SA = 4 * MiB, WS_SAG = 4 * MiB + 256 * 1024;
constexpr size_t WS_SA2 = 4 * MiB + 640 * 1024;
constexpr size_t WS_SBQKV = 5 * MiB + 576 * 1024, WS_SBKV = WS_SBQKV + 32 * 1024, WS_SBQ = WS_SBKV + 16 * 1024;
constexpr size_t WS_SB13 = 5 * MiB, WS_SBM13 = 5 * MiB + 64 * 1024;
constexpr size_t WS_WQKV = 8 * MiB, WS_WO = 20 * MiB, WS_WKV = 24 * MiB, WS_WQ = 28 * MiB, WS_WBO = 32 * MiB, WS_W13 = 36 * MiB, WS_W2 = 58 * MiB, WS_MW13 = 70 * MiB, WS_MW2 = 294 * MiB;
constexpr size_t WS_XN = 408 * MiB, WS_XN2 = 440 * MiB, WS_XBF = 472 * MiB;
constexpr size_t WS_Q = 536 * MiB, WS_K = 600 * MiB, WS_V = 664 * MiB, WS_KSH = 728 * MiB, WS_VSH = 792 * MiB, WS_HID = 856 * MiB, WS_END = 1320 * MiB;
constexpr int TAIL_NS = 2, TAIL_ROWS = (MAXTILES - 256) * 256;
constexpr size_t WS_YT = WS_KSH;
constexpr size_t WS_XG = WS_Q;
static_assert((size_t)MAXTILES * 256 * D * 2 <= WS_KSH - WS_Q && (size_t)MAXTILES * 256 * FFE * 2 <= WS_END - WS_HID && WS_MW2 + (size_t)16 * D * FFE * 2 <= WS_XN, "d_ws map");
constexpr int CW_TMO = 0, CW_CODE = 1, CW_BAR = 4096;

constexpr int RING_OFF = 0, RING_BYTES = 131072;
constexpr int LDSCTL_OFF = RING_BYTES, MISC_OFF = LDSCTL_OFF + 320;
constexpr int ROUTE_OFF = RING_BYTES + 1024;
constexpr int RT_CNT = 0, RT_BASE = 8, RT_SEG = 16, RT_NT = 25, RT_TEXP = 32, RT_WC = 320, RT_LS = 336, RT_HIST = 600;
constexpr int PTR_OFF = RING_BYTES + 512;
constexpr int SCALEBUF_OFF = RING_BYTES + 4096;
constexpr int LDS_BYTES = 147456;
static_assert(ROUTE_OFF + (RT_HIST + 8) * 4 <= LDS_BYTES, "LDS map");

#define GAS __attribute__((address_space(1)))
#define LAS __attribute__((address_space(3)))
typedef unsigned short bf16;
typedef unsigned v4u __attribute__((ext_vector_type(4)));
typedef unsigned v2u __attribute__((ext_vector_type(2)));
typedef float f32x4 __attribute__((ext_vector_type(4)));
typedef float f32x2 __attribute__((ext_vector_type(2)));
typedef GAS unsigned gu32;
#define RLX_AGENT __ATOMIC_RELAXED, __HIP_MEMORY_SCOPE_AGENT
#define LDS_WAIT() asm volatile("s_waitcnt lgkmcnt(0)" ::: "memory")
#define VM_WAIT() asm volatile("s_waitcnt vmcnt(0)" ::: "memory")
__device__ __forceinline__ unsigned f2bf(float f) { unsigned u = __builtin_bit_cast(unsigned, f); return (u + 0x7fffu + ((u >> 16) & 1u)) >> 16; }
__device__ __forceinline__ unsigned pk2(float lo, float hi) { return f2bf(lo) | (f2bf(hi) << 16); }
__device__ __forceinline__ float bflo(unsigned w) { return __uint_as_float(w << 16); }
__device__ __forceinline__ float bfhi(unsigned w) { return __uint_as_float(w & 0xffff0000u); }
template <int CTRL> __device__ __forceinline__ float dppf(float v) { return __uint_as_float((unsigned)__builtin_amdgcn_update_dpp(0, (int)__float_as_uint(v), CTRL, 0xf, 0xf, true)); }
template <int CTRL> __device__ __forceinline__ int dppi(int v) { return __builtin_amdgcn_update_dpp(0, v, CTRL, 0xf, 0xf, true); }
#define DPP_X1 0xB1
#define DPP_X2 0x4E
#define DPP_HM 0x141
#define DPP_RM 0x140
#define DPP_X8 0x128
__device__ __forceinline__ float sum16x(float v) { const auto r = __builtin_amdgcn_permlane16_swap(__float_as_uint(v), __float_as_uint(v), false, false); return __uint_as_float(r[0]) + __uint_as_float(r[1]); }
__device__ __forceinline__ float sum32x(float v) { const auto r = __builtin_amdgcn_permlane32_swap(__float_as_uint(v), __float_as_uint(v), false, false); return __uint_as_float(r[0]) + __uint_as_float(r[1]); }
__device__ __forceinline__ float max16x(float v) { const auto r = __builtin_amdgcn_permlane16_swap(__float_as_uint(v), __float_as_uint(v), false, false); return fmaxf(__uint_as_float(r[0]), __uint_as_float(r[1])); }
__device__ __forceinline__ float max32x(float v) { const auto r = __builtin_amdgcn_permlane32_swap(__float_as_uint(v), __float_as_uint(v), false, false); return fmaxf(__uint_as_float(r[0]), __uint_as_float(r[1])); }
__device__ __forceinline__ int isum16x(int v) { const auto r = __builtin_amdgcn_permlane16_swap((unsigned)v, (unsigned)v, false, false); return (int)(r[0] + r[1]); }
__device__ __forceinline__ int isum32x(int v) { const auto r = __builtin_amdgcn_permlane32_swap((unsigned)v, (unsigned)v, false, false); return (int)(r[0] + r[1]); }
__device__ __forceinline__ float wave_sum(float v) { v += dppf<DPP_X1>(v); v += dppf<DPP_X2>(v); v += dppf<DPP_HM>(v); v += dppf<DPP_RM>(v); return sum32x(sum16x(v)); }
__device__ __forceinline__ float wave_max(float v) { v = fmaxf(v, dppf<DPP_X1>(v)); v = fmaxf(v, dppf<DPP_X2>(v)); v = fmaxf(v, dppf<DPP_HM>(v)); v = fmaxf(v, dppf<DPP_RM>(v)); return max32x(max16x(v)); }
__device__ __forceinline__ int wave_isum(int v) { v += dppi<DPP_X1>(v); v += dppi<DPP_X2>(v); v += dppi<DPP_HM>(v); v += dppi<DPP_RM>(v); return isum32x(isum16x(v)); }
__device__ __forceinline__ float max_x8_16_32(float v) { v = fmaxf(v, dppf<DPP_X8>(v)); return max32x(max16x(v)); }
__device__ __forceinline__ float ex2(float x) { return __builtin_amdgcn_exp2f(x); }
__device__ __forceinline__ float lg2(float x) { return __builtin_amdgcn_logf(x); }

#define XB_TMO      128
#define XB_XCNT(j)  (256  + 64 * (j))
#define XB_XSUB(j)  (1280 + 64 * (j))
#define XB_XGEN(j)  (2304 + 64 * (j))
#define XB_TOP      3328
#define XB_TOPGEN   3392
#define XB_LSUB(j)  (3456 + 64 * (j))
#define XB_LGEN(j)  (4480 + 64 * (j))
#define XCD_BAR_WORDS 5504
#define XB_SPIN_CAP (1u << 18)

__device__ __forceinline__ unsigned xb_ld(unsigned* p)              { return __hip_atomic_load(p, __ATOMIC_RELAXED, __HIP_MEMORY_SCOPE_AGENT); }
__device__ __forceinline__ unsigned xb_add(unsigned* p, unsigned v) { return __hip_atomic_fetch_add(p, v, __ATOMIC_RELAXED, __HIP_MEMORY_SCOPE_AGENT); }
__device__ __forceinline__ unsigned xb_xcc_id() { return (unsigned)__builtin_amdgcn_s_getreg((3 << 11) | 20) & 0xFu; }
#define XB_SPIN(cond, bar) do { unsigned _sp = 0; while (cond) { __builtin_amdgcn_s_sleep(1); \
    if ((++_sp & 255u) == 0u) { if (xb_ld(&(bar)[XB_TMO])) break; if (_sp > XB_SPIN_CAP) { atomicAdd(&(bar)[XB_TMO], 1u); break; } } } } while (0)

struct XcdBarrier {
    unsigned* bar; unsigned x;
    volatile LAS unsigned* st;
};

__device__ __forceinline__ XcdBarrier xcd_barrier_post(unsigned* bar, volatile LAS unsigned* st) {
    XcdBarrier b; b.bar = bar; b.x = xb_xcc_id(); b.st = st;
    if (threadIdx.x == 0) st[3] = 1u + xb_add(&bar[XB_XCNT(b.x)], 1u);
    return b;
}
__device__ __forceinline__ void xcd_barrier_complete(unsigned* bar, unsigned x, unsigned& nloc, unsigned& nx, unsigned& reg32) {
    const unsigned G = gridDim.x * gridDim.y * gridDim.z;
    unsigned sum, cnt, mine, n32, sp = 0u;
    for (;;) {
        sum = 0u; cnt = 0u; mine = 0u; n32 = 0u;
#pragma unroll
        for (unsigned j = 0; j < 16; ++j) { const unsigned c = xb_ld(&bar[XB_XCNT(j)]); sum += c; cnt += (c > 0u) ? 1u : 0u; n32 += (c == 32u && j < 8u) ? 1u : 0u; mine = (j == x) ? c : mine; }
        if (sum == G) break;
        __builtin_amdgcn_s_sleep(1);
        if ((++sp & 255u) == 0u) { if (xb_ld(&bar[XB_TMO])) break; if (sp > XB_SPIN_CAP) { atomicAdd(&bar[XB_TMO], 1u); break; } }
    }
    nloc = mine > 0u ? mine : 1u; nx = cnt > 0u ? cnt : 1u;
    reg32 = (sum == G && G == 256u && n32 == 8u) ? 1u : 0u;
}

__device__ __forceinline__ void xcd_barrier(const XcdBarrier& b) {
    asm volatile("s_waitcnt vmcnt(0)" ::: "memory");
    __syncthreads();
    if (threadIdx.x == 0) {
        unsigned* bar = b.bar;
        __builtin_amdgcn_s_waitcnt(0);
        unsigned nloc = b.st[0], nx = b.st[1];
        if (nloc == 0u) { unsigned r32; xcd_barrier_complete(bar, b.x, nloc, nx, r32); b.st[0] = nloc; b.st[1] = nx; b.st[2] = 1u + r32; }
        const unsigned old = xb_add(&bar[XB_XSUB(b.x)], 1u);
        const unsigned gen = old / nloc;
        if (old + 1u == (gen + 1u) * nloc) {
            __builtin_amdgcn_fence(__ATOMIC_RELEASE, "agent");
            asm volatile("s_waitcnt vmcnt(0)" ::: "memory");
            const unsigned og = xb_add(&bar[XB_TOP], 1u);
            const unsigned tg = og / nx;
            if (og + 1u == (tg + 1u) * nx) xb_add(&bar[XB_TOPGEN], 1u);
            else XB_SPIN(xb_ld(&bar[XB_TOPGEN]) == tg, bar);
            __builtin_amdgcn_fence(__ATOMIC_ACQUIRE, "agent");
            xb_add(&bar[XB_XGEN(b.x)], 1u);
            asm volatile("s_waitcnt vmcnt(0)" ::: "memory");
        } else {
            XB_SPIN(xb_ld(&bar[XB_XGEN(b.x)]) == gen, bar);
            __builtin_amdgcn_fence(__ATOMIC_ACQUIRE, "agent");
            asm volatile("s_waitcnt vmcnt(0)" ::: "memory");
        }
    }
    __syncthreads();
}

__device__ __forceinline__ void xcd_barrier_local(const XcdBarrier& b) {
    asm volatile("s_waitcnt vmcnt(0)" ::: "memory");
    __syncthreads();
    if (threadIdx.x == 0) {
        unsigned* bar = b.bar;
        __builtin_amdgcn_s_waitcnt(0);
        const unsigned old = xb_add(&bar[XB_LSUB(b.x)], 1u);
        const unsigned gen = old >> 5;
        if (((old + 1u) & 31u) == 0u) xb_add(&bar[XB_LGEN(b.x)], 1u);
        else XB_SPIN(xb_ld(&bar[XB_LGEN(b.x)]) == gen, bar);
        __builtin_amdgcn_fence(__ATOMIC_ACQUIRE, "agent");
        asm volatile("s_waitcnt vmcnt(0)" ::: "memory");
    }
    __syncthreads();
}

struct Ctx { LAS unsigned char* lds; int tid, lane, wave, vcu, G; };
__device__ __forceinline__ Ctx phase_ctx(const Ctx& C0) { Ctx C = C0; int t = C0.tid; asm volatile("" : "+v"(t)); C.tid = t; C.lane = t & 63; return C; }
enum { IN_X = 0, IN_C, IN_RELB, IN_MODW, IN_MODB, IN_NMIX, IN_NFFN, IN_AWQKV, IN_AWO, IN_KVNG, IN_KVMW, IN_KVMB, IN_BWKV, IN_BWQ, IN_BWO, IN_W13, IN_W2, IN_RW, IN_MW13, IN_MW2, IN_FNG, IN_OUT, IN_WS, IN_COUNT };
__device__ __forceinline__ unsigned long long ptr_bits(const Ctx& C, int k) {
    volatile LAS unsigned long long* t = (volatile LAS unsigned long long*)(C.lds + PTR_OFF);
    const unsigned long long v = t[k];
    const unsigned lo = __builtin_amdgcn_readfirstlane((unsigned)v), hi = __builtin_amdgcn_readfirstlane((unsigned)(v >> 32));
    return ((unsigned long long)hi << 32) | lo; }
__device__ __forceinline__ const float* inp(const Ctx& C, int k) { return (const float*)ptr_bits(C, k); }
__device__ __forceinline__ float* outp(const Ctx& C) { return (float*)ptr_bits(C, IN_OUT); }
__device__ __forceinline__ unsigned char* wsp(const Ctx& C) { return (unsigned char*)ptr_bits(C, IN_WS); }

__device__ __forceinline__ void tr_load(f32x4 (&v)[8], const float* W, int N, int cs, int k0, int lane) {
#pragma unroll
    for (int i = 0; i < 8; ++i) v[i] = *(const GAS f32x4*)(W + (size_t)(k0 + 8 * i + (lane >> 3)) * N + cs + 4 * (lane & 7));
}
template <bool F8>
__device__ __forceinline__ void tr_item(const f32x4 (&v)[8], int K, bf16* WT, int rd, int k0, LAS float* scr, int lane) {
#pragma unroll
    for (int i = 0; i < 8; ++i) { LAS float* d = scr + (8 * i + (lane >> 3)) * 33 + 4 * (lane & 7); d[0] = v[i].x; d[1] = v[i].y; d[2] = v[i].z; d[3] = v[i].w; }
    LDS_WAIT(); asm volatile("" ::: "memory");
    const int c = lane & 7;
    if (F8) {
#pragma unroll
        for (int j = 0; j < 4; ++j) { const int n = (lane >> 3) + 8 * j; const LAS float* s = scr + (8 * c) * 33 + n;
            v2u o; o.x = pg8::pk4_fp8(s[0 * 33] * WSCALE8, s[1 * 33] * WSCALE8, s[2 * 33] * WSCALE8, s[3 * 33] * WSCALE8); o.y = pg8::pk4_fp8(s[4 * 33] * WSCALE8, s[5 * 33] * WSCALE8, s[6 * 33] * WSCALE8, s[7 * 33] * WSCALE8);
            *(GAS v2u*)((unsigned char*)WT + (size_t)(rd + n) * K + k0 + 8 * c) = o; }
    } else {
#pragma unroll
        for (int j = 0; j < 4; ++j) { const int n = (lane >> 3) + 8 * j; const LAS float* s = scr + (8 * c) * 33 + n;
            v4u o; o.x = pk2(s[0 * 33], s[1 * 33]); o.y = pk2(s[2 * 33], s[3 * 33]); o.z = pk2(s[4 * 33], s[5 * 33]); o.w = pk2(s[6 * 33], s[7 * 33]);
            *(GAS v4u*)(WT + (size_t)(rd + n) * K + k0 + 8 * c) = o; }
    }
    LDS_WAIT(); asm volatile("" ::: "memory");
}
template <bool F8>
__device__ __forceinline__ void tr_group(const float* src, bf16* dst, int K, int N, int F, int cnt, int& it, int NTW, LAS float* scr, int lane) {
    const int nblk = N / 32, ipm = (K / 64) * nblk, total = cnt * ipm;
#define TRG_LOAD(vv, it_) do { const int mi_ = (it_) / ipm, r_ = (it_) - mi_ * ipm, kb_ = r_ / nblk, rd_ = 32 * (r_ - kb_ * nblk); int cs_ = rd_; \
        if (F) { const int j_ = rd_ >> 8, w_ = rd_ & 255; cs_ = (w_ < 128) ? 128 * j_ + w_ : F + 128 * j_ + (w_ - 128); } tr_load(vv, src + (size_t)mi_ * K * N, N, cs_, 64 * kb_, lane); } while (0)
    f32x4 v[8], vn[8];
    if (it < total) TRG_LOAD(v, it);
    for (; it < total; it += NTW) {
        const int mi = it / ipm, r = it - mi * ipm, kb = r / nblk, nb = r - kb * nblk, rd = 32 * nb;
        if (it + NTW < total) TRG_LOAD(vn, it + NTW);
        tr_item<F8>(v, K, F8 ? (bf16*)((unsigned char*)dst + (size_t)mi * K * N) : dst + (size_t)mi * K * N, rd, 64 * kb, scr, lane);
#pragma unroll
        for (int i = 0; i < 8; ++i) v[i] = vn[i];
    }
#undef TRG_LOAD
    it -= total;
}
__device__ __forceinline__ unsigned q8b(float x) { return __float_as_uint(x + 12582912.0f) & 0xffu; }
__device__ __forceinline__ void tr_group_i8(const float* src, unsigned char* dst, float* sBout, int K, int N, int F, int cnt, int& it, int NTW, LAS float* scr, int lane) {
    const int nblk = N / 32, total = cnt * nblk;
    for (; it < total; it += NTW) {
        const int mi = it / nblk, nb = it - mi * nblk, rd = 32 * nb;
        int cs = rd; if (F) { const int j = rd >> 8, w = rd & 255; cs = (w < 128) ? 128 * j + w : F + 128 * j + (w - 128); }
        const float* W = src + (size_t)mi * K * N + cs + 4 * (lane & 7);
        f32x4 mx = (f32x4){0.f, 0.f, 0.f, 0.f};
#pragma unroll 2
        for (int kb = 0; kb < K / 64; ++kb) {
#pragma unroll
            for (int i = 0; i < 8; ++i) { const f32x4 v = *(const GAS f32x4*)(W + (size_t)(64 * kb + 8 * i + (lane >> 3)) * N);
                mx.x = fmaxf(mx.x, fabsf(v.x)); mx.y = fmaxf(mx.y, fabsf(v.y)); mx.z = fmaxf(mx.z, fabsf(v.z)); mx.w = fmaxf(mx.w, fabsf(v.w)); } }
        mx.x = max_x8_16_32(mx.x); mx.y = max_x8_16_32(mx.y); mx.z = max_x8_16_32(mx.z); mx.w = max_x8_16_32(mx.w);
        f32x4 inv, sc;
        inv.x = mx.x > 0.f ? 127.0f / mx.x : 0.f; inv.y = mx.y > 0.f ? 127.0f / mx.y : 0.f; inv.z = mx.z > 0.f ? 127.0f / mx.z : 0.f; inv.w = mx.w > 0.f ? 127.0f / mx.w : 0.f;
        sc = mx * (1.0f / 127.0f);
        if ((lane >> 3) == 0) *(GAS f32x4*)(sBout + (size_t)mi * N + rd + 4 * (lane & 7)) = sc;
        unsigned char* WT = dst + ((size_t)mi * N + rd) * K;
        for (int kb = 0; kb < K / 64; ++kb) {
            f32x4 v[8];
#pragma unroll
            for (int i = 0; i < 8; ++i) v[i] = *(const GAS f32x4*)(W + (size_t)(64 * kb + 8 * i + (lane >> 3)) * N);
#pragma unroll
            for (int i = 0; i < 8; ++i) { LAS float* d = scr + (8 * i + (lane >> 3)) * 33 + 4 * (lane & 7); d[0] = v[i].x * inv.x; d[1] = v[i].y * inv.y; d[2] = v[i].z * inv.z; d[3] = v[i].w * inv.w; }
            LDS_WAIT(); asm volatile("" ::: "memory");
            const int c = lane & 7;
#pragma unroll
            for (int j = 0; j < 4; ++j) { const int n = (lane >> 3) + 8 * j; const LAS float* s = scr + (8 * c) * 33 + n;
                v2u o; o.x = q8b(s[0 * 33]) | (q8b(s[1 * 33]) << 8) | (q8b(s[2 * 33]) << 16) | (q8b(s[3 * 33]) << 24); o.y = q8b(s[4 * 33]) | (q8b(s[5 * 33]) << 8) | (q8b(s[6 * 33]) << 16) | (q8b(s[7 * 33]) << 24);
                *(GAS v2u*)(WT + (size_t)n * K + 64 * kb + 8 * c) = o; }
            LDS_WAIT(); asm volatile("" ::: "memory");
        }
    }
    it -= total;
}
__device__ __forceinline__ void i8_wg_group(const Ctx& C, const float* src, unsigned char* dst, float* sBout, int N, int F, int cnt, int& it, LAS float* scr) {
    constexpr int K = D;
    const int lane = C.lane, nblk = N / 32, total = cnt * nblk;
    LAS float* pmax = (LAS float*)(C.lds + 69632);
#define I8WG_SRC(it_) ([&](int i_) { const int mi_ = i_ / nblk, rd_ = 32 * (i_ - mi_ * nblk); int cs_ = rd_; if (F) { const int j_ = rd_ >> 8, w_ = rd_ & 255; cs_ = (w_ < 128) ? 128 * j_ + w_ : F + 128 * j_ + (w_ - 128); } \
        return src + (size_t)mi_ * K * N + (size_t)(128 * C.wave + (lane >> 3)) * N + cs_ + 4 * (lane & 7); })(it_)
    f32x4 v[16], vn[16];
    if (it < total) { const float* W0 = I8WG_SRC(it);
#pragma unroll
        for (int i = 0; i < 16; ++i) v[i] = *(const GAS f32x4*)(W0 + (size_t)(8 * i) * N); }
    for (; it < total; it += C.G) {
        const int mi = it / nblk, nb = it - mi * nblk, rd = 32 * nb, par = (it / C.G) & 1;
        f32x4 mx = (f32x4){0.f, 0.f, 0.f, 0.f};
#pragma unroll
        for (int i = 0; i < 16; ++i) { mx.x = fmaxf(mx.x, fabsf(v[i].x)); mx.y = fmaxf(mx.y, fabsf(v[i].y)); mx.z = fmaxf(mx.z, fabsf(v[i].z)); mx.w = fmaxf(mx.w, fabsf(v[i].w)); }
        mx.x = max_x8_16_32(mx.x); mx.y = max_x8_16_32(mx.y); mx.z = max_x8_16_32(mx.z); mx.w = max_x8_16_32(mx.w);
        if (lane < 8) *(LAS f32x4*)(pmax + (par * 8 + C.wave) * 32 + 4 * lane) = mx;
        __syncthreads();
        if (it + C.G < total) { const float* Wn = I8WG_SRC(it + C.G);
#pragma unroll
            for (int i = 0; i < 16; ++i) vn[i] = *(const GAS f32x4*)(Wn + (size_t)(8 * i) * N); }
#pragma unroll
        for (int w = 0; w < 8; ++w) { const f32x4 p = *(const LAS f32x4*)(pmax + (par * 8 + w) * 32 + 4 * (lane & 7)); mx.x = fmaxf(mx.x, p.x); mx.y = fmaxf(mx.y, p.y); mx.z = fmaxf(mx.z, p.z); mx.w = fmaxf(mx.w, p.w); }
        f32x4 inv;
        inv.x = mx.x > 0.f ? 127.0f / mx.x : 0.f; inv.y = mx.y > 0.f ? 127.0f / mx.y : 0.f; inv.z = mx.z > 0.f ? 127.0f / mx.z : 0.f; inv.w = mx.w > 0.f ? 127.0f / mx.w : 0.f;
        if (C.wave == 0 && lane < 8) *(GAS f32x4*)(sBout + (size_t)mi * N + rd + 4 * lane) = mx * (1.0f / 127.0f);
        unsigned char* WT = dst + ((size_t)mi * N + rd) * K + 128 * C.wave;
#pragma unroll
        for (int hf = 0; hf < 2; ++hf) {
#pragma unroll
            for (int i = 0; i < 8; ++i) { LAS float* d = scr + (8 * i + (lane >> 3)) * 33 + 4 * (lane & 7); const f32x4 x = v[8 * hf + i]; d[0] = x.x * inv.x; d[1] = x.y * inv.y; d[2] = x.z * inv.z; d[3] = x.w * inv.w; }
            LDS_WAIT(); asm volatile("" ::: "memory");
            const int c = lane & 7;
#pragma unroll
            for (int j = 0; j < 4; ++j) { const int n = (lane >> 3) + 8 * j; const LAS float* sp = scr + (8 * c) * 33 + n;
                v2u o; o.x = q8b(sp[0 * 33]) | (q8b(sp[1 * 33]) << 8) | (q8b(sp[2 * 33]) << 16) | (q8b(sp[3 * 33]) << 24); o.y = q8b(sp[4 * 33]) | (q8b(sp[5 * 33]) << 8) | (q8b(sp[6 * 33]) << 16) | (q8b(sp[7 * 33]) << 24);
                *(GAS v2u*)(WT + (size_t)n * K + 64 * hf + 8 * c) = o; }
            LDS_WAIT(); asm volatile("" ::: "memory");
        }
#pragma unroll
        for (int i = 0; i < 16; ++i) v[i] = vn[i];
    }
#undef I8WG_SRC
    it -= total;
}
__device__ __forceinline__ void gemv_mod(const Ctx& C, int w) {
    const float* Wm; const float* bias; int N, j0, ooff;
    if (w < 192) { const int l = w / 48, cb = w % 48; Wm = inp(C, IN_MODW) + (size_t)l * D * MODW; bias = inp(C, IN_MODB) + l * MODW; N = MODW; j0 = 128 * cb; ooff = l * MODW + j0; }
    else { const int cb = w - 192; Wm = inp(C, IN_KVMW); bias = inp(C, IN_KVMB); N = 2 * D; j0 = 128 * cb; ooff = KVMOD + j0; }
    const LAS f32x4* tab = (const LAS f32x4*)(C.lds + 65536) + 2 * 128 * C.wave;
    const GAS f32x2* wp = (const GAS f32x2*)(Wm + (size_t)(128 * C.wave) * N + j0) + C.lane;
    const size_t rs = (size_t)(N / 2);
    float a0[8], a1[8];
#pragma unroll
    for (int b = 0; b < 8; ++b) { a0[b] = 0.f; a1[b] = 0.f; }
#pragma unroll 1
    for (int k0 = 0; k0 < 128; k0 += 32) {
        f32x2 wq[32];
#pragma unroll
        for (int i = 0; i < 32; ++i) wq[i] = wp[(size_t)(k0 + i) * rs];
#pragma unroll
        for (int i = 0; i < 32; ++i) { const int k = k0 + i; const f32x2 wv = wq[i]; const f32x4 s0 = tab[2 * k], s1 = tab[2 * k + 1];
            a0[0] += s0.x * wv.x; a1[0] += s0.x * wv.y; a0[1] += s0.y * wv.x; a1[1] += s0.y * wv.y; a0[2] += s0.z * wv.x; a1[2] += s0.z * wv.y; a0[3] += s0.w * wv.x; a1[3] += s0.w * wv.y;
            a0[4] += s1.x * wv.x; a1[4] += s1.x * wv.y; a0[5] += s1.y * wv.x; a1[5] += s1.y * wv.y; a0[6] += s1.z * wv.x; a1[6] += s1.z * wv.y; a0[7] += s1.w * wv.x; a1[7] += s1.w * wv.y; }
    }
    LAS float* part = (LAS float*)(C.lds + 98304);
#pragma unroll
    for (int b = 0; b < 8; ++b) *(LAS f32x2*)(part + (C.wave * 8 + b) * 128 + 2 * C.lane) = (f32x2){a0[b], a1[b]};
    __syncthreads();
    float* mod = (float*)(wsp(C) + WS_MOD);
#pragma unroll
    for (int j = 0; j < 2; ++j) { const int idx = C.tid + 512 * j, b = idx >> 7, col = idx & 127; float s = bias[j0 + col];
#pragma unroll
        for (int ww = 0; ww < 8; ++ww) s += part[(ww * 8 + b) * 128 + col];
        mod[(size_t)b * MODLD + ooff + col] = s; }
    __syncthreads();
}
__device__ __forceinline__ void p0_prologue(const Ctx& C0) {
    const Ctx C = phase_ctx(C0);
    const int wg = (int)blockIdx.x;
    if (wg < 208) {
        LAS float* tab = (LAS float*)(C.lds + 65536);
        { const float* cin = inp(C, IN_C); float cv[NB * D / (NWAVES * 64)];
#pragma unroll
          for (int q = 0; q < NB * D / (NWAVES * 64); ++q) cv[q] = cin[C.tid + q * NWAVES * 64];
#pragma unroll
          for (int q = 0; q < NB * D / (NWAVES * 64); ++q) { const int idx = C.tid + q * NWAVES * 64, b = idx >> 10, k = idx & 1023; const float v = cv[q]; tab[k * 8 + b] = v / (1.0f + __expf(-v)); } }
        __syncthreads();
        gemv_mod(C, wg);
    } else if (wg < 224 && C.wave == 7) {
        const int h = wg - 208; float* bt = (float*)(wsp(C) + WS_BIAS) + h * 1024;
#pragma unroll
        for (int i = 0; i < 16; ++i) { const int d = C.lane + 64 * i; int bk;
            if (d < 16) bk = d; else { bk = 16 + (int)(logf((float)d / 16.0f) / 4.1588830833596715f * 16.0f); bk = bk > 31 ? 31 : bk; }
            bt[d] = inp(C, IN_RELB)[bk * NH + h] * LOG2E; }
    }
    {
        LAS float* scr = (LAS float*)(C.lds + C.wave * 8704);
        unsigned char* ws = wsp(C);
        int itg = wg;
        i8_wg_group(C, inp(C, IN_MW13), ws + WS_MW13, (float*)(ws + WS_SBM13), 2 * FFE, FFE, 16, itg, scr);
        i8_wg_group(C, inp(C, IN_W13), ws + WS_W13, (float*)(ws + WS_SB13), 2 * FF, FF, 2, itg, scr);
        i8_wg_group(C, inp(C, IN_AWQKV), ws + WS_WQKV, (float*)(ws + WS_SBQKV), 3 * D, 0, 2, itg, scr);
        i8_wg_group(C, inp(C, IN_BWKV), ws + WS_WKV, (float*)(ws + WS_SBKV), 2 * D, 0, 1, itg, scr);
        i8_wg_group(C, inp(C, IN_BWQ), ws + WS_WQ, (float*)(ws + WS_SBQ), D, 0, 2, itg, scr);
        int it = wg * NWAVES + C.wave; const int NTW = C.G * NWAVES;
        tr_group<true>(inp(C, IN_MW2), (bf16*)(ws + WS_MW2), FFE, D, 0, 16, it, NTW, scr, C.lane);
        tr_group<true>(inp(C, IN_W2), (bf16*)(ws + WS_W2), FF, D, 0, 2, it, NTW, scr, C.lane);
        tr_group<true>(inp(C, IN_AWO), (bf16*)(ws + WS_WO), D, D, 0, 2, it, NTW, scr, C.lane);
        tr_group<true>(inp(C, IN_BWO), (bf16*)(ws + WS_WBO), D, D, 0, 2, it, NTW, scr, C.lane);
    }
}

__device__ __forceinline__ void tail_row(v2u (&y)[4], const unsigned char* ws, int ts, int lane) {
    f32x4 p[TAIL_NS][4];
#pragma unroll
    for (int k = 0; k < TAIL_NS; ++k)
#pragma unroll
        for (int j = 0; j < 4; ++j) p[k][j] = ((const GAS f32x4*)((const float*)(ws + WS_YT) + ((size_t)k * TAIL_ROWS + ts) * D) + lane)[64 * j];
#pragma unroll
    for (int j = 0; j < 4; ++j) { f32x4 a = p[0][j];
#pragma unroll
        for (int k = 1; k < TAIL_NS; ++k) a += p[k][j];
        y[j] = (v2u){pk2(a.x, a.y), pk2(a.z, a.w)}; }
}
template <bool COMBINE, bool KV2, bool ROUTER, bool FINAL, bool F8OUT = false, bool XIN_F32 = false>
__device__ __forceinline__ void token_phase(const Ctx& C0, const void* xin, void* xout, const float* gnorm, int off_sh, int off_sc, bf16* XNo, int off_gf, const float* router) {
    const Ctx C = phase_ctx(C0);
    const int gw = C.vcu * NWAVES + C.wave, r0 = gw * 16, b = r0 >> 12, lane = C.lane;
    unsigned char* const ws = wsp(C);
    const float* modb = (const float*)(ws + WS_MOD) + (size_t)b * MODLD;
    const float* kvng = KV2 ? inp(C, IN_KVNG) : nullptr;
    f32x4 A[4], Bv[4], A2[4], B2[4], GF[4];
#pragma unroll
    for (int j = 0; j < 4; ++j) { const int col = 256 * j + 4 * lane;
        const f32x4 g = *(const f32x4*)(gnorm + col);
        if (FINAL) { A[j] = g; Bv[j] = (f32x4){0.f, 0.f, 0.f, 0.f}; }
        else { const f32x4 sc = *(const f32x4*)(modb + off_sc + col); A[j] = g * (sc + 1.0f); Bv[j] = *(const f32x4*)(modb + off_sh + col); }
        if (KV2) { const f32x4 g2 = *(const f32x4*)(kvng + col), sc2 = *(const f32x4*)(modb + KVMOD + D + col); A2[j] = g2 * (sc2 + 1.0f); B2[j] = *(const f32x4*)(modb + KVMOD + col); }
        if (COMBINE) GF[j] = *(const f32x4*)(modb + off_gf + col);
    }
    LAS int* rt = (LAS int*)(C.lds + ROUTE_OFF);
    if (ROUTER) {
        LAS float* rw = (LAS float*)C.lds;
        { float rv[D * NE / (NWAVES * 64)];
#pragma unroll
          for (int q = 0; q < D * NE / (NWAVES * 64); ++q) rv[q] = router[C.tid + q * NWAVES * 64];
#pragma unroll
          for (int q = 0; q < D * NE / (NWAVES * 64); ++q) { const int i = C.tid + q * NWAVES * 64, sl = i >> 2; rw[((sl & ~7) | ((sl & 7) ^ ((sl >> 4) & 7))) * 4 + (i & 3)] = rv[q]; } }
        if (C.tid < 8) rt[RT_HIST + C.tid] = 0;
        __syncthreads();
    }
    int cnt[8];
#pragma unroll
    for (int e = 0; e < 8; ++e) cnt[e] = 0;
    const bf16* Y2 = (const bf16*)(ws + WS_XG);
    const int* tslot = (const int*)(ws + WS_TOKS); const float* tw = (const float*)(ws + WS_TOKW);
    constexpr int RG = 4;
    for (int i0 = 0; i0 < 16; i0 += RG) {
      f32x4 vin[RG][4]; v2u ya_[RG][4], yc_[RG][4]; float w0_[RG], w1_[RG]; int sl0_[RG], sl1_[RG];
#pragma unroll
      for (int rr = 0; rr < RG; ++rr) { const int row = r0 + i0 + rr;
        if (XIN_F32) { const GAS f32x4* xr = (const GAS f32x4*)((const float*)xin + (size_t)row * D) + lane;
#pragma unroll
            for (int j = 0; j < 4; ++j) vin[rr][j] = xr[64 * j];
        } else { const GAS v2u* xr = (const GAS v2u*)((const bf16*)xin + (size_t)row * D) + lane;
#pragma unroll
            for (int j = 0; j < 4; ++j) { const v2u w = xr[64 * j]; vin[rr][j] = (f32x4){bflo(w.x), bfhi(w.x), bflo(w.y), bfhi(w.y)}; } }
        if (COMBINE) {
            const int s0 = tslot[2 * row], s1 = tslot[2 * row + 1]; w0_[rr] = tw[2 * row]; w1_[rr] = tw[2 * row + 1]; sl0_[rr] = __builtin_amdgcn_readfirstlane(s0); sl1_[rr] = __builtin_amdgcn_readfirstlane(s1);
            const GAS v2u* y0 = (const GAS v2u*)(Y2 + (size_t)(s0 < 65536 ? s0 : 0) * D) + lane; const GAS v2u* y1 = (const GAS v2u*)(Y2 + (size_t)(s1 < 65536 ? s1 : 0) * D) + lane;
#pragma unroll
            for (int j = 0; j < 4; ++j) { ya_[rr][j] = y0[64 * j]; yc_[rr][j] = y1[64 * j]; } } }
      if (COMBINE) {
        int anyt = 0;
#pragma unroll
        for (int rr = 0; rr < RG; ++rr) anyt |= (sl0_[rr] | sl1_[rr]) >> 16;
        if (anyt) {
#pragma unroll
            for (int rr = 0; rr < RG; ++rr) {
                if (sl0_[rr] >= 65536) { tail_row(ya_[rr], ws, sl0_[rr] - 65536, lane); asm volatile("" ::: "memory"); }
                if (sl1_[rr] >= 65536) { tail_row(yc_[rr], ws, sl1_[rr] - 65536, lane); asm volatile("" ::: "memory"); } } } }
#pragma unroll
      for (int rr = 0; rr < RG; ++rr) {
        const int row = r0 + i0 + rr;
        f32x4 v[4];
#pragma unroll
        for (int j = 0; j < 4; ++j) v[j] = vin[rr][j];
        if (COMBINE) {
#pragma unroll
            for (int j = 0; j < 4; ++j) { const v2u a = ya_[rr][j], c = yc_[rr][j];
                f32x4 ya = (f32x4){bflo(a.x), bfhi(a.x), bflo(a.y), bfhi(a.y)}, yc = (f32x4){bflo(c.x), bfhi(c.x), bflo(c.y), bfhi(c.y)};
                v[j] = v[j] + GF[j] * (ya * w0_[rr] + yc * w1_[rr]); }
            if (!FINAL) { GAS v2u* xo = (GAS v2u*)((bf16*)xout + (size_t)row * D) + lane;
#pragma unroll
                for (int j = 0; j < 4; ++j) xo[64 * j] = (v2u){pk2(v[j].x, v[j].y), pk2(v[j].z, v[j].w)}; }
        }
        float ss = 0.f;
#pragma unroll
        for (int j = 0; j < 4; ++j) ss += (v[j].x * v[j].x + v[j].y * v[j].y) + (v[j].z * v[j].z + v[j].w * v[j].w);
        const float rstd = 1.0f / sqrtf(wave_sum(ss) * (1.0f / D) + RMS_EPS);
        f32x4 hv[4];
#pragma unroll
        for (int j = 0; j < 4; ++j) hv[j] = (v[j] * rstd) * A[j] + Bv[j];
        if (FINAL) { GAS f32x4* xo = (GAS f32x4*)((float*)xout + (size_t)row * D) + lane;
#pragma unroll
            for (int j = 0; j < 4; ++j) __builtin_nontemporal_store(hv[j], xo + 64 * j);
        } else if (F8OUT) { GAS unsigned* o4 = (GAS unsigned*)((unsigned char*)XNo + (size_t)row * D) + lane;
            float am = 0.f;
#pragma unroll
            for (int j = 0; j < 4; ++j) am = fmaxf(am, fmaxf(fmaxf(fabsf(hv[j].x), fabsf(hv[j].y)), fmaxf(fabsf(hv[j].z), fabsf(hv[j].w))));
            am = wave_max(am); const float inv = am > 0.f ? 127.0f / am : 0.f;
            if (lane == 0) ((float*)(ws + WS_SA))[row] = am * (1.0f / 127.0f);
#pragma unroll
            for (int j = 0; j < 4; ++j) o4[64 * j] = q8b(hv[j].x * inv) | (q8b(hv[j].y * inv) << 8) | (q8b(hv[j].z * inv) << 16) | (q8b(hv[j].w * inv) << 24);
        } else { GAS v2u* o8 = (GAS v2u*)(XNo + (size_t)row * D) + lane;
#pragma unroll
            for (int j = 0; j < 4; ++j) o8[64 * j] = (v2u){pk2(hv[j].x, hv[j].y), pk2(hv[j].z, hv[j].w)}; }
        if (KV2) { GAS unsigned* o4 = (GAS unsigned*)(ws + WS_XN2 + (size_t)row * D) + lane; f32x4 h2[4]; float am = 0.f;
#pragma unroll
            for (int j = 0; j < 4; ++j) { h2[j] = (v[j] * rstd) * A2[j] + B2[j]; am = fmaxf(am, fmaxf(fmaxf(fabsf(h2[j].x), fabsf(h2[j].y)), fmaxf(fabsf(h2[j].z), fabsf(h2[j].w)))); }
            am = wave_max(am); const float inv = am > 0.f ? 127.0f / am : 0.f;
            if (lane == 0) ((float*)(ws + WS_SA2))[row] = am * (1.0f / 127.0f);
#pragma unroll
            for (int j = 0; j < 4; ++j) o4[64 * j] = q8b(h2[j].x * inv) | (q8b(h2[j].y * inv) << 8) | (q8b(h2[j].z * inv) << 16) | (q8b(h2[j].w * inv) << 24); }
        if (ROUTER) {
            const LAS f32x4* rw = (const LAS f32x4*)C.lds;
            f32x4 p0 = (f32x4){0.f, 0.f, 0.f, 0.f}, p1 = p0;
#pragma unroll
            for (int j = 0; j < 4; ++j) { const int col = 256 * j + 4 * lane;
                const LAS f32x4* rq = rw + 2 * col; const int sx = (lane >> 1) & 7;
                p0 += rq[0 ^ sx] * hv[j].x; p1 += rq[1 ^ sx] * hv[j].x; p0 += rq[2 ^ sx] * hv[j].y; p1 += rq[3 ^ sx] * hv[j].y;
                p0 += rq[4 ^ sx] * hv[j].z; p1 += rq[5 ^ sx] * hv[j].z; p0 += rq[6 ^ sx] * hv[j].w; p1 += rq[7 ^ sx] * hv[j].w; }
            float p[8] = {wave_sum(p0.x), wave_sum(p0.y), wave_sum(p0.z), wave_sum(p0.w), wave_sum(p1.x), wave_sum(p1.y), wave_sum(p1.z), wave_sum(p1.w)};
            int e0 = 0; float v0 = p[0];
#pragma unroll
            for (int e = 1; e < 8; ++e) if (p[e] > v0) { v0 = p[e]; e0 = e; }
            int e1 = 0; float v1 = -INFINITY;
#pragma unroll
            for (int e = 0; e < 8; ++e) if (e != e0 && p[e] > v1) { v1 = p[e]; e1 = e; }
            const float w0 = 1.0f / (1.0f + __expf(v1 - v0)), w1 = 1.0f - w0;
            if (lane == 0) { ((int*)(ws + WS_TOKE))[row] = e0 | (e1 << 8); *(f32x2*)((float*)(ws + WS_TOKW) + 2 * row) = (f32x2){w0, w1}; }
#pragma unroll
            for (int e = 0; e < 8; ++e) cnt[e] += (e == e0 || e == e1) ? 1 : 0;
        }
      }
    }
    if (ROUTER) {
        if (lane == 0) {
#pragma unroll
            for (int e = 0; e < 8; ++e) __hip_atomic_fetch_add(rt + RT_HIST + e, cnt[e], __ATOMIC_RELAXED, __HIP_MEMORY_SCOPE_WORKGROUP);
        }
        __syncthreads();
        if (C.tid < 8) ((int*)(ws + WS_HIST))[C.vcu * 8 + C.tid] = rt[RT_HIST + C.tid];
    }
}

__device__ __forceinline__ void route_phase(const Ctx& C0, const bf16* XN) {
    const Ctx C = phase_ctx(C0);
    LAS int* rt = (LAS int*)(C.lds + ROUTE_OFF);
    unsigned char* const ws = wsp(C);
    const int* hist = (const int*)(ws + WS_HIST);
    v4u rowv[16]; float sav = 0.f;
#pragma unroll
    for (int i = 0; i < 16; ++i) { const int t2 = 128 * C.vcu + 16 * C.wave + i; rowv[i] = ((const GAS v4u*)((const unsigned char*)XN + (size_t)t2 * D))[C.lane]; }
    if (C.lane < 16) sav = ((const GAS float*)(ws + WS_SA))[128 * C.vcu + 16 * C.wave + C.lane];
    const int tok = 128 * C.vcu + (C.tid & 127);
    int e0 = -1, e1 = -1; if (C.tid < 128) { const int ee = ((const int*)(ws + WS_TOKE))[tok]; e0 = ee & 255; e1 = ee >> 8; }
    { const int e = C.wave; int tot = 0, pre = 0;
#pragma unroll
      for (int i = 0; i < 4; ++i) { const int wg = C.lane + 64 * i; const int v = hist[wg * 8 + e]; tot += v; pre += (wg < C.vcu) ? v : 0; }
      tot = wave_isum(tot); pre = wave_isum(pre);
      if (C.lane == 0) { rt[RT_CNT + e] = tot; rt[RT_BASE + e] = pre; } }
    __syncthreads();
    { int tp[9]; tp[0] = 0;
#pragma unroll
        for (int e = 0; e < 8; ++e) tp[e + 1] = tp[e] + ((rt[RT_CNT + e] + 255) >> 8);
        if (C.tid < 9) { int v = 0;
#pragma unroll
            for (int e = 0; e < 9; ++e) v = (C.tid == e) ? tp[e] : v;
            rt[RT_SEG + C.tid] = v * 256; }
        if (C.tid == 9) rt[RT_NT] = tp[8] < MAXTILES ? tp[8] : MAXTILES;
        if (C.tid < MAXTILES && C.tid < tp[8]) { int e = 0;
#pragma unroll
            for (int k = 1; k < 8; ++k) e += (C.tid >= tp[k]) ? 1 : 0;
            rt[RT_TEXP + C.tid] = e; } }
    __syncthreads();
    unsigned long long bal[8];
#pragma unroll
    for (int e = 0; e < 8; ++e) bal[e] = __ballot((e0 == e) || (e1 == e));
    if (C.tid == 0) {
#pragma unroll
        for (int e = 0; e < 8; ++e) rt[RT_WC + e] = __popcll(bal[e]);
    }
    __syncthreads();
    if (C.tid < 128) { int s0 = 0, s1 = 0; const unsigned long long lt = (1ull << C.lane) - 1ull;
#pragma unroll
        for (int e = 0; e < 8; ++e) { const int slot = rt[RT_SEG + e] + rt[RT_BASE + e] + __popcll(bal[e] & lt) + (C.wave == 1 ? rt[RT_WC + e] : 0); if (e0 == e) s0 = slot; if (e1 == e) s1 = slot; }
        ((int*)(ws + WS_TOKS))[2 * tok] = s0; ((int*)(ws + WS_TOKS))[2 * tok + 1] = s1; rt[RT_LS + 2 * C.tid] = s0; rt[RT_LS + 2 * C.tid + 1] = s1; }
    __syncthreads();
    bf16* XG = (bf16*)(ws + WS_XG);
#pragma unroll
    for (int i = 0; i < 16; ++i) { const int tl = 16 * C.wave + i; const int s0 = rt[RT_LS + 2 * tl], s1 = rt[RT_LS + 2 * tl + 1];
        ((GAS v4u*)((unsigned char*)XG + (size_t)s0 * D))[C.lane] = rowv[i]; ((GAS v4u*)((unsigned char*)XG + (size_t)s1 * D))[C.lane] = rowv[i]; }
    if (C.lane < 16) { const int tl = 16 * C.wave + C.lane; ((GAS float*)(ws + WS_SAG))[rt[RT_LS + 2 * tl]] = sav; ((GAS float*)(ws + WS_SAG))[rt[RT_LS + 2 * tl + 1]] = sav; }
}

__device__ __forceinline__ void kmean_phase(const Ctx& C0, const bf16* Kb) {
    const Ctx C = phase_ctx(C0);
    const int gw = C.vcu * NWAVES + C.wave;
    if (gw < 1024) { const int cb = gw & 7, n = (gw >> 3) & 15, b = gw >> 7;
        const GAS unsigned* kp = (const GAS unsigned*)(Kb + ((size_t)(b * SEQ + 256 * n)) * D + 128 * cb) + C.lane; float s0 = 0.f, s1 = 0.f;
#pragma unroll 16
        for (int i = 0; i < 256; ++i) { const unsigned w = kp[(size_t)i * (D / 2)]; s0 += bflo(w); s1 += bfhi(w); }
        const int col = 128 * cb + 2 * C.lane, h = col >> 6, d = col & 63;
        float* km = (float*)(wsp(C) + WS_KMEAN) + ((size_t)((b * NH + h) * 16 + n)) * 64 + d; km[0] = s0 * (1.f / 256.f); km[1] = s1 * (1.f / 256.f); }
}


namespace att {
typedef short bf16x8 __attribute__((ext_vector_type(8)));
typedef float f32x16 __attribute__((ext_vector_type(16)));
typedef short v4i16_t __attribute__((ext_vector_type(4)));
__device__ __forceinline__ unsigned cvtpk(float lo, float hi) { typedef float f2 __attribute__((ext_vector_type(2))); typedef __bf16 b2 __attribute__((ext_vector_type(2))); const f2 v = {lo, hi}; const b2 b = __builtin_convertvector(v, b2); return __builtin_bit_cast(unsigned, b); }
__device__ __forceinline__ float swap32(float x, int hi) { auto rr = __builtin_amdgcn_permlane32_swap(__float_as_uint(x), __float_as_uint(x), false, false); return __uint_as_float(hi ? rr[0] : rr[1]); }
__device__ __forceinline__ void dma_k_piece(const bf16* Kh, int kv0, int piece, LAS unsigned char* kslot, int lane) {
    const int row = 8 * piece + (lane >> 3);
    const bf16* src = Kh + (size_t)(kv0 + row) * D + ((lane & 7) ^ ((row >> 1) & 7)) * 8;
    __builtin_amdgcn_global_load_lds((const unsigned*)src, (LAS unsigned*)(kslot + piece * 1024), 16, 0, 0); }
__device__ __forceinline__ void dma_v_piece(const bf16* Vh, int kv0, int piece, LAS unsigned char* vslot, int lane) {
    const int row = 8 * piece + (lane >> 3);
    const bf16* src = Vh + (size_t)(kv0 + row) * D + ((lane & 7) ^ (((row >> 1) & 1) << 2)) * 8;
    __builtin_amdgcn_global_load_lds((const unsigned*)src, (LAS unsigned*)(vslot + piece * 1024), 16, 0, 0); }
__device__ __forceinline__ int kfrag_off(int d0, int r32, int hi) { return 128 * r32 + 16 * ((2 * d0 + hi) ^ ((r32 >> 1) & 7)); }
__device__ __forceinline__ void qkt(f32x16& p0, f32x16& p1, const LAS unsigned char* kslot, const bf16x8 (&qr)[4], int r32, int hi) {
    p0 = (f32x16){0.f, 0.f, 0.f, 0.f, 0.f, 0.f, 0.f, 0.f, 0.f, 0.f, 0.f, 0.f, 0.f, 0.f, 0.f, 0.f}; p1 = p0;
    bf16x8 kf[8];
#pragma unroll
    for (int d0 = 0; d0 < 4; ++d0) { const LAS unsigned char* kb = kslot + kfrag_off(d0, r32, hi); kf[2 * d0] = *(const LAS bf16x8*)(kb); kf[2 * d0 + 1] = *(const LAS bf16x8*)(kb + 4096); }
#pragma unroll
    for (int d0 = 0; d0 < 4; ++d0) { p0 = __builtin_amdgcn_mfma_f32_32x32x16_bf16(kf[2 * d0], qr[d0], p0, 0, 0, 0); p1 = __builtin_amdgcn_mfma_f32_32x32x16_bf16(kf[2 * d0 + 1], qr[d0], p1, 0, 0, 0); }
}
__device__ __forceinline__ v4i16_t vtr(const LAS unsigned char* p) { return __builtin_amdgcn_ds_read_tr16_b64_v4i16((LAS v4i16_t*)p); }
__device__ __forceinline__ void pvt(f32x16 (&o)[2], const LAS unsigned char* vslot, int lane, const v4u (&pw)[4]) {
    const int r = (lane & 15) >> 2, f = (r >> 1) & 1;
    const LAS unsigned char* vb0 = vslot + (4 * (lane >> 5) + r) * 128 + f * 64 + ((lane >> 4) & 1) * 32 + (lane & 3) * 8;
    const LAS unsigned char* vb1 = vslot + (4 * (lane >> 5) + r) * 128 + (f ^ 1) * 64 + ((lane >> 4) & 1) * 32 + (lane & 3) * 8;
    v4i16_t lo[8], hh[8];
#pragma unroll
    for (int i = 0; i < 4; ++i) { lo[i] = vtr(vb0 + i * 2048); hh[i] = vtr(vb0 + i * 2048 + 1024); lo[4 + i] = vtr(vb1 + i * 2048); hh[4 + i] = vtr(vb1 + i * 2048 + 1024); }
#pragma unroll
    for (int i = 0; i < 8; ++i) { const bf16x8 vf = (bf16x8){lo[i][0], lo[i][1], lo[i][2], lo[i][3], hh[i][0], hh[i][1], hh[i][2], hh[i][3]};
        o[i >> 2] = __builtin_amdgcn_mfma_f32_32x32x16_bf16(vf, __builtin_bit_cast(bf16x8, pw[i & 3]), o[i >> 2], 0, 0, 0); }
}
__device__ __forceinline__ void pack_p(v4u (&pw)[4], const f32x16& p0, const f32x16& p1) {
#pragma unroll
    for (int i = 0; i < 4; ++i) { pw[0][i] = cvtpk(p0[2 * i], p0[2 * i + 1]); pw[1][i] = cvtpk(p0[8 + 2 * i], p0[9 + 2 * i]); pw[2][i] = cvtpk(p1[2 * i], p1[2 * i + 1]); pw[3][i] = cvtpk(p1[8 + 2 * i], p1[9 + 2 * i]); }
}
__device__ __forceinline__ void store_o(bf16* Orow  , const f32x16 (&o)[2], float scale, int hi) {
#pragma unroll
    for (int dh = 0; dh < 2; ++dh)
#pragma unroll
        for (int gp = 0; gp < 2; ++gp) { float na[4], nb[4];
#pragma unroll
            for (int e = 0; e < 4; ++e) { auto rr = __builtin_amdgcn_permlane32_swap(__float_as_uint(o[dh][8 * gp + e] * scale), __float_as_uint(o[dh][8 * gp + 4 + e] * scale), false, false); na[e] = __uint_as_float(rr[0]); nb[e] = __uint_as_float(rr[1]); }
            const v4u w = (v4u){cvtpk(na[0], na[1]), cvtpk(na[2], na[3]), cvtpk(nb[0], nb[1]), cvtpk(nb[2], nb[3])};
            *(GAS v4u*)(Orow + 32 * dh + 8 * (2 * gp + hi)) = w; }
}
constexpr int BT_DMAX = 1119, BT_LEN = BT_DMAX + 1 + BT_PAD, BT_CS = 1424;
static_assert(BT_CS >= BT_LEN + 4 && BT_CS % 64 == 16, "bias table copies");
__device__ __forceinline__ const LAS float* bias_ptr(const LAS float* bt, int qrow, int hi, int tile) {
    const int jb = BT_DMAX - qrow + 64 * tile + 4 * hi, m = jb & 3, jc = jb > m ? jb : m;
    return bt + m * BT_CS - m + jc; }
__device__ __forceinline__ void store_o8(unsigned char* Orow  , const f32x16 (&o)[2], float scale, int hi) {
#pragma unroll
    for (int dh = 0; dh < 2; ++dh)
#pragma unroll
        for (int gp = 0; gp < 2; ++gp) { float na[4], nb[4];
#pragma unroll
            for (int e = 0; e < 4; ++e) { auto rr = __builtin_amdgcn_permlane32_swap(__float_as_uint(o[dh][8 * gp + e] * scale), __float_as_uint(o[dh][8 * gp + 4 + e] * scale), false, false); na[e] = __uint_as_float(rr[0]); nb[e] = __uint_as_float(rr[1]); }
            const v2u w = (v2u){pg8::pk4_fp8(na[0], na[1], na[2], na[3]), pg8::pk4_fp8(nb[0], nb[1], nb[2], nb[3])};
            *(GAS v2u*)(Orow + 32 * dh + 8 * (2 * gp + hi)) = w; }
}
}

#define MOBA_WAITBAR(N) do { if (!(VAR & 1)) asm volatile("s_waitcnt vmcnt(" #N ") lgkmcnt(0)\n\ts_barrier" ::: "memory"); } while (0)
__device__ __forceinline__ float vmax3(float a, float b, float c) { float r; asm("v_max3_f32 %0, %1, %2, %3" : "=v"(r) : "v"(a), "v"(b), "v"(c)); return r; }
__device__ __forceinline__ float vadd(float a, float b) { float r; asm("v_add_f32_e32 %0, %1, %2" : "=v"(r) : "v"(a), "v"(b)); return r; }
__device__ __forceinline__ float vmax(float a, float b) { float r; asm("v_max_f32_e32 %0, %1, %2" : "=v"(r) : "v"(a), "v"(b)); return r; }
__device__ __forceinline__ float vmul(float a, float b) { float r; asm("v_mul_f32_e32 %0, %1, %2" : "=v"(r) : "v"(a), "v"(b)); return r; }
#define MSB() __builtin_amdgcn_sched_barrier(0)
#define ME4(X, i) do { if (VAR & 8) break; X[i] = ex2(X[i]); X[(i) + 1] = ex2(X[(i) + 1]); X[(i) + 2] = ex2(X[(i) + 2]); X[(i) + 3] = ex2(X[(i) + 3]); } while (0)
#define MC2(W, j, X, i) do { if (VAR & 8) break; W[j] = att::cvtpk(X[i], X[(i) + 1]); W[(j) + 1] = att::cvtpk(X[(i) + 2], X[(i) + 3]); } while (0)
#define MMF(a, b, c) ((VAR & 4) ? (c) : __builtin_amdgcn_mfma_f32_32x32x16_bf16(a, b, c, 0, 0, 0))
template <int VAR>
__device__ __forceinline__ void moba_step(att::f32x16& A0, att::f32x16& A1, att::f32x16& B0, att::f32x16& B1, int s, int NT, int u, int wid, int lane, int qrow, unsigned selmask,
                                          float& mref, float& l, att::f32x16 (&o)[2], const LAS unsigned char* lds, const LAS float* bt, const att::bf16x8 (&qr)[4], att::bf16x8 (&kf)[8]) {
    const int r32 = lane & 31, hi = lane >> 5;
    const int s1 = (s + 1 < NT) ? s + 1 : s;
    const int t1 = (s1 < 4) ? 4 * u + s1 : s1 - 4;
    const bool mine = (s1 < 4) ? (2 * s1 <= wid) : (((selmask >> (t1 >> 2)) & 1u) != 0u);
    const unsigned q0w = hi ? 0u : (mine ? (__float_as_uint(-mref) >> 16) : 0xFF80u), k0w = hi ? 0u : 0x3F80u;
    const att::bf16x8 qaug = __builtin_bit_cast(att::bf16x8, (v4u){q0w, 0u, 0u, 0u}), kone = __builtin_bit_cast(att::bf16x8, (v4u){k0w, 0u, 0u, 0u});
    const LAS unsigned char* vsl = lds + (s % 5) * 16384 + 8192;
    const int s2 = (s + 2 < NT) ? s + 2 : NT - 1, t2 = (s2 < 4) ? 4 * u + s2 : s2 - 4;
    const LAS unsigned char* ksl2 = lds + (s2 % 5) * 16384;
    const LAS float* bp2 = att::bias_ptr(bt, qrow, hi, t2); asm volatile("" : "+v"(bp2));
#define MBL(g) do { const f32x4 x0_ = *(const LAS f32x4*)(bp2 + 8 * (g)), x1_ = *(const LAS f32x4*)(bp2 + 32 + 8 * (g)); \
        A0[4 * (g)] = x0_.x; A0[4 * (g) + 1] = x0_.y; A0[4 * (g) + 2] = x0_.z; A0[4 * (g) + 3] = x0_.w; A1[4 * (g)] = x1_.x; A1[4 * (g) + 1] = x1_.y; A1[4 * (g) + 2] = x1_.z; A1[4 * (g) + 3] = x1_.w; } while (0)
#define MKL(d0) do { const LAS unsigned char* kb_ = ksl2 + att::kfrag_off(d0, r32, hi); kf[2 * (d0)] = *(const LAS att::bf16x8*)(kb_); kf[2 * (d0) + 1] = *(const LAS att::bf16x8*)(kb_ + 4096); } while (0)
    const int vr = (lane & 15) >> 2, vf_ = (vr >> 1) & 1;
    const LAS unsigned char* vb0 = vsl + (4 * hi + vr) * 128 + vf_ * 64 + ((lane >> 4) & 1) * 32 + (lane & 3) * 8;
    const LAS unsigned char* vb1 = vsl + (4 * hi + vr) * 128 + (vf_ ^ 1) * 64 + ((lane >> 4) & 1) * 32 + (lane & 3) * 8;
    asm volatile("" : "+v"(vb0), "+v"(vb1));
    att::v4i16_t lo[8], hh[8]; v4u pw[4];
    MSB();
    B0 = MMF(kf[0], qr[0], B0); ME4(A0, 0);  MC2(pw[0], 0, A0, 0);  MSB();
    B1 = MMF(kf[1], qr[0], B1); ME4(A0, 4);  MC2(pw[0], 2, A0, 4);  MSB();
    B0 = MMF(kf[2], qr[1], B0); ME4(A0, 8);  MC2(pw[1], 0, A0, 8);  MSB();
    B1 = MMF(kf[3], qr[1], B1); ME4(A0, 12); MC2(pw[1], 2, A0, 12); MSB();
    B0 = MMF(kf[4], qr[2], B0); ME4(A1, 0);  MC2(pw[2], 0, A1, 0);  lo[0] = att::vtr(vb0); hh[0] = att::vtr(vb0 + 1024); lo[1] = att::vtr(vb0 + 2048); hh[1] = att::vtr(vb0 + 3072); MSB();
    B1 = MMF(kf[5], qr[2], B1); ME4(A1, 4);  MC2(pw[2], 2, A1, 4);  lo[2] = att::vtr(vb0 + 4096); hh[2] = att::vtr(vb0 + 5120); lo[3] = att::vtr(vb0 + 6144); hh[3] = att::vtr(vb0 + 7168); MSB();
    B0 = MMF(kf[6], qr[3], B0); ME4(A1, 8);  MC2(pw[3], 0, A1, 8);  lo[4] = att::vtr(vb1); hh[4] = att::vtr(vb1 + 1024); lo[5] = att::vtr(vb1 + 2048); hh[5] = att::vtr(vb1 + 3072); MSB();
    B1 = MMF(kf[7], qr[3], B1); ME4(A1, 12); MC2(pw[3], 2, A1, 12); lo[6] = att::vtr(vb1 + 4096); hh[6] = att::vtr(vb1 + 5120); lo[7] = att::vtr(vb1 + 6144); hh[7] = att::vtr(vb1 + 7168); MSB();
    B0 = MMF(kone, qaug, B0); MSB();
    B1 = MMF(kone, qaug, B1); MSB();
#define MVF(i) (att::bf16x8){lo[i][0], lo[i][1], lo[i][2], lo[i][3], hh[i][0], hh[i][1], hh[i][2], hh[i][3]}
#define MPW(k) __builtin_bit_cast(att::bf16x8, pw[k])
    float la, lb, lc, ld, ma, mb, mc, md;
    o[0] = MMF(MVF(0), MPW(0), o[0]); la = vadd(A0[0], A0[1]); lb = vadd(A1[0], A1[1]); lc = vadd(A0[2], A0[3]); ld = vadd(A1[2], A1[3]); la = vadd(la, A0[4]); lb = vadd(lb, A1[4]); MSB();
    o[0] = MMF(MVF(1), MPW(1), o[0]); lc = vadd(lc, A0[5]); ld = vadd(ld, A1[5]); la = vadd(la, A0[6]); lb = vadd(lb, A1[6]); lc = vadd(lc, A0[7]); ld = vadd(ld, A1[7]); la = vadd(la, A0[8]); lb = vadd(lb, A1[8]); MSB();
    o[0] = MMF(MVF(2), MPW(2), o[0]); lc = vadd(lc, A0[9]); ld = vadd(ld, A1[9]); la = vadd(la, A0[10]); lb = vadd(lb, A1[10]); lc = vadd(lc, A0[11]); ld = vadd(ld, A1[11]); la = vadd(la, A0[12]); lb = vadd(lb, A1[12]); MSB();
    o[0] = MMF(MVF(3), MPW(3), o[0]); lc = vadd(lc, A0[13]); ld = vadd(ld, A1[13]); la = vadd(la, A0[14]); lb = vadd(lb, A1[14]); lc = vadd(lc, A0[15]); ld = vadd(ld, A1[15]); la = vadd(la, lc); lb = vadd(lb, ld); MSB();
    o[1] = MMF(MVF(4), MPW(0), o[1]); MKL(0); MBL(0); ma = vmax3(B0[0], B0[1], B0[2]); mb = vmax3(B1[0], B1[1], B1[2]); mc = vmax3(B0[3], B0[4], B0[5]); md = vmax3(B1[3], B1[4], B1[5]); MSB();
    o[1] = MMF(MVF(5), MPW(1), o[1]); MKL(1); MBL(1); ma = vmax3(ma, B0[6], B0[7]); mb = vmax3(mb, B1[6], B1[7]); mc = vmax3(mc, B0[8], B0[9]); md = vmax3(md, B1[8], B1[9]); MSB();
    o[1] = MMF(MVF(6), MPW(2), o[1]); MKL(2); MBL(2); ma = vmax3(ma, B0[10], B0[11]); mb = vmax3(mb, B1[10], B1[11]); mc = vmax3(mc, B0[12], B0[13]); md = vmax3(md, B1[12], B1[13]); MSB();
    o[1] = MMF(MVF(7), MPW(3), o[1]); MKL(3); MBL(3); ma = vmax3(ma, B0[14], B0[15]); mb = vmax3(mb, B1[14], B1[15]); ma = vmax3(ma, mc, md); MSB();
#undef MVF
#undef MPW
#undef MBL
#undef MKL
    l += vadd(la, lb);
    float mx = vmax(ma, mb); mx = vmax(mx, att::swap32(mx, hi));
    const bool mv = mx > 8.0f;
    if (__any(mv)) {
        const float nref = mv ? __uint_as_float((__float_as_uint(mref + mx) + 0x8000u) & 0xffff0000u) : mref, d = nref - mref, f = ex2(-d); mref = nref; l *= f;
#pragma unroll
        for (int r = 0; r < 16; ++r) { o[0][r] *= f; o[1][r] *= f; B0[r] -= d; B1[r] -= d; } }
}
template <int VAR>
__device__ __forceinline__ void moba_phase(const Ctx& C0, const bf16* Q, const bf16* Kb, const bf16* Vb, bf16* O) {
    const Ctx C = phase_ctx(C0);
    const int lane = C.lane, r32 = lane & 31, hi = lane >> 5, wid = C.wave;
    unsigned char* const ws = wsp(C);
    const float* kmean = (const float*)(ws + WS_KMEAN); const float* btab = (const float*)(ws + WS_BIAS);
    LAS unsigned char* lds = C.lds;
    LAS float* bt = (LAS float*)(lds + 81920);
    const int bh = C.vcu >> 1, b = bh >> 4, h = bh & 15;
    { constexpr int NQ = (4 * att::BT_CS + NWAVES * 64 - 1) / (NWAVES * 64); float bv[NQ];
#pragma unroll
      for (int q = 0; q < NQ; ++q) { const int i = C.tid + q * NWAVES * 64, m = i / att::BT_CS, j = i - m * att::BT_CS + m, d = att::BT_DMAX - j;
          bv[q] = (i >= 4 * att::BT_CS || j >= att::BT_LEN || d < 0) ? -INFINITY : btab[h * 1024 + (d > 1023 ? 1023 : d)]; }
#pragma unroll
      for (int q = 0; q < NQ; ++q) { const int i = C.tid + q * NWAVES * 64; if (i < 4 * att::BT_CS) bt[i] = bv[q]; } }
    const bf16* Kh = Kb + (size_t)b * SEQ * D + h * HD; const bf16* Vh = Vb + (size_t)b * SEQ * D + h * HD;
    LAS float* kml = (LAS float*)(lds + 81920 + 4 * att::BT_CS * 4);
#pragma unroll 1
    for (int nn = 0; nn < 2; ++nn) { const int n = 2 * wid + nn; const GAS v4u* kp = (const GAS v4u*)(Kh + (size_t)(256 * n + (lane >> 3)) * D) + (lane & 7); float sk[8];
#pragma unroll
        for (int j = 0; j < 8; ++j) sk[j] = 0.f;
#pragma unroll 32
        for (int i = 0; i < 32; ++i) { const v4u w = kp[(size_t)i * (8 * D / 8)];
            sk[0] += bflo(w.x); sk[1] += bfhi(w.x); sk[2] += bflo(w.y); sk[3] += bfhi(w.y); sk[4] += bflo(w.z); sk[5] += bfhi(w.z); sk[6] += bflo(w.w); sk[7] += bfhi(w.w); }
#pragma unroll
        for (int j = 0; j < 8; ++j) { float t = sk[j]; t += dppf<DPP_X8>(t); sk[j] = sum32x(sum16x(t)); }
        if (lane < 8) {
#pragma unroll
            for (int j = 0; j < 8; ++j) kml[n * 64 + 8 * lane + j] = sk[j] * (1.f / 256.f); } }
    __syncthreads();
    for (int iu = 0; iu < 8; ++iu) {
        const int sidx0 = 4 * (C.vcu & 1) + (iu >> 1), u = (iu & 1) ? 15 - sidx0 : sidx0;
        const int qrow = 256 * u + 32 * wid + r32, tok = b * SEQ + qrow;
#define MOBA_TILE(s) (((s) < 4) ? 4 * u + (s) : (s) - 4)
#define MOBA_DMA(s) do { if (VAR & 2) break; const int t_ = MOBA_TILE(s); att::dma_k_piece(Kh, 64 * t_, wid, lds + ((s) % 5) * 16384, lane); att::dma_v_piece(Vh, 64 * t_, wid, lds + ((s) % 5) * 16384 + 8192, lane); } while (0)
        MOBA_DMA(0); MOBA_DMA(1); MOBA_DMA(2); MOBA_DMA(3);
        att::bf16x8 qr[4];
#pragma unroll
        for (int d0 = 0; d0 < 4; ++d0) qr[d0] = *(const GAS att::bf16x8*)(Q + (size_t)tok * D + h * HD + d0 * 16 + hi * 8);
        unsigned selmask = 0;
        if (u <= 3) selmask = (1u << u) - 1u;
        else {
            const LAS float* km = kml + 8 * hi;
            float g[15];
#pragma unroll
            for (int n = 0; n < 15; ++n) {
                if (n < u) { float s = 0.f;
#pragma unroll
                    for (int d0 = 0; d0 < 4; ++d0) { const f32x4 a = *(const LAS f32x4*)(km + n * 64 + 16 * d0), c = *(const LAS f32x4*)(km + n * 64 + 16 * d0 + 4);
                        s += __uint_as_float((unsigned)(unsigned short)qr[d0][0] << 16) * a.x; s += __uint_as_float((unsigned)(unsigned short)qr[d0][1] << 16) * a.y;
                        s += __uint_as_float((unsigned)(unsigned short)qr[d0][2] << 16) * a.z; s += __uint_as_float((unsigned)(unsigned short)qr[d0][3] << 16) * a.w;
                        s += __uint_as_float((unsigned)(unsigned short)qr[d0][4] << 16) * c.x; s += __uint_as_float((unsigned)(unsigned short)qr[d0][5] << 16) * c.y;
                        s += __uint_as_float((unsigned)(unsigned short)qr[d0][6] << 16) * c.z; s += __uint_as_float((unsigned)(unsigned short)qr[d0][7] << 16) * c.w; }
                    g[n] = s + att::swap32(s, hi);
                } else g[n] = -INFINITY;
            }
#pragma unroll
            for (int r = 0; r < 3; ++r) { float best = -INFINITY; int bi = 0;
#pragma unroll
                for (int n = 0; n < 15; ++n) if (!((selmask >> n) & 1u) && g[n] > best) { best = g[n]; bi = n; }
                selmask |= 1u << bi; }
        }
        const int NT = 4 * u + 4;
        float mref = 0.f, l = 0.f; att::f32x16 o[2];
#pragma unroll
        for (int r = 0; r < 16; ++r) { o[0][r] = 0.f; o[1][r] = 0.f; }
        att::f32x16 a0, a1, b0, b1;
        att::bf16x8 kfn[8];
        MOBA_WAITBAR(4);
        {
            const LAS float* bp = att::bias_ptr(bt, qrow, hi, 4 * u); asm volatile("" : "+v"(bp));
#pragma unroll
            for (int g = 0; g < 4; ++g) { const f32x4 x0 = *(const LAS f32x4*)(bp + 8 * g), x1 = *(const LAS f32x4*)(bp + 32 + 8 * g);
                a0[4 * g] = x0.x; a0[4 * g + 1] = x0.y; a0[4 * g + 2] = x0.z; a0[4 * g + 3] = x0.w; a1[4 * g] = x1.x; a1[4 * g + 1] = x1.y; a1[4 * g + 2] = x1.z; a1[4 * g + 3] = x1.w; }
            att::bf16x8 kf[8];
#pragma unroll
            for (int d0 = 0; d0 < 4; ++d0) { const LAS unsigned char* kb = lds + att::kfrag_off(d0, r32, hi); kf[2 * d0] = *(const LAS att::bf16x8*)(kb); kf[2 * d0 + 1] = *(const LAS att::bf16x8*)(kb + 4096); }
#pragma unroll
            for (int d0 = 0; d0 < 4; ++d0) { a0 = MMF(kf[2 * d0], qr[d0], a0); a1 = MMF(kf[2 * d0 + 1], qr[d0], a1); }
            float mx = fmaxf(a0[0], a1[0]);
#pragma unroll
            for (int r = 1; r < 16; ++r) mx = fmaxf(mx, fmaxf(a0[r], a1[r]));
            mx = fmaxf(mx, att::swap32(mx, hi));
            mref = __uint_as_float((__float_as_uint(mx) + 0x8000u) & 0xffff0000u);
#pragma unroll
            for (int r = 0; r < 16; ++r) { a0[r] -= mref; a1[r] -= mref; }
            MSB();
            const LAS float* bq = att::bias_ptr(bt, qrow, hi, 4 * u + 1); asm volatile("" : "+v"(bq));
#pragma unroll
            for (int g = 0; g < 4; ++g) { const f32x4 x0 = *(const LAS f32x4*)(bq + 8 * g), x1 = *(const LAS f32x4*)(bq + 32 + 8 * g);
                b0[4 * g] = x0.x; b0[4 * g + 1] = x0.y; b0[4 * g + 2] = x0.z; b0[4 * g + 3] = x0.w; b1[4 * g] = x1.x; b1[4 * g + 1] = x1.y; b1[4 * g + 2] = x1.z; b1[4 * g + 3] = x1.w; }
#pragma unroll
            for (int d0 = 0; d0 < 4; ++d0) { const LAS unsigned char* kb = lds + 16384 + att::kfrag_off(d0, r32, hi); kfn[2 * d0] = *(const LAS att::bf16x8*)(kb); kfn[2 * d0 + 1] = *(const LAS att::bf16x8*)(kb + 4096); }
        }
        for (int s = 0; s < NT; s += 2) {
            if (s + 3 < NT) MOBA_WAITBAR(2); else MOBA_WAITBAR(0);
            if (s + 4 < NT) MOBA_DMA(s + 4);
            moba_step<VAR>(a0, a1, b0, b1, s, NT, u, wid, lane, qrow, selmask, mref, l, o, lds, bt, qr, kfn);
            if (s + 4 < NT) MOBA_WAITBAR(2); else MOBA_WAITBAR(0);
            if (s + 5 < NT) MOBA_DMA(s + 5);
            moba_step<VAR>(b0, b1, a0, a1, s + 1, NT, u, wid, lane, qrow, selmask, mref, l, o, lds, bt, qr, kfn);
        }
        l += att::swap32(l, hi);
        att::store_o8((unsigned char*)O + (size_t)tok * D + h * HD, o, OSCALE8 / l, hi);
        MOBA_WAITBAR(0);
    }
#undef MOBA_TILE
#undef MOBA_DMA
}

template <int SVAR>
__device__ __forceinline__ void sb_phase(const Ctx& C0, const bf16* Q, const bf16* Kb, const bf16* Vb, bf16* O) {
    const Ctx C = phase_ctx(C0);
    const int lane = C.lane, r32 = lane & 31, hi = lane >> 5, wid = C.wave;
    LAS unsigned char* wbuf = C.lds + wid * 16384;
    const int gw = C.vcu * NWAVES + wid;
    const int vr = (lane & 15) >> 2, vf_ = (vr >> 1) & 1;
    const int voff0 = (4 * hi + vr) * 128 + vf_ * 64 + ((lane >> 4) & 1) * 32 + (lane & 3) * 8, voff1 = (4 * hi + vr) * 128 + (vf_ ^ 1) * 64 + ((lane >> 4) & 1) * 32 + (lane & 3) * 8;
    for (int iu = 0; iu < 8; ++iu) {
        const int U = (C.vcu * 8 + iu) * NWAVES + wid, bh = U >> 7, qt = U & 127, b = bh >> 4, h = bh & 15;
        const int t = 32 * qt + r32, tok = b * SEQ + t;
        const bf16* Kh = Kb + (size_t)b * SEQ * D + h * HD; const bf16* Vh = Vb + (size_t)b * SEQ * D + h * HD;
#define SB_DMA(tk_, p_) do { _Pragma("unroll") for (int pc = 0; pc < 4; ++pc) att::dma_k_piece(Kh, 32 * (tk_), pc, wbuf + (p_) * 8192, lane); \
                             _Pragma("unroll") for (int pc = 0; pc < 4; ++pc) att::dma_v_piece(Vh, 32 * (tk_), pc, wbuf + (p_) * 8192 + 4096, lane); } while (0)
        asm volatile("s_waitcnt lgkmcnt(0)" ::: "memory");
        SB_DMA(qt, 0);
        att::bf16x8 qr[4];
#pragma unroll
        for (int d0 = 0; d0 < 4; ++d0) qr[d0] = *(const GAS att::bf16x8*)(Q + (size_t)tok * D + h * HD + d0 * 16 + hi * 8);
        float L = 1.f; att::f32x16 o[2];
#pragma unroll
        for (int r = 0; r < 16; ++r) { o[0][r] = 0.f; o[1][r] = 0.f; }
        int p = 0;
        for (int tk = qt; tk >= 0; --tk) {
            if (tk > 0) { asm volatile("s_waitcnt lgkmcnt(0)" ::: "memory"); SB_DMA(tk - 1, p ^ 1); asm volatile("s_waitcnt vmcnt(8)" ::: "memory"); }
            else asm volatile("s_waitcnt vmcnt(0)" ::: "memory");
            const LAS unsigned char* kslot = wbuf + p * 8192; const LAS unsigned char* vslot = kslot + 4096;
            att::bf16x8 kf[4];
#pragma unroll
            for (int d0 = 0; d0 < 4; ++d0) kf[d0] = *(const LAS att::bf16x8*)(kslot + att::kfrag_off(d0, r32, hi));
            att::f32x16 z;
#pragma unroll
            for (int r = 0; r < 16; ++r) z[r] = 0.f;
#pragma unroll
            for (int d0 = 0; d0 < 4; ++d0) z = __builtin_amdgcn_mfma_f32_32x32x16_bf16(kf[d0], qr[d0], z, 0, 0, 0);
            att::f32x16 s;
#pragma unroll
            for (int r = 0; r < 16; ++r) { const float e = ex2(z[r]); s[r] = __builtin_amdgcn_rcpf(1.0f + e); z[r] = 1.0f - s[r]; }
            if (tk == qt) { const int lim = r32 - 4 * hi;
#pragma unroll
                for (int r = 0; r < 16; ++r) { const int ko = (r & 3) + 8 * (r >> 2); if (!(ko < lim)) { s[r] = 1.f; z[r] = 0.f; } } }
            __builtin_amdgcn_sched_barrier(0);
            float Gs[4], E[4], T[4], EG[4];
#pragma unroll
            for (int gq = 0; gq < 4; ++gq) Gs[gq] = vmul(vmul(s[4 * gq], s[4 * gq + 1]), vmul(s[4 * gq + 2], s[4 * gq + 3]));
            E[3] = 1.f; E[2] = Gs[3]; E[1] = vmul(E[2], Gs[2]); E[0] = vmul(E[1], Gs[1]);
            EG[3] = Gs[3]; EG[2] = E[1]; EG[1] = E[0]; EG[0] = vmul(E[0], Gs[0]);
#pragma unroll
            for (int gq = 0; gq < 3; ++gq) T[gq] = vmul(E[gq], att::swap32(hi ? EG[gq] : E[gq], hi));
            T[3] = att::swap32(hi ? EG[3] : 1.f, hi);
            const float own = EG[0], tot = vmul(own, att::swap32(own, hi));
#pragma unroll
            for (int gq = 0; gq < 4; ++gq) { const float b3 = vmul(L, T[gq]), b2 = vmul(b3, s[4 * gq + 3]), b1 = vmul(b2, s[4 * gq + 2]), b0 = vmul(b1, s[4 * gq + 1]);
                z[4 * gq + 3] = vmul(z[4 * gq + 3], b3); z[4 * gq + 2] = vmul(z[4 * gq + 2], b2); z[4 * gq + 1] = vmul(z[4 * gq + 1], b1); z[4 * gq] = vmul(z[4 * gq], b0); }
            L = vmul(L, tot);
            v4u pw0, pw1;
#pragma unroll
            for (int i = 0; i < 4; ++i) { pw0[i] = att::cvtpk(z[2 * i], z[2 * i + 1]); pw1[i] = att::cvtpk(z[8 + 2 * i], z[9 + 2 * i]); }
            { const att::v4i16_t l00 = att::vtr(vslot + voff0), h00 = att::vtr(vslot + voff0 + 1024), l01 = att::vtr(vslot + voff0 + 2048), h01 = att::vtr(vslot + voff0 + 3072);
              const att::v4i16_t l10 = att::vtr(vslot + voff1), h10 = att::vtr(vslot + voff1 + 1024), l11 = att::vtr(vslot + voff1 + 2048), h11 = att::vtr(vslot + voff1 + 3072);
#define SB_VF(lo_, hh_) (att::bf16x8){lo_[0], lo_[1], lo_[2], lo_[3], hh_[0], hh_[1], hh_[2], hh_[3]}
              o[0] = __builtin_amdgcn_mfma_f32_32x32x16_bf16(SB_VF(l00, h00), __builtin_bit_cast(att::bf16x8, pw0), o[0], 0, 0, 0);
              o[0] = __builtin_amdgcn_mfma_f32_32x32x16_bf16(SB_VF(l01, h01), __builtin_bit_cast(att::bf16x8, pw1), o[0], 0, 0, 0);
              o[1] = __builtin_amdgcn_mfma_f32_32x32x16_bf16(SB_VF(l10, h10), __builtin_bit_cast(att::bf16x8, pw0), o[1], 0, 0, 0);
              o[1] = __builtin_amdgcn_mfma_f32_32x32x16_bf16(SB_VF(l11, h11), __builtin_bit_cast(att::bf16x8, pw1), o[1], 0, 0, 0);
#undef SB_VF
            }
            if (!__any(L >= 7.5e-37f)) break;
            p ^= 1;
        }
        att::store_o8((unsigned char*)O + (size_t)tok * D + h * HD, o, OSCALE8, hi);
#undef SB_DMA
    }
}

__device__ __forceinline__ float dot64(const v4u (&q)[8], const GAS v4u* kr) { float s = 0.f;
#pragma unroll
    for (int i = 0; i < 8; ++i) { const v4u k = kr[i];
        s += bflo(q[i].x) * bflo(k.x); s += bfhi(q[i].x) * bfhi(k.x); s += bflo(q[i].y) * bflo(k.y); s += bfhi(q[i].y) * bfhi(k.y);
        s += bflo(q[i].z) * bflo(k.z); s += bfhi(q[i].z) * bfhi(k.z); s += bflo(q[i].w) * bflo(k.w); s += bfhi(q[i].w) * bfhi(k.w); }
    return s; }
__device__ __forceinline__ void moba_naive(const Ctx& C0, const bf16* Q, const bf16* Kb, const bf16* Vb, bf16* O) {
    const Ctx C = phase_ctx(C0);
    LAS float* sc = (LAS float*)(C.lds + C.wave * 4096);
    const float* kmean = (const float*)(wsp(C) + WS_KMEAN); const float* btab = (const float*)(wsp(C) + WS_BIAS);
    const int gw = C.vcu * NWAVES + C.wave, lane = C.lane;
    for (int ip = 0; ip < 256; ++ip) {
        const int p = gw * 256 + ip, tok = p >> 4, h = p & 15, b = tok >> 12, qpos = tok & 4095, u = qpos >> 8;
        const bf16* qp = Q + (size_t)tok * D + h * HD;
        v4u qv[8];
#pragma unroll
        for (int i = 0; i < 8; ++i) qv[i] = ((const GAS v4u*)qp)[i];
        const float qd = __uint_as_float((unsigned)qp[lane] << 16);
        const float* km = kmean + (size_t)((b * NH + h) * 16) * 64 + lane;
        float g[15];
#pragma unroll
        for (int n = 0; n < 15; ++n) g[n] = (n < u) ? wave_sum(qd * km[n * 64]) : -INFINITY;
        unsigned mask = 0;
        if (u <= 3) mask = (1u << u) - 1u;
        else {
#pragma unroll
            for (int r = 0; r < 3; ++r) { float best = -INFINITY; int bi = 0;
#pragma unroll
                for (int n = 0; n < 15; ++n) if (!((mask >> n) & 1u) && g[n] > best) { best = g[n]; bi = n; }
                mask |= 1u << bi; }
        }
        mask |= 1u << u;
        const float* bt = btab + h * 1024;
        float mx = -INFINITY; int ns = 0;
        for (int n = 0; n <= u; ++n) { if (!((mask >> n) & 1u)) continue;
            for (int c4 = 0; c4 < 4; ++c4) { const int kpos = 256 * n + 64 * c4 + lane; const int dist = qpos - kpos;
                float s = dot64(qv, (const GAS v4u*)(Kb + (size_t)(b * SEQ + kpos) * D + h * HD));
                s += bt[dist < 0 ? 0 : (dist > 1023 ? 1023 : dist)];
                if (dist < 0) s = -INFINITY;
                sc[ns * 256 + 64 * c4 + lane] = s; mx = fmaxf(mx, s); }
            ++ns; }
        mx = wave_max(mx);
        LDS_WAIT(); asm volatile("" ::: "memory");
        float l = 0.f;
        for (int i = 0; i < ns * 4; ++i) { const float pz = ex2(sc[64 * i + lane] - mx); sc[64 * i + lane] = pz; l += pz; }
        l = wave_sum(l);
        LDS_WAIT(); asm volatile("" ::: "memory");
        float o = 0.f; int n2 = 0;
        for (int n = 0; n <= u; ++n) { if (!((mask >> n) & 1u)) continue;
            const bf16* vp = Vb + (size_t)(b * SEQ + 256 * n) * D + h * HD + lane;
#pragma unroll 8
            for (int i = 0; i < 256; ++i) o += sc[n2 * 256 + i] * __uint_as_float((unsigned)vp[(size_t)i * D] << 16);
            ++n2; }
        LDS_WAIT(); asm volatile("" ::: "memory");
        O[(size_t)tok * D + h * HD + lane] = (bf16)f2bf(o / l);
    }
}
__device__ __forceinline__ void sb_naive(const Ctx& C0, const bf16* Q, const bf16* Kb, const bf16* Vb, bf16* O) {
    const Ctx C = phase_ctx(C0);
    LAS float* sc = (LAS float*)(C.lds + C.wave * 4096);
    const int gw = C.vcu * NWAVES + C.wave, lane = C.lane;
    for (int ip = 0; ip < 256; ++ip) {
        const int p = gw * 256 + ip, tok = p >> 4, h = p & 15, b = tok >> 12, t = tok & 4095;
        const bf16* qp = Q + (size_t)tok * D + h * HD;
        v4u qv[8];
#pragma unroll
        for (int i = 0; i < 8; ++i) qv[i] = ((const GAS v4u*)qp)[i];
        float L = 0.f, o = 0.f;
        for (int c = (t - 1) >> 6; c >= 0; --c) {
            const int j = 64 * c + lane; const bool valid = j < t;
            const float z = dot64(qv, (const GAS v4u*)(Kb + (size_t)(b * SEQ + j) * D + h * HD));
            const float sp = valid ? (fmaxf(z, 0.f) + lg2(1.0f + ex2(-fabsf(z)))) : 0.f;
            float incl = sp;
#pragma unroll
            for (int off = 1; off < 64; off <<= 1) { const float tmp = __shfl_down(incl, off); if (lane + off < 64) incl += tmp; }
            const float excl = incl - sp;
            const float a = valid ? ex2(z - sp + L - excl) : 0.f;
            L -= __shfl(incl, 0);
            sc[lane] = a;
            LDS_WAIT(); asm volatile("" ::: "memory");
            const bf16* vp = Vb + (size_t)(b * SEQ + 64 * c) * D + h * HD + lane;
#pragma unroll 8
            for (int i = 0; i < 64; ++i) o += sc[i] * __uint_as_float((unsigned)vp[(size_t)i * D] << 16);
            LDS_WAIT(); asm volatile("" ::: "memory");
            if (L < -120.0f) break;
        }
        O[(size_t)tok * D + h * HD + lane] = (bf16)f2bf(o);
    }
}

#ifndef DUP_GEMM
#define DUP_GEMM 0
#endif
#ifndef DUP_ATT
#define DUP_ATT 0
#endif
#ifndef DUP_TOK
#define DUP_TOK 0
#endif
#ifndef DUP_MISC
#define DUP_MISC 0
#endif
#ifndef DUP_PRO
#define DUP_PRO 0
#endif
#ifndef SB_VAR
#define SB_VAR 0
#endif
#ifndef MOBA_VAR
#define MOBA_VAR 0
#endif
#ifndef NAIVE_MOBA
#define NAIVE_MOBA 0
#endif
#ifndef NAIVE_SB
#define NAIVE_SB 0
#endif
#ifndef DUP_BAR
#define DUP_BAR 0
#endif
#define GRID_BAR() do { xcd_barrier(bar); if (DUP_BAR) xcd_barrier(bar); } while (0)
#define LOCAL_BAR() do { if (reg32) xcd_barrier_local(bar); else xcd_barrier(bar); } while (0)
#define WSB(off) ((bf16*)(ws + (off)))
template <int l>
__device__ __forceinline__ void layer_body(const Ctx& C, const XcdBarrier& bar, LAS unsigned char* ring, const LAS int* rt, const int G, const int bx, const bool reg32) {
        if (l == 2) { void* xo = wsp(C) + WS_XBF; token_phase<true, true, false, false, true>(C, xo, xo, inp(C, IN_NMIX) + l * D, l * MODW + 0 * D, l * MODW + 1 * D, (bf16*)(wsp(C) + WS_XN), (l - 1) * MODW + 5 * D, nullptr); }
        else if (l == 0) token_phase<false, false, false, false, true, true>(C, inp(C, IN_X), nullptr, inp(C, IN_NMIX) + l * D, l * MODW + 0 * D, l * MODW + 1 * D, (bf16*)(wsp(C) + WS_XN), 0, nullptr);
        else token_phase<false, false, false, false, true>(C, wsp(C) + WS_XBF, nullptr, inp(C, IN_NMIX) + l * D, l * MODW + 0 * D, l * MODW + 1 * D, (bf16*)(wsp(C) + WS_XN), 0, nullptr);
        if (l == 2) GRID_BAR(); else LOCAL_BAR();
        if (l < 2) {
            { unsigned char* ws = wsp(C); pg8::Gemm g{WSB(WS_XN), (const bf16*)(ws + WS_WQKV + (size_t)l * 3 * D * D), NTOK, 3 * D, D / 2}; pg8::ScaleStage<pg8::StaticOrder> S; S.init(NTOK, 3 * D, G, bx); S.sA = (const float*)(ws + WS_SA); S.sB = (const float*)(ws + WS_SBQKV) + (size_t)l * 3 * D; S.buf = ring + SCALEBUF_OFF; S.cnt = 0;
              pg8::EpiBf16I8 E{WSB(WS_Q), D, D, (size_t)(WS_K - WS_Q) / 2, QSCALE, ring + SCALEBUF_OFF, 0};
              pg8::gemm_phase<pg8::EpiBf16I8, pg8::ScaleStage<pg8::StaticOrder>, true, true, 2>(ring, g, S, E); }
            LOCAL_BAR();
            { unsigned char* ws = wsp(C); if (NAIVE_MOBA) moba_naive(C, WSB(WS_Q), WSB(WS_K), WSB(WS_V), WSB(WS_Q)); else { if (DUP_ATT & 1) moba_phase<MOBA_VAR>(C, WSB(WS_Q), WSB(WS_K), WSB(WS_V), WSB(WS_HID)); moba_phase<0>(C, WSB(WS_Q), WSB(WS_K), WSB(WS_V), WSB(WS_HID)); } }
        } else {
            if (l == 2) { unsigned char* ws = wsp(C); pg8::Gemm g{WSB(WS_XN2), (const bf16*)(ws + WS_WKV), NTOK, 2 * D, D / 2}; pg8::ScaleStage<pg8::StaticOrder> S; S.init(NTOK, 2 * D, G, bx); S.sA = (const float*)(ws + WS_SA2); S.sB = (const float*)(ws + WS_SBKV); S.buf = ring + SCALEBUF_OFF; S.cnt = 0;
              pg8::EpiBf16I8 E{WSB(WS_KSH), D, D, (size_t)(WS_VSH - WS_KSH) / 2, 1.0f, ring + SCALEBUF_OFF, 0};
              pg8::gemm_phase<pg8::EpiBf16I8, pg8::ScaleStage<pg8::StaticOrder>, true, true, 2>(ring, g, S, E); }
            { unsigned char* ws = wsp(C); pg8::Gemm g{WSB(WS_XN), (const bf16*)(ws + WS_WQ + (size_t)(l - 2) * D * D), NTOK, D, D / 2}; pg8::ScaleStage<pg8::StaticOrder> S; S.init(NTOK, D, G, bx); S.sA = (const float*)(ws + WS_SA); S.sB = (const float*)(ws + WS_SBQ) + (size_t)(l - 2) * D; S.buf = ring + SCALEBUF_OFF; S.cnt = 0;
              pg8::EpiBf16I8 E{WSB(WS_Q), D, D, 0, QSCALE, ring + SCALEBUF_OFF, 0};
              pg8::gemm_phase<pg8::EpiBf16I8, pg8::ScaleStage<pg8::StaticOrder>, true, true, 2>(ring, g, S, E); }
            LOCAL_BAR();
            { unsigned char* ws = wsp(C); if (NAIVE_SB) sb_naive(C, WSB(WS_Q), WSB(WS_KSH), WSB(WS_VSH), WSB(WS_Q)); else { if (DUP_ATT & 2) sb_phase<SB_VAR>(C, WSB(WS_Q), WSB(WS_KSH), WSB(WS_VSH), WSB(WS_HID)); sb_phase<0>(C, WSB(WS_Q), WSB(WS_KSH), WSB(WS_VSH), WSB(WS_HID)); } }
        }
        LOCAL_BAR();
        { unsigned char* ws = wsp(C);
          const bf16* wo = (const bf16*)((l < 2) ? ws + WS_WO + (size_t)l * D * D : ws + WS_WBO + (size_t)(l - 2) * D * D);
          pg8::Gemm g{WSB(WS_HID), wo, NTOK, D, D / 2}; pg8::StaticOrder S; S.init(NTOK, D, G, bx);
          if (l == 0) { pg8::EpiResidB<true> E{inp(C, IN_X), WSB(WS_XBF), (const float*)(ws + WS_MOD) + l * MODW + 2 * D, MODLD, 1.0f / (OSCALE8 * WSCALE8)};
              pg8::gemm_phase<pg8::EpiResidB<true>, pg8::StaticOrder, true, true, 1>(ring, g, S, E); }
          else { pg8::EpiResidB<false> E{WSB(WS_XBF), WSB(WS_XBF), (const float*)(ws + WS_MOD) + l * MODW + 2 * D, MODLD, 1.0f / (OSCALE8 * WSCALE8)};
              pg8::gemm_phase<pg8::EpiResidB<false>, pg8::StaticOrder, true, true, 1>(ring, g, S, E); } }
        LOCAL_BAR();
        if (l & 1) token_phase<false, false, true, false, true>(C, wsp(C) + WS_XBF, nullptr, inp(C, IN_NFFN) + l * D, l * MODW + 3 * D, l * MODW + 4 * D, (bf16*)(wsp(C) + WS_XN), 0, inp(C, IN_RW) + (size_t)(l >> 1) * D * NE);
        else token_phase<false, false, false, false, true>(C, wsp(C) + WS_XBF, nullptr, inp(C, IN_NFFN) + l * D, l * MODW + 3 * D, l * MODW + 4 * D, (bf16*)(wsp(C) + WS_XN), 0, nullptr);
        if (l & 1) GRID_BAR(); else LOCAL_BAR();
        if (!(l & 1)) {
            { unsigned char* ws = wsp(C); pg8::Gemm g{WSB(WS_XN), (const bf16*)(ws + WS_W13 + (size_t)(l >> 1) * 2 * FF * D), NTOK, 2 * FF, D / 2}; pg8::ScaleStage<pg8::StaticOrder> S; S.init(NTOK, 2 * FF, G, bx); S.sA = (const float*)(ws + WS_SA); S.sB = (const float*)(ws + WS_SB13) + (size_t)(l >> 1) * 2 * FF; S.buf = ring + SCALEBUF_OFF; S.cnt = 0;
              pg8::EpiSwiGluI8 E{ws + WS_HID, FF, 2 * FF / 256, ring + SCALEBUF_OFF, HSCALE8, 0};
              pg8::gemm_phase<pg8::EpiSwiGluI8, pg8::ScaleStage<pg8::StaticOrder>, true, true, 2>(ring, g, S, E); }
            LOCAL_BAR();
            { unsigned char* ws = wsp(C); pg8::Gemm g{WSB(WS_HID), (const bf16*)(ws + WS_W2 + (size_t)(l >> 1) * D * FF), NTOK, D, FF / 2}; pg8::StaticOrder S; S.init(NTOK, D, G, bx);
              pg8::EpiResidB<false> E{WSB(WS_XBF), WSB(WS_XBF), (const float*)(ws + WS_MOD) + l * MODW + 5 * D, MODLD, 1.0f / (HSCALE8 * WSCALE8)};
              pg8::gemm_phase<pg8::EpiResidB<false>, pg8::StaticOrder, true, true, 1>(ring, g, S, E); }
            LOCAL_BAR();
        } else {
            for (int dup = 0; dup <= DUP_MISC; ++dup) { if (dup) __syncthreads(); route_phase(C, (const bf16*)(wsp(C) + WS_XN)); }
            GRID_BAR();
            const int ntiles = __builtin_amdgcn_readfirstlane(rt[RT_NT]);
            { unsigned char* ws = wsp(C); pg8::Gemm g{WSB(WS_XG), (const bf16*)(ws + WS_MW13 + (size_t)(l >> 1) * NE * 2 * FFE * D), MAXTILES * 256, 2 * FFE, D / 2}; pg8::ScaleStage<pg8::MoeOrder> S; S.init(ntiles, 2 * FFE / 256, G, bx, rt + RT_TEXP); S.sA = (const float*)(ws + WS_SAG); S.sB = (const float*)(ws + WS_SBM13) + (size_t)(l >> 1) * NE * 2 * FFE; S.buf = ring + SCALEBUF_OFF; S.cnt = 0;
              pg8::EpiSwiGluI8 E{ws + WS_HID, FFE, 2 * FFE / 256, ring + SCALEBUF_OFF, HSCALE8, 0};
              pg8::gemm_phase<pg8::EpiSwiGluI8, pg8::ScaleStage<pg8::MoeOrder>, true, true, 2>(ring, g, S, E); }
            GRID_BAR();
            { unsigned char* ws = wsp(C); pg8::Gemm g{WSB(WS_HID), (const bf16*)(ws + WS_MW2 + (size_t)(l >> 1) * NE * D * FFE), MAXTILES * 256, D, FFE / 2, 0}; pg8::MoeOrder S; S.init(ntiles < 256 ? ntiles : 256, D / 256, G, bx, rt + RT_TEXP);
              pg8::EpiBf16 E{WSB(WS_XG), D, 0, 0, 1.0f, D / 256, 1.0f / (HSCALE8 * WSCALE8)};
              pg8::gemm_phase<pg8::EpiBf16, pg8::MoeOrder, true, true, 1>(ring, g, S, E); }
            if (ntiles > 256) { unsigned char* ws = wsp(C); pg8::Gemm g{WSB(WS_HID), (const bf16*)(ws + WS_MW2 + (size_t)(l >> 1) * NE * D * FFE), MAXTILES * 256, D, FFE / 2 / TAIL_NS, FFE / 2}; pg8::TailOrder S; S.init(ntiles - 256, D / 256, TAIL_NS, G, bx, rt + RT_TEXP);
              pg8::EpiPlaneF32 E{(float*)(ws + WS_YT), D / 256, 1.0f / (HSCALE8 * WSCALE8), (size_t)TAIL_ROWS * D};
              pg8::gemm_phase<pg8::EpiPlaneF32, pg8::TailOrder, true, true, 1>(ring, g, S, E); }
            GRID_BAR();
        }
    }

struct Args { const float* in[21]; float* out; unsigned char* ws; };
__global__ void __launch_bounds__(NWAVES * 64, 2) yoco_fwd(Args args) {
    extern __shared__ __attribute__((aligned(16))) unsigned char lds[];
    Ctx C;
    C.lds = (LAS unsigned char*)lds; C.tid = threadIdx.x; C.lane = C.tid & 63; C.wave = __builtin_amdgcn_readfirstlane(C.tid >> 6);
    C.G = gridDim.x; { const int bx = blockIdx.x; C.vcu = (C.G % 8 == 0) ? (bx % 8) * (C.G / 8) + bx / 8 : bx; }
    for (int u = C.tid; u < (LDS_BYTES - LDSCTL_OFF) / 4; u += NWAVES * 64) ((LAS unsigned*)(C.lds + LDSCTL_OFF))[u] = 0u;
    __syncthreads();
    if (C.tid < IN_COUNT) ((LAS unsigned long long*)(C.lds + PTR_OFF))[C.tid] = ((const unsigned long long*)__builtin_amdgcn_kernarg_segment_ptr())[C.tid];
    __syncthreads();
    XcdBarrier bar = xcd_barrier_post((unsigned*)((gu32*)(wsp(C) + WS_CTL) + CW_BAR), (volatile LAS unsigned*)(C.lds + MISC_OFF) + 8);
    LAS unsigned char* ring = C.lds + RING_OFF;
    const LAS int* rt = (const LAS int*)(C.lds + ROUTE_OFF);
    const int G = C.G, bx = (int)blockIdx.x;

    for (int dup = 0; dup <= DUP_PRO; ++dup) { if (dup) __syncthreads(); p0_prologue(C); } GRID_BAR();

    const bool reg32 = __builtin_amdgcn_readfirstlane((int)bar.st[2]) == 2;
    int bxv = bx;
    if (reg32) { const int rank = __builtin_amdgcn_readfirstlane((int)bar.st[3]) - 1, xcc = (int)bar.x; C.vcu = xcc * 32 + rank; bxv = rank * 8 + xcc; }

    layer_body<0>(C, bar, ring, rt, G, bxv, reg32);
    layer_body<1>(C, bar, ring, rt, G, bxv, reg32);
    layer_body<2>(C, bar, ring, rt, G, bxv, reg32);
    layer_body<3>(C, bar, ring, rt, G, bxv, reg32);
    token_phase<true, false, false, true>(C, wsp(C) + WS_XBF, outp(C), inp(C, IN_FNG), 0, 0, nullptr, 3 * MODW + 5 * D, nullptr);
}

extern "C" void kernel_launch(void* const* d_in, const int* in_sizes, int n_in, void* d_out, int out_size, void* d_ws, size_t ws_size, hipStream_t stream) {
    static int grid = 0;
    if (grid == 0) {
        if (n_in != 21 || in_sizes[0] != NTOK * D || out_size != NTOK * D || ws_size < WS_END) { fprintf(stderr, "kernel_launch: unexpected shapes (n_in %d, in0 %d, out %d, ws %zu); nothing launched\n", n_in, n_in > 0 ? in_sizes[0] : -1, out_size, ws_size); grid = -1; return; }
        int dev = 0, cus = 0, per_cu = 0;
        if (hipGetDevice(&dev) != hipSuccess || hipDeviceGetAttribute(&cus, hipDeviceAttributeMultiprocessorCount, dev) != hipSuccess) { fprintf(stderr, "kernel_launch: device query failed\n"); grid = -1; return; }
        if (hipFuncSetAttribute((const void*)yoco_fwd, hipFuncAttributeMaxDynamicSharedMemorySize, LDS_BYTES) != hipSuccess) { fprintf(stderr, "kernel_launch: hipFuncSetAttribute failed\n"); grid = -1; return; }
        if (hipOccupancyMaxActiveBlocksPerMultiprocessor(&per_cu, (const void*)yoco_fwd, NWAVES * 64, LDS_BYTES) != hipSuccess || per_cu < 1)
            fprintf(stderr, "kernel_launch: note: occupancy query reports %d workgroups per CU\n", per_cu);
        (void)hipGetLastError();
        if (cus < 256) { fprintf(stderr, "kernel_launch: this kernel needs 256 CUs (found %d); nothing launched\n", cus); grid = -1; return; }
        grid = 256;
    }
    if (grid < 0) return;
    if (hipMemsetAsync((char*)d_ws + WS_CTL, 0, CTL_ZERO_BYTES, stream) != hipSuccess) { fprintf(stderr, "kernel_launch: hipMemsetAsync failed\n"); return; }
    Args a{};
    for (int i = 0; i < 21; ++i) a.in[i] = (const float*)d_in[i];
    a.out = (float*)d_out; a.ws = (unsigned char*)d_ws;
    hipLaunchKernelGGL(yoco_fwd, dim3(grid), dim3(NWAVES * 64), LDS_BYTES, stream, a);
    const hipError_t le = hipPeekAtLastError();
    if (le != hipSuccess) fprintf(stderr, "kernel_launch: launch failed: %s\n", hipGetErrorName(le));
}
```
